# Optimizing an MI355X kernel written in HIP

```python
import jax, jax.numpy as jnp
from jax import lax
import numpy as np

D_MODEL = 2048
BATCH = 2
SEQ = 8192
DEPTH = 1

EPS = 1e-5
POOL_GROUPS = 4
POOL_WINDOWS = (2, 4, 8, 16)
POOL_WIDTH = D_MODEL
POOL_GW = POOL_WIDTH // POOL_GROUPS
POOL_OUT_GW = D_MODEL // POOL_GROUPS
SSD_EXPAND = 2
SSD_INNER = SSD_EXPAND * D_MODEL
SSD_HEADDIM = 64
SSD_HEADS = SSD_INNER // SSD_HEADDIM
SSD_GROUPS = 8
SSD_HPG = SSD_HEADS // SSD_GROUPS
SSD_STATE = 128
SSD_CONV = 4
SSD_CHUNK = 128
SSD_CONV_DIM = SSD_INNER + 2 * SSD_GROUPS * SSD_STATE
N_EXPERTS = 32
TOP_K = 4
D_FF = D_MODEL
SWIGLU_ALPHA = 1.702
SWIGLU_LIMIT = 7.0
MOE_BLOCK = 256
IN_COLS = POOL_WIDTH + SSD_INNER + SSD_CONV_DIM + SSD_HEADS + 2 * D_MODEL
IN_SPLITS = (POOL_WIDTH,
             POOL_WIDTH + SSD_INNER,
             POOL_WIDTH + SSD_INNER + SSD_CONV_DIM,
             POOL_WIDTH + SSD_INNER + SSD_CONV_DIM + SSD_HEADS,
             POOL_WIDTH + SSD_INNER + SSD_CONV_DIM + SSD_HEADS + D_MODEL)

kernel_name = "hybrid_pool_ssd_moe_block"


def rmsnorm(x, w):
    xf = x.astype(jnp.float32)
    y = xf * lax.rsqrt(jnp.mean(xf * xf, axis=-1, keepdims=True) + EPS)
    return (y * w.astype(jnp.float32)).astype(x.dtype)


def causal_pool_mixer(xp, w_pool, pool_scale):
    B, S = xp.shape[:2]
    xg = xp.reshape(B, S, POOL_GROUPS, POOL_GW).astype(jnp.float32)
    csum = jnp.cumsum(xg, axis=1)
    t = jnp.arange(1, S + 1, dtype=jnp.float32)
    means = []
    for g, w in enumerate(POOL_WINDOWS):
        c = csum[:, :, g]
        lagged = jnp.pad(c, ((0, 0), (w, 0), (0, 0)))[:, :S]
        means.append((c - lagged) / jnp.minimum(t, float(w))[None, :, None])
    pooled = jnp.stack(means, axis=2) - xg
    y = jnp.einsum('bsgi,gio->bsgo', pooled.astype(xp.dtype), w_pool)
    return y.reshape(B, S, D_MODEL) * pool_scale


def ssd_mixer(z, xbc, dt_raw, conv_w, conv_b, dt_bias, a_log, d_skip, ssd_norm_w, w_ssd_out):
    B, S = z.shape[:2]
    nc, L, G, J, P, N = S // SSD_CHUNK, SSD_CHUNK, SSD_GROUPS, SSD_HPG, SSD_HEADDIM, SSD_STATE
    xpad = jnp.pad(xbc, ((0, 0), (SSD_CONV - 1, 0), (0, 0)))
    conv = conv_b + sum(xpad[:, k:k + S] * conv_w[k] for k in range(SSD_CONV))
    conv = jax.nn.silu(conv.astype(jnp.float32))
    xs, bm, cm = jnp.split(conv, [SSD_INNER, SSD_INNER + G * N], axis=-1)
    xs = xs.reshape(B, nc, L, G, J, P)
    bm = bm.reshape(B, nc, L, G, N)
    cm = cm.reshape(B, nc, L, G, N)
    dt = jax.nn.softplus(dt_raw.astype(jnp.float32) + dt_bias.astype(jnp.float32))
    a = -jnp.exp(a_log.astype(jnp.float32))
    dt = dt.reshape(B, nc, L, G, J)
    a_cum = jnp.cumsum(dt * a.reshape(G, J), axis=2)
    x_dt = xs * dt[..., None]
    pos = jnp.arange(L)
    causal = (pos[:, None] >= pos[None, :])[None, None, :, :, None, None]
    seg = a_cum[:, :, :, None] - a_cum[:, :, None, :]
    decay = jnp.exp(jnp.where(causal, seg, -jnp.inf))
    cb = jnp.einsum('bclgn,bcsgn->bclsg', cm, bm)
    y_diag = jnp.einsum('bclsgj,bcsgjp->bclgjp', cb[..., None] * decay, x_dt)
    decay_to_end = jnp.exp(a_cum[:, :, -1:] - a_cum)
    states = jnp.einsum('bcsgn,bcsgjp->bcgjpn', bm, x_dt * decay_to_end[..., None])
    chunk_decay = jnp.exp(a_cum[:, :, -1])

    def step(carry, inp):
        st, dec = inp
        return carry * dec[..., None, None] + st, carry

    init = jnp.zeros((B, G, J, P, N), jnp.float32)
    _, prev_states = lax.scan(step, init, (jnp.moveaxis(states, 1, 0), jnp.moveaxis(chunk_decay, 1, 0)))
    prev_states = jnp.moveaxis(prev_states, 0, 1)
    y_off = jnp.einsum('bclgn,bcgjpn->bclgjp', cm, prev_states) * jnp.exp(a_cum)[..., None]
    y = y_diag + y_off + d_skip.astype(jnp.float32).reshape(G, J)[:, :, None] * xs
    y = y.reshape(B, S, SSD_INNER)
    yg = (y * jax.nn.silu(z.astype(jnp.float32))).reshape(B, S, G, SSD_INNER // G)
    yg = yg * lax.rsqrt(jnp.mean(yg * yg, axis=-1, keepdims=True) + EPS)
    yg = yg.reshape(B, S, SSD_INNER) * ssd_norm_w.astype(jnp.float32)
    return yg.astype(z.dtype) @ w_ssd_out


def clamped_swiglu(h):
    glu, lin = jnp.split(h, 2, axis=-1)
    glu = jnp.minimum(glu, SWIGLU_LIMIT)
    lin = jnp.clip(lin, -SWIGLU_LIMIT, SWIGLU_LIMIT)
    return glu * jax.nn.sigmoid(SWIGLU_ALPHA * glu) * (lin + 1.0)


def moe_ffn(u, router_w, router_b, w_up, b_up, w_down, b_down):
    B, S, D = u.shape
    T = B * S
    TK = T * TOP_K
    ut = u.reshape(T, D)
    logits = (ut @ router_w).astype(jnp.float32) + router_b.astype(jnp.float32)
    top_logits, top_idx = lax.top_k(logits, TOP_K)
    gates = jax.nn.softmax(top_logits, axis=-1)
    flat_e = top_idx.reshape(TK).astype(jnp.int32)
    order = jnp.argsort(flat_e, stable=True)
    sorted_e = flat_e[order]
    counts = jnp.bincount(flat_e, length=N_EXPERTS)
    padded = (counts + MOE_BLOCK - 1) // MOE_BLOCK * MOE_BLOCK
    start = jnp.cumsum(counts) - counts
    pend = jnp.cumsum(padded)
    pstart = pend - padded
    dest_sorted = pstart[sorted_e] + jnp.arange(TK, dtype=jnp.int32) - start[sorted_e]
    dest = jnp.zeros((TK,), jnp.int32).at[order].set(dest_sorted.astype(jnp.int32))
    n_blocks = -(-TK // MOE_BLOCK) + N_EXPERTS
    n_slots = n_blocks * MOE_BLOCK
    tok = jnp.arange(TK, dtype=jnp.int32) // TOP_K
    slot_tok = jnp.full((n_slots,), T, jnp.int32).at[dest].set(tok)
    u_pad = jnp.concatenate([ut, jnp.zeros((1, D), ut.dtype)], axis=0)
    xb = u_pad[slot_tok].reshape(n_blocks, MOE_BLOCK, D)
    block_start = jnp.arange(n_blocks, dtype=jnp.int32) * MOE_BLOCK
    block_expert = jnp.minimum(jnp.searchsorted(pend, block_start, side='right'), N_EXPERTS - 1)

    def expert_block(args):
        xblk, e = args
        hgu = xblk @ w_up[e] + b_up[e]
        return clamped_swiglu(hgu) @ w_down[e] + b_down[e]

    yb = lax.map(expert_block, (xb, block_expert)).reshape(n_slots, D)
    y = jnp.einsum('tk,tkd->td', gates.astype(u.dtype), yb[dest].reshape(T, TOP_K, D))
    return y.reshape(B, S, D)


def setup_inputs(seed: int = 0) -> dict:
    key = jax.random.key(seed)
    ks = jax.random.split(key, 24)
    f32 = jnp.float32
    nrm = lambda k, shape, scale: jax.random.normal(k, shape, f32) * scale
    dt_init = jnp.exp(jax.random.uniform(ks[7], (SSD_HEADS,), f32, np.log(1e-3), np.log(1e-1)))
    return {
        "x": nrm(ks[0], (BATCH, SEQ, D_MODEL), 1.0),
        "norm_mix_w": 1.0 + nrm(ks[1], (D_MODEL,), 0.05),
        "w_in": nrm(ks[2], (D_MODEL, IN_COLS), D_MODEL ** -0.5),
        "w_pool": nrm(ks[3], (POOL_GROUPS, POOL_GW, POOL_OUT_GW), POOL_GW ** -0.5),
        "pool_scale": 1.0 + nrm(ks[4], (D_MODEL,), 0.1),
        "conv_w": nrm(ks[5], (SSD_CONV, SSD_CONV_DIM), 0.5),
        "conv_b": nrm(ks[6], (SSD_CONV_DIM,), 0.01),
        "dt_bias": dt_init + jnp.log(-jnp.expm1(-dt_init)),
        "a_log": jnp.log(jax.random.uniform(ks[8], (SSD_HEADS,), f32, 1.0, 16.0)),
        "d_skip": 1.0 + nrm(ks[9], (SSD_HEADS,), 0.1),
        "ssd_norm_w": 1.0 + nrm(ks[10], (SSD_INNER,), 0.05),
        "w_ssd_out": nrm(ks[11], (SSD_INNER, D_MODEL), SSD_INNER ** -0.5),
        "w_out": nrm(ks[12], (D_MODEL, D_MODEL), D_MODEL ** -0.5),
        "norm_ffn_w": 1.0 + nrm(ks[13], (D_MODEL,), 0.05),
        "router_w": nrm(ks[14], (D_MODEL, N_EXPERTS), D_MODEL ** -0.5),
        "router_b": nrm(ks[15], (N_EXPERTS,), 0.01),
        "w_up": nrm(ks[16], (N_EXPERTS, D_MODEL, 2 * D_FF), D_MODEL ** -0.5),
        "b_up": nrm(ks[17], (N_EXPERTS, 2 * D_FF), 0.01),
        "w_down": nrm(ks[18], (N_EXPERTS, D_FF, D_MODEL), D_FF ** -0.5),
        "b_down": nrm(ks[19], (N_EXPERTS, D_MODEL), 0.01),
        "norm_final_w": 1.0 + nrm(ks[20], (D_MODEL,), 0.05),
    }


def reference(x, norm_mix_w, w_in, w_pool, pool_scale, conv_w, conv_b, dt_bias, a_log, d_skip,
              ssd_norm_w, w_ssd_out, w_out, norm_ffn_w, router_w, router_b, w_up, b_up,
              w_down, b_down, norm_final_w):
    h = x
    for _ in range(DEPTH):
        u = rmsnorm(h, norm_mix_w)
        proj = u @ w_in
        xp, z, xbc, dt_raw, g_pool, g_ssd = jnp.split(proj, IN_SPLITS, axis=-1)
        pool_out = causal_pool_mixer(xp, w_pool, pool_scale)
        ssd_out = ssd_mixer(z, xbc, dt_raw, conv_w, conv_b, dt_bias, a_log, d_skip,
                            ssd_norm_w, w_ssd_out)
        merged = jax.nn.sigmoid(g_pool) * pool_out + jax.nn.sigmoid(g_ssd) * ssd_out
        h = h + merged @ w_out
        h = h + moe_ffn(rmsnorm(h, norm_ffn_w), router_w, router_b, w_up, b_up, w_down, b_down)
    return rmsnorm(h, norm_final_w)
```

```cpp
#include <hip/hip_runtime.h>
#include <cstdio>
#include <cstdint>

#ifndef MK_N_LAUNCHES
#define MK_N_LAUNCHES 1
#endif

#define LAS __attribute__((address_space(3)))
#define GAS __attribute__((address_space(1)))
typedef unsigned short bf16;
typedef unsigned char uchar;
typedef short bf16x8 __attribute__((ext_vector_type(8)));
typedef float f32x4 __attribute__((ext_vector_type(4)));
typedef float f32x2 __attribute__((ext_vector_type(2)));
typedef unsigned u32x4 __attribute__((ext_vector_type(4)));
typedef unsigned u32x2 __attribute__((ext_vector_type(2)));
typedef int i32x8 __attribute__((ext_vector_type(8)));
typedef int i32x4_t __attribute__((ext_vector_type(4)));
typedef GAS unsigned gu32;
#define RLX_AGENT __ATOMIC_RELAXED, __HIP_MEMORY_SCOPE_AGENT
#define LDS_WAIT() asm volatile("s_waitcnt lgkmcnt(0)" ::: "memory")
#define VM_WAIT() asm volatile("s_waitcnt vmcnt(0)" ::: "memory")

__device__ __forceinline__ unsigned cvt_pk_bf16(float lo, float hi) { unsigned r; asm volatile("v_cvt_pk_bf16_f32 %0, %1, %2" : "=v"(r) : "v"(lo), "v"(hi)); return r; }
typedef __bf16 bf16x2_t __attribute__((ext_vector_type(2)));
__device__ __forceinline__ unsigned cvt_pk_bf16_v(float lo, float hi) { const f32x2 v = {lo, hi}; return __builtin_bit_cast(unsigned, __builtin_convertvector(v, bf16x2_t)); }
__device__ __forceinline__ unsigned cvt4_fp8(float a, float b, float c, float d) { int w = 0; w = __builtin_amdgcn_cvt_pk_fp8_f32(a, b, w, false); w = __builtin_amdgcn_cvt_pk_fp8_f32(c, d, w, true); return (unsigned)w; }
__device__ __forceinline__ float bflo(unsigned u) { return __uint_as_float(u << 16); }
__device__ __forceinline__ float bfhi(unsigned u) { return __uint_as_float(u & 0xffff0000u); }
__device__ __forceinline__ float sigmoidf_(float x) { return __builtin_amdgcn_rcpf(1.0f + __expf(-x)); }
__device__ __forceinline__ float siluf_(float x) { return x * __builtin_amdgcn_rcpf(1.0f + __expf(-x)); }
__device__ __forceinline__ float wave_sum(float v) {
#pragma unroll
    for (int o = 1; o < 64; o <<= 1) v += __shfl_xor(v, o);
    return v;
}

constexpr int T = 16384, D = 2048, SEQ = 8192;
constexpr int ZI = 4096, XBCW = 6144, NH = 64, NPAD = 16640, INCOLS = 16448;
constexpr int NEXP = 32;
constexpr float EPS = 1e-5f;

namespace pg8 {
constexpr int BM = 256, BK = 64, HALF = 128, HTB = HALF * BK * 2, STAGE_BYTES = 8 * HTB, NXCD = 8, WGM = 8;
__host__ __device__ __forceinline__ int lds_byte(int r, int c) { const int st = (r >> 4) * 2 + (c >> 5), rr = r & 15, cc = c & 31, ob = rr * 64 + cc * 2; return st * 1024 + (ob ^ (((ob >> 9) & 1) << 5)); }
__host__ __device__ __forceinline__ void stage_rc(int b, int& R, int& C) { const int st = b / 1024, sb = b % 1024, swz = sb ^ (((sb >> 9) & 1) << 5); R = (st >> 1) * 16 + swz / 64; C = (st & 1) * 32 + (swz % 64) / 2; }
__host__ __device__ __forceinline__ int perm32(int rho) { const int n = rho >> 4, i = rho & 15; return 8 * (i >> 2) + 4 * n + (i & 3); }

struct Unit { int pm, pn, e; };

struct TileOrder {
    int nM, nN, nwg, G, c, nx;
    __device__ __forceinline__ void init(int nM_, int nN_, int G_, int c_, int nx_ = NXCD) { nM = nM_; nN = nN_; nwg = nM * nN; G = G_; c = c_; nx = nx_; }
    __device__ __forceinline__ bool tile(int i, int& pm, int& pn) const {
        const long L = (long)i * G + c; if (L >= nwg) return false;
        int wgid = (int)L; { const int q = nwg / nx, r = nwg % nx, xcd = wgid % nx, off = wgid / nx; wgid = (xcd < r ? xcd * (q + 1) : r * (q + 1) + (xcd - r) * q) + off; }
        const int nig = WGM * nN, gid = wgid / nig, fm = gid * WGM, gsz = (nM - fm) < WGM ? (nM - fm) : WGM;
        pm = fm + ((wgid % nig) % gsz); pn = (wgid % nig) / gsz; return true;
    }
};

template <class Epi, class Sched, bool ALIGN_EPI, bool SP2, bool FP8 = false>
__device__ __forceinline__ void gemm_phase(LAS uchar* lds, const bf16* Abase, const int K, const Sched& S, const Epi& E) {
    const int tid = threadIdx.x, wid = __builtin_amdgcn_readfirstlane(tid >> 6), lane = tid & 63, wr = wid >> 2, wc = wid & 3, fr = lane & 15, fq = lane >> 4;
    const int nt = K / BK;
    unsigned voffB[2];
#pragma unroll
    for (int i = 0; i < 2; ++i) { int R, C; stage_rc(tid * 16 + i * 8192, R, C); const int Rb = Epi::PERM ? ((R & ~31) + perm32(R & 31)) : R;
        voffB[i] = (unsigned)(Rb * K + C) * 2u; }
#define PG8_AOFFS(dst, u) do { _Pragma("unroll") for (int h = 0; h < 2; ++h) _Pragma("unroll") for (int i = 0; i < 2; ++i) { int R, C; stage_rc(tid * 16 + i * 8192, R, C); \
        dst[h][i] = S.arow(u, h * HALF + R) + (unsigned)C * 2u; } } while (0)
    const size_t kstep = (size_t)(BK * 2);
    const size_t hstep = (size_t)HALF * K * 2;
    const unsigned ldsw = (unsigned)wid * 1024u;
    const int aoff = lds_byte(wr * 64 + fr, fq * 8), boff = lds_byte(wc * 32 + fr, fq * 8);
#define PG8_SA(b, h) (((b) * 2 + (h)) * HTB)
#define PG8_SB(b, h) ((4 + (b) * 2 + (h)) * HTB)
#define PG8_STAGE(bufoff, gbase, voff) do { _Pragma("unroll") for (int _i = 0; _i < 2; ++_i) \
        __builtin_amdgcn_global_load_lds((const unsigned*)((const char*)(gbase) + (voff)[_i]), (LAS unsigned*)(lds + (bufoff) + ldsw + _i * 8192), 16, 0, 0); } while (0)
#define PG8_RD(off) (*(const LAS u32x4*)(lds + (off)))
#define PG8_LDA(dst, b, h) do { _Pragma("unroll") for (int m = 0; m < 4; ++m) { if constexpr (FP8) dst##8[m] = __builtin_bit_cast(i32x8, __builtin_shufflevector(PG8_RD(PG8_SA(b, h) + aoff + m * 2048), PG8_RD(PG8_SA(b, h) + aoff + m * 2048 + 1024), 0, 1, 2, 3, 4, 5, 6, 7)); \
        else { _Pragma("unroll") for (int k = 0; k < 2; ++k) dst[m][k] = *(const LAS bf16x8*)(lds + PG8_SA(b, h) + aoff + m * 2048 + k * 1024); } } } while (0)
#define PG8_LDB(dst, b, h) do { _Pragma("unroll") for (int n = 0; n < 2; ++n) { if constexpr (FP8) dst##8[n] = __builtin_bit_cast(i32x8, __builtin_shufflevector(PG8_RD(PG8_SB(b, h) + boff + n * 2048), PG8_RD(PG8_SB(b, h) + boff + n * 2048 + 1024), 0, 1, 2, 3, 4, 5, 6, 7)); \
        else { _Pragma("unroll") for (int k = 0; k < 2; ++k) dst[n][k] = *(const LAS bf16x8*)(lds + PG8_SB(b, h) + boff + n * 2048 + k * 1024); } } } while (0)
#define PG8_MMA(ai, bj, At, Bt) do { __builtin_amdgcn_s_setprio(1); _Pragma("unroll") for (int m = 0; m < 4; ++m) _Pragma("unroll") for (int n = 0; n < 2; ++n) { \
        if constexpr (FP8) { asm volatile("v_mfma_scale_f32_16x16x128_f8f6f4 %0, %1, %2, %0, %3, %4 op_sel_hi:[0,0,0]" : "+v"(acc[ai][bj][m][n]) : "v"(Bt##8[n]), "v"(At##8[m]), "v"(sc_1), "v"(sc_1)); } \
        else { _Pragma("unroll") for (int k = 0; k < 2; ++k) acc[ai][bj][m][n] = __builtin_amdgcn_mfma_f32_16x16x32_bf16(Bt[n][k], At[m][k], acc[ai][bj][m][n], 0, 0, 0); } } \
        __builtin_amdgcn_s_setprio(0); } while (0)
#define PG8_WAIT_V(n) asm volatile("s_waitcnt vmcnt(" #n ")" ::: "memory")
#define PG8_WAIT_L(n) asm volatile("s_waitcnt lgkmcnt(" #n ")" ::: "memory")
#define PG8_BAR __builtin_amdgcn_s_barrier()
#define PG8_SCHED __builtin_amdgcn_sched_barrier(0)
    Unit cur, nxt; int ui = 0;
    if (!S.next(0, cur)) return;
    f32x4 acc[2][2][4][2];
#pragma unroll
    for (int a = 0; a < 2; ++a)
#pragma unroll
        for (int b = 0; b < 2; ++b)
#pragma unroll
            for (int m = 0; m < 4; ++m)
#pragma unroll
                for (int n = 0; n < 2; ++n) acc[a][b][m][n] = (f32x4){0.f, 0.f, 0.f, 0.f};
    bf16x8 At[4][2], B0[2][2], B1[2][2];
    i32x8 At8[4], B08[2], B18[2];
    int sc_1 = 0x7F7F7F7F;
    if constexpr (FP8) asm volatile("" : "+v"(sc_1));
    unsigned vA[2][2];
    LAS u32x4* nva_lds = (LAS u32x4*)(lds + STAGE_BYTES) + tid;
    PG8_AOFFS(vA, cur); *nva_lds = (u32x4){vA[0][0], vA[0][1], vA[1][0], vA[1][1]};
    const char* cA = (const char*)Abase; const char* cB = S.bbase(cur);
    if constexpr (SP2) {
        PG8_STAGE(PG8_SB(0, 0), cB, voffB); PG8_STAGE(PG8_SB(0, 1), cB + hstep, voffB); PG8_STAGE(PG8_SA(0, 0), cA, vA[0]); PG8_STAGE(PG8_SA(0, 1), cA, vA[1]);
        if (wr == 1) PG8_BAR;
        PG8_WAIT_V(2); PG8_BAR;
        PG8_STAGE(PG8_SB(1, 0), cB + kstep, voffB); PG8_STAGE(PG8_SA(1, 0), cA + kstep, vA[0]); PG8_STAGE(PG8_SB(1, 1), cB + hstep + kstep, voffB);
        PG8_WAIT_V(6); PG8_BAR;
    } else {
        PG8_STAGE(PG8_SB(0, 0), cB, voffB); PG8_STAGE(PG8_SA(0, 0), cA, vA[0]); PG8_STAGE(PG8_SB(0, 1), cB + hstep, voffB); PG8_STAGE(PG8_SA(0, 1), cA, vA[1]);
        if (wr == 1) PG8_BAR;
        PG8_WAIT_V(4); PG8_BAR;
        PG8_STAGE(PG8_SB(1, 0), cB + kstep, voffB); PG8_STAGE(PG8_SA(1, 0), cA + kstep, vA[0]); PG8_STAGE(PG8_SB(1, 1), cB + hstep + kstep, voffB);
        PG8_WAIT_V(6); PG8_BAR;
    }
    for (;;) {
        const bool has_next = S.next(ui + 1, nxt);
        const char* nB = has_next ? S.bbase(nxt) : cB;
        if (has_next) { unsigned nvA[2][2]; PG8_AOFFS(nvA, nxt); *nva_lds = (u32x4){nvA[0][0], nvA[0][1], nvA[1][0], nvA[1][1]}; }
        for (int t = 0; t < nt; t += 2) {
            const bool last = (t == nt - 2);
            const char* a1 = cA + (size_t)(t + 1) * kstep;
            const char* a2 = last ? cA : cA + (size_t)(t + 2) * kstep; const char* b2 = last ? nB : cB + (size_t)(t + 2) * kstep;
            const char* a3 = a2 + kstep; const char* b3 = b2 + kstep;
#define PG8_SWAPA do { if (last) { const u32x4 t_ = *nva_lds; vA[0][0] = t_[0]; vA[0][1] = t_[1]; vA[1][0] = t_[2]; vA[1][1] = t_[3]; } } while (0)
            if constexpr (SP2) {
            PG8_LDB(B0, 0, 0); PG8_LDB(B1, 0, 1); PG8_SCHED; PG8_LDA(At, 0, 0); PG8_STAGE(PG8_SA(1, 1), a1, vA[1]); PG8_SWAPA;
            PG8_WAIT_V(8); PG8_WAIT_L(0); PG8_BAR; PG8_MMA(0, 0, At, B0); PG8_MMA(0, 1, At, B1); PG8_BAR; PG8_SCHED;
            PG8_LDA(At, 0, 1); PG8_STAGE(PG8_SB(0, 0), b2, voffB); PG8_STAGE(PG8_SB(0, 1), b2 + hstep, voffB); PG8_STAGE(PG8_SA(0, 0), a2, vA[0]);
            PG8_WAIT_V(8); PG8_WAIT_L(0); PG8_BAR; PG8_MMA(1, 0, At, B0); PG8_MMA(1, 1, At, B1); PG8_BAR; PG8_SCHED;
            PG8_LDB(B0, 1, 0); PG8_LDB(B1, 1, 1); PG8_SCHED; PG8_LDA(At, 1, 0); PG8_STAGE(PG8_SA(0, 1), a2, vA[1]);
            PG8_WAIT_V(8); PG8_WAIT_L(0); PG8_BAR; PG8_MMA(0, 0, At, B0); PG8_MMA(0, 1, At, B1); PG8_BAR; PG8_SCHED;
            PG8_LDA(At, 1, 1); PG8_STAGE(PG8_SB(1, 0), b3, voffB); PG8_STAGE(PG8_SB(1, 1), b3 + hstep, voffB); PG8_STAGE(PG8_SA(1, 0), a3, vA[0]);
            PG8_WAIT_V(8); PG8_WAIT_L(0); PG8_BAR; PG8_MMA(1, 0, At, B0); PG8_MMA(1, 1, At, B1); PG8_BAR; PG8_SCHED;
            } else {
            PG8_LDB(B0, 0, 0); PG8_SCHED; PG8_LDA(At, 0, 0); PG8_STAGE(PG8_SA(1, 1), a1, vA[1]); PG8_SWAPA;
            PG8_WAIT_L(8); PG8_BAR; PG8_WAIT_L(0); PG8_MMA(0, 0, At, B0); PG8_BAR; PG8_SCHED;
            PG8_LDB(B1, 0, 1); PG8_STAGE(PG8_SB(0, 0), b2, voffB);
            PG8_BAR; PG8_WAIT_L(0); PG8_MMA(0, 1, At, B1); PG8_BAR;
            PG8_LDA(At, 0, 1); PG8_STAGE(PG8_SA(0, 0), a2, vA[0]);
            PG8_BAR; PG8_WAIT_L(0); PG8_MMA(1, 0, At, B0); PG8_BAR; PG8_SCHED;
            PG8_STAGE(PG8_SB(0, 1), b2 + hstep, voffB);
            PG8_WAIT_V(6); PG8_BAR; PG8_MMA(1, 1, At, B1); PG8_BAR;
            PG8_LDB(B0, 1, 0); PG8_SCHED; PG8_LDA(At, 1, 0); PG8_STAGE(PG8_SA(0, 1), a2, vA[1]);
            PG8_WAIT_L(8); PG8_BAR; PG8_WAIT_L(0); PG8_MMA(0, 0, At, B0); PG8_BAR; PG8_SCHED;
            PG8_LDB(B1, 1, 1); PG8_STAGE(PG8_SB(1, 0), b3, voffB);
            PG8_BAR; PG8_WAIT_L(0); PG8_MMA(0, 1, At, B1); PG8_BAR;
            PG8_LDA(At, 1, 1); PG8_STAGE(PG8_SA(1, 0), a3, vA[0]);
            PG8_BAR; PG8_WAIT_L(0); PG8_MMA(1, 0, At, B0); PG8_BAR; PG8_SCHED;
            PG8_STAGE(PG8_SB(1, 1), b3 + hstep, voffB);
            PG8_WAIT_V(6); PG8_BAR; PG8_MMA(1, 1, At, B1); PG8_BAR;
            }
        }
        if constexpr (ALIGN_EPI) { if (wr == 0) PG8_BAR; }
        if constexpr (FP8) asm volatile("s_nop 15\n\ts_nop 15" ::: "memory");
        E(acc, cur, wr, wc, fr, fq);
        if constexpr (FP8) asm volatile("s_nop 7" ::: "memory");
        if (!has_next) break;
#pragma unroll
        for (int a = 0; a < 2; ++a)
#pragma unroll
            for (int b = 0; b < 2; ++b)
#pragma unroll
                for (int m = 0; m < 4; ++m)
#pragma unroll
                    for (int n = 0; n < 2; ++n) acc[a][b][m][n] = (f32x4){0.f, 0.f, 0.f, 0.f};
        cur = nxt; cB = nB; ++ui;
        if constexpr (ALIGN_EPI) { if (wr == 1) PG8_BAR; }
    }
    PG8_WAIT_V(0);
    if constexpr (!ALIGN_EPI) { if (wr == 0) PG8_BAR; }
    PG8_BAR;
#undef PG8_SA
#undef PG8_SB
#undef PG8_STAGE
#undef PG8_RD
#undef PG8_AOFFS
#undef PG8_SWAPA
#undef PG8_LDA
#undef PG8_LDB
#undef PG8_MMA
#undef PG8_WAIT_V
#undef PG8_WAIT_L
#undef PG8_BAR
#undef PG8_SCHED
}
}

#ifndef PG8_SP2
#define PG8_SP2 true
#endif
#ifndef PG8_ALIGN
#define PG8_ALIGN true
#endif

constexpr int NWAVES = 8;
constexpr int NPHASES = 12;
constexpr int N_LAUNCHES = MK_N_LAUNCHES;
#ifndef MOE_FP8
#define MOE_FP8 1
#endif
#ifndef MK_DOUBLE
#define MK_DOUBLE -1
#endif
#define REPS(k) for (int rep_ = 0; rep_ < ((MK_DOUBLE) == (k) ? 2 : 1); ++rep_)
#ifndef MK_CUTS
#define MK_CUTS 0x7fe
#endif

constexpr size_t MiB = 1u << 20;
constexpr size_t WS_CTL = 0, CTL_ZERO_BYTES = 256 * 1024;
constexpr size_t WS_WIN = 1 * MiB, WS_WPOOL = 66 * MiB, WS_WSSD = 68 * MiB, WS_WOUT = 84 * MiB, WS_WUP = 92 * MiB, WS_WDOWN = 604 * MiB;
constexpr size_t WS_U = 860 * MiB, WS_XP = 924 * MiB, WS_Z = 988 * MiB, WS_XBC = 1116 * MiB, WS_GP = 1308 * MiB, WS_GS = 1372 * MiB, WS_DT = 1436 * MiB;
constexpr size_t WS_POOLED = 1440 * MiB, WS_STATES = 1504 * MiB, WS_CDEC = 1632 * MiB, WS_YG = 1633 * MiB, WS_MERGED = 1761 * MiB, WS_H1 = 1825 * MiB;
constexpr size_t WS_ACT = 1953 * MiB, WS_YB = 2241 * MiB, WS_SLOTTOK = 2529 * MiB, WS_TOKE = 2531 * MiB, WS_TOKPOS = 2532 * MiB, WS_GATE = 2533 * MiB, WS_XC = 2534 * MiB, WS_U8 = 2534 * MiB  , WS_WIN8 = 2574 * MiB  , WS_END = 2726 * MiB;
static_assert(WS_WIN + (size_t)NPAD * D * 2 <= WS_WPOOL && WS_WUP + (size_t)NEXP * 4096 * 2048 * 2 <= WS_WDOWN && WS_WDOWN + (size_t)NEXP * 2048 * 2048 * 2 <= WS_U, "ws map (weights)");
static_assert(WS_XBC + (size_t)T * XBCW * 2 <= WS_GP && WS_STATES + (size_t)2 * 64 * 64 * 64 * 128 * 2 <= WS_CDEC && WS_ACT + (size_t)288 * 256 * 2048 * 2 <= WS_YB && WS_YB + (size_t)288 * 256 * 2048 * 2 <= WS_SLOTTOK, "ws map");
constexpr int CW_TMO = 0, CW_BAR = 4096, CW_CNT = 49152;
static_assert((CW_CNT + 64 * NEXP) * 4 <= (int)CTL_ZERO_BYTES, "ctl");

constexpr int LDS_BYTES = 147456;
constexpr int LDSCTL_OFF = LDS_BYTES - 1024;
constexpr int LW_BAR = 8, LW_RBS = 16, LW_CNT = 64;

#define XB_TMO      128
#define XB_XCNT(j)  (256  + 64 * (j))
#define XB_XSUB(j)  (1280 + 64 * (j))
#define XB_XGEN(j)  (2304 + 64 * (j))
#define XB_TOP      3328
#define XB_TOPGEN   3392
#define XCD_BAR_WORDS 3456
#define XB_SPIN_CAP (1u << 18)
__device__ __forceinline__ unsigned xb_ld(unsigned* p)              { return __hip_atomic_load(p, __ATOMIC_RELAXED, __HIP_MEMORY_SCOPE_AGENT); }
__device__ __forceinline__ unsigned xb_add(unsigned* p, unsigned v) { return __hip_atomic_fetch_add(p, v, __ATOMIC_RELAXED, __HIP_MEMORY_SCOPE_AGENT); }
__device__ __forceinline__ unsigned xb_xcc_id() { return (unsigned)__builtin_amdgcn_s_getreg((3 << 11) | 20) & 0xFu; }
#define XB_SPIN(cond, bar) do { unsigned _sp = 0; while (cond) { __builtin_amdgcn_s_sleep(1); \
    if ((++_sp & 255u) == 0u) { if (xb_ld(&(bar)[XB_TMO])) break; if (_sp > XB_SPIN_CAP) { atomicAdd(&(bar)[XB_TMO], 1u); break; } } } } while (0)
struct XcdBarrier { unsigned* bar; unsigned x; volatile LAS unsigned* st; };
__device__ __forceinline__ XcdBarrier xcd_barrier_post(unsigned* bar, volatile LAS unsigned* st) {
    XcdBarrier b; b.bar = bar; b.x = xb_xcc_id(); b.st = st;
    if (threadIdx.x == 0) (void)xb_add(&bar[XB_XCNT(b.x)], 1u);
    return b;
}
__device__ __forceinline__ void xcd_barrier_complete(unsigned* bar, unsigned x, unsigned& nloc, unsigned& nx) {
    const unsigned G = gridDim.x * gridDim.y * gridDim.z;
    unsigned sum, cnt, mine, sp = 0u;
    for (;;) {
        sum = 0u; cnt = 0u; mine = 0u;
#pragma unroll
        for (unsigned j = 0; j < 16; ++j) { const unsigned c = xb_ld(&bar[XB_XCNT(j)]); sum += c; cnt += (c > 0u) ? 1u : 0u; mine = (j == x) ? c : mine; }
        if (sum == G) break;
        __builtin_amdgcn_s_sleep(1);
        if ((++sp & 255u) == 0u) { if (xb_ld(&bar[XB_TMO])) break; if (sp > XB_SPIN_CAP) { atomicAdd(&bar[XB_TMO], 1u); break; } }
    }
    nloc = mine > 0u ? mine : 1u; nx = cnt > 0u ? cnt : 1u;
}
__device__ __forceinline__ void xcd_barrier(const XcdBarrier& b) {
    asm volatile("s_waitcnt vmcnt(0)" ::: "memory");
    __syncthreads();
    if (threadIdx.x == 0) {
        unsigned* bar = b.bar;
        __builtin_amdgcn_s_waitcnt(0);
        unsigned nloc = b.st[0], nx = b.st[1];
        if (nloc == 0u) { xcd_barrier_complete(bar, b.x, nloc, nx); b.st[0] = nloc; b.st[1] = nx; }
        const unsigned old = xb_add(&bar[XB_XSUB(b.x)], 1u);
        const unsigned gen = old / nloc;
        if (old + 1u == (gen + 1u) * nloc) {
            __builtin_amdgcn_fence(__ATOMIC_RELEASE, "agent");
            asm volatile("s_waitcnt vmcnt(0)" ::: "memory");
            const unsigned og = xb_add(&bar[XB_TOP], 1u);
            const unsigned tg = og / nx;
            if (og + 1u == (tg + 1u) * nx) xb_add(&bar[XB_TOPGEN], 1u);
            else XB_SPIN(xb_ld(&bar[XB_TOPGEN]) == tg, bar);
            __builtin_amdgcn_fence(__ATOMIC_ACQUIRE, "agent");
            xb_add(&bar[XB_XGEN(b.x)], 1u);
            asm volatile("s_waitcnt vmcnt(0)" ::: "memory");
        } else {
            XB_SPIN(xb_ld(&bar[XB_XGEN(b.x)]) == gen, bar);
            __builtin_amdgcn_fence(__ATOMIC_ACQUIRE, "agent");
            asm volatile("s_waitcnt vmcnt(0)" ::: "memory");
        }
    }
    __syncthreads();
}

struct Frame {
    LAS uchar* lds; volatile LAS unsigned* LW; gu32* ctl;
    int tid, lane, wave, G;
    uchar* ws; float* out;
    const float *x, *norm_mix_w, *w_in, *w_pool, *pool_scale, *conv_w, *conv_b, *dt_bias, *a_log, *d_skip, *ssd_norm_w, *w_ssd_out, *w_out, *norm_ffn_w, *router_w, *router_b, *w_up, *b_up, *w_down, *b_down, *norm_final_w;
};
#define WSP(type, off) ((type*)(F.ws + (off)))

struct DenseOrder {
    pg8::TileOrder to; const bf16* Bt; int K; int pn0 = 0, skip_lo = 1 << 20, skip_n = 0;
    __device__ __forceinline__ bool next(int i, pg8::Unit& u) const { u.e = 0; const bool ok = to.tile(i, u.pm, u.pn); u.pn += pn0; if (u.pn >= skip_lo) u.pn += skip_n; return ok; }
    __device__ __forceinline__ unsigned arow(const pg8::Unit& u, int R) const { return (unsigned)(u.pm * 256 + R) * (unsigned)(K * 2); }
    __device__ __forceinline__ const char* bbase(const pg8::Unit& u) const { return (const char*)Bt + (size_t)u.pn * 256 * K * 2; }
};
struct PoolOrder {
    int G, c; const bf16* Bt;
    __device__ __forceinline__ bool next(int i, pg8::Unit& u) const { const int L = i * G + c; if (L >= 512) return false; u.e = L >> 7; u.pm = (L & 127) >> 1; u.pn = L & 1; return true; }
    __device__ __forceinline__ unsigned arow(const pg8::Unit& u, int R) const { return (unsigned)(u.e * T + u.pm * 256 + R) * 1024u; }
    __device__ __forceinline__ const char* bbase(const pg8::Unit& u) const { return (const char*)Bt + (size_t)(u.e * 512 + u.pn * 256) * 1024; }
};
struct MoeOrder {
    pg8::TileOrder to; const bf16* Bt; int K; size_t estride_bytes; volatile LAS unsigned* LW; const int* slot_tok; bool gather;
    __device__ __forceinline__ bool next(int i, pg8::Unit& u) const {
        if (!to.tile(i, u.pm, u.pn)) return false;
        int e = 0;
#pragma unroll 8
        for (int j = 1; j <= NEXP; ++j) e += ((int)LW[LW_RBS + j] <= u.pm) ? 1 : 0;
        u.e = __builtin_amdgcn_readfirstlane(e); return true;
    }
    __device__ __forceinline__ unsigned arow(const pg8::Unit& u, int R) const {
        if (!gather) return (unsigned)(u.pm * 256 + R) * (unsigned)(K * 2);
        const int idx = (u.pm - (int)LW[LW_RBS + u.e]) * 256 + R, cnt = (int)LW[LW_CNT + u.e];
        const int tok = slot_tok[u.e * T + (idx < cnt ? idx : 0)];
        return (unsigned)(idx < cnt ? tok : 0) * (unsigned)(K * 2);
    }
    __device__ __forceinline__ const char* bbase(const pg8::Unit& u) const { return (const char*)Bt + (size_t)u.e * estride_bytes + (size_t)u.pn * 256 * K * 2; }
};

template <bool F8>
struct EpiInProjT {
    static constexpr bool PERM = true;
    bf16 *xp, *z, *xbc, *gp, *gs; float* dt;
    __device__ __forceinline__ void operator()(const f32x4 (&acc)[2][2][4][2], const pg8::Unit& u, int wr, int wc, int fr, int fq) const {
        const int row0 = u.pm * 256 + wr * 64 + fr, pn = u.pn;
        if (pn == 64) {
            if (wc < 2) {
#pragma unroll
                for (int ai = 0; ai < 2; ++ai)
#pragma unroll
                    for (int m = 0; m < 4; ++m) { float* p = dt + (size_t)(row0 + ai * 128 + m * 16) * 64 + wc * 32 + 8 * fq; *(f32x4*)p = acc[ai][0][m][0]; *(f32x4*)(p + 4) = acc[ai][0][m][1]; }
            }
            return;
        }
        bf16* base; int ldc, colt;
        if (pn < 8) { base = xp; ldc = 2048; colt = pn * 256; } else if (pn < 24) { base = z; ldc = 4096; colt = (pn - 8) * 256; } else if (pn < 48) { base = xbc; ldc = 6144; colt = (pn - 24) * 256; }
        else if (pn < 56) { base = gp; ldc = 2048; colt = (pn - 48) * 256; } else { base = gs; ldc = 2048; colt = (pn - 56) * 256; }
        const int col0 = colt + wc * 32 + 8 * fq;
#pragma unroll
        for (int ai = 0; ai < 2; ++ai)
#pragma unroll
            for (int m = 0; m < 4; ++m) { bf16* rowp = base + (size_t)(row0 + ai * 128 + m * 16) * ldc + col0;
#pragma unroll
                for (int bj = 0; bj < 2; ++bj) { constexpr float sc = F8 ? 1.0f / 32.0f : 1.0f; const f32x4 v0 = acc[ai][bj][m][0] * sc, v1 = acc[ai][bj][m][1] * sc;
                    u32x4 w; w.x = cvt_pk_bf16(v0[0], v0[1]); w.y = cvt_pk_bf16(v0[2], v0[3]); w.z = cvt_pk_bf16(v1[0], v1[1]); w.w = cvt_pk_bf16(v1[2], v1[3]);
                    *(u32x4*)(rowp + bj * 128) = w; } }
    }
};
typedef EpiInProjT<false> EpiInProj;
struct EpiPool {
    static constexpr bool PERM = true;
    bf16* merged; const bf16* gp; const float* ps;
    __device__ __forceinline__ void operator()(const f32x4 (&acc)[2][2][4][2], const pg8::Unit& u, int wr, int wc, int fr, int fq) const {
        const int row0 = u.pm * 256 + wr * 64 + fr, col0 = u.e * 512 + u.pn * 256 + wc * 32 + 8 * fq;
        f32x4 sv[2][2];
#pragma unroll
        for (int bj = 0; bj < 2; ++bj)
#pragma unroll
            for (int n = 0; n < 2; ++n) sv[bj][n] = *(const f32x4*)(ps + col0 + bj * 128 + 4 * n);
#pragma unroll
        for (int ai = 0; ai < 2; ++ai) {
            u32x4 gq[4][2];
#pragma unroll
            for (int m = 0; m < 4; ++m)
#pragma unroll
                for (int bj = 0; bj < 2; ++bj) gq[m][bj] = *(const u32x4*)(gp + (size_t)(row0 + ai * 128 + m * 16) * 2048 + col0 + bj * 128);
#pragma unroll
            for (int m = 0; m < 4; ++m) { const size_t ro = (size_t)(row0 + ai * 128 + m * 16) * 2048 + col0;
#pragma unroll
                for (int bj = 0; bj < 2; ++bj) { const u32x4 g = gq[m][bj];
                    const f32x4 v0 = acc[ai][bj][m][0] * sv[bj][0], v1 = acc[ai][bj][m][1] * sv[bj][1];
                    u32x4 w; w.x = cvt_pk_bf16(v0[0] * sigmoidf_(bflo(g.x)), v0[1] * sigmoidf_(bfhi(g.x))); w.y = cvt_pk_bf16(v0[2] * sigmoidf_(bflo(g.y)), v0[3] * sigmoidf_(bfhi(g.y)));
                    w.z = cvt_pk_bf16(v1[0] * sigmoidf_(bflo(g.z)), v1[1] * sigmoidf_(bfhi(g.z))); w.w = cvt_pk_bf16(v1[2] * sigmoidf_(bflo(g.w)), v1[3] * sigmoidf_(bfhi(g.w)));
                    *(u32x4*)(merged + ro + bj * 128) = w; } } }
    }
};
struct EpiSsdOut {
    static constexpr bool PERM = true;
    bf16* merged; const bf16* gs;
    __device__ __forceinline__ void operator()(const f32x4 (&acc)[2][2][4][2], const pg8::Unit& u, int wr, int wc, int fr, int fq) const {
        const int row0 = u.pm * 256 + wr * 64 + fr, col0 = u.pn * 256 + wc * 32 + 8 * fq;
#pragma unroll
        for (int ai = 0; ai < 2; ++ai) {
            u32x4 gq[4][2], pq[4][2];
#pragma unroll
            for (int m = 0; m < 4; ++m)
#pragma unroll
                for (int bj = 0; bj < 2; ++bj) { const size_t ro = (size_t)(row0 + ai * 128 + m * 16) * 2048 + col0 + bj * 128; gq[m][bj] = *(const u32x4*)(gs + ro); pq[m][bj] = *(const u32x4*)(merged + ro); }
#pragma unroll
            for (int m = 0; m < 4; ++m) { const size_t ro = (size_t)(row0 + ai * 128 + m * 16) * 2048 + col0;
#pragma unroll
                for (int bj = 0; bj < 2; ++bj) { const u32x4 g = gq[m][bj]; const u32x4 p = pq[m][bj];
                    const f32x4 v0 = acc[ai][bj][m][0], v1 = acc[ai][bj][m][1];
                    u32x4 w; w.x = cvt_pk_bf16(v0[0] * sigmoidf_(bflo(g.x)) + bflo(p.x), v0[1] * sigmoidf_(bfhi(g.x)) + bfhi(p.x)); w.y = cvt_pk_bf16(v0[2] * sigmoidf_(bflo(g.y)) + bflo(p.y), v0[3] * sigmoidf_(bfhi(g.y)) + bfhi(p.y));
                    w.z = cvt_pk_bf16(v1[0] * sigmoidf_(bflo(g.z)) + bflo(p.z), v1[1] * sigmoidf_(bfhi(g.z)) + bfhi(p.z)); w.w = cvt_pk_bf16(v1[2] * sigmoidf_(bflo(g.w)) + bflo(p.w), v1[3] * sigmoidf_(bfhi(g.w)) + bfhi(p.w));
                    *(u32x4*)(merged + ro + bj * 128) = w; } } }
    }
};
struct EpiWout {
    static constexpr bool PERM = true;
    const float* x; bf16* h1;
    __device__ __forceinline__ void operator()(const f32x4 (&acc)[2][2][4][2], const pg8::Unit& u, int wr, int wc, int fr, int fq) const {
        const int row0 = u.pm * 256 + wr * 64 + fr, col0 = u.pn * 256 + wc * 32 + 8 * fq;
#pragma unroll
        for (int ai = 0; ai < 2; ++ai) {
            f32x4 xq[4][2][2];
#pragma unroll
            for (int m = 0; m < 4; ++m)
#pragma unroll
                for (int bj = 0; bj < 2; ++bj)
#pragma unroll
                    for (int n = 0; n < 2; ++n) xq[m][bj][n] = *(const f32x4*)(x + (size_t)(row0 + ai * 128 + m * 16) * 2048 + col0 + bj * 128 + n * 4);
#pragma unroll
            for (int m = 0; m < 4; ++m) { const size_t ro = (size_t)(row0 + ai * 128 + m * 16) * 2048 + col0;
#pragma unroll
                for (int bj = 0; bj < 2; ++bj) { const f32x4 v0 = xq[m][bj][0] + acc[ai][bj][m][0], v1 = xq[m][bj][1] + acc[ai][bj][m][1];
                    u32x4 w; w.x = cvt_pk_bf16(v0[0], v0[1]); w.y = cvt_pk_bf16(v0[2], v0[3]); w.z = cvt_pk_bf16(v1[0], v1[1]); w.w = cvt_pk_bf16(v1[2], v1[3]);
                    *(u32x4*)(h1 + ro + bj * 128) = w; } } }
    }
};
constexpr float WSC = MOE_FP8 ? 1.0f / 32.0f : 1.0f;
__device__ __forceinline__ float swiglu_(float glu, float lin) { glu = fminf(glu, 7.0f); lin = fminf(fmaxf(lin, -7.0f), 7.0f); return glu * sigmoidf_(1.702f * glu) * (lin + 1.0f); }
struct EpiUp {
    static constexpr bool PERM = true;
    uchar* act; const float* b_up;
    __device__ __forceinline__ void operator()(const f32x4 (&acc)[2][2][4][2], const pg8::Unit& u, int wr, int wc, int fr, int fq) const {
        const int row0 = u.pm * 256 + wr * 64 + fr, col0 = u.pn * 128 + wc * 32 + 8 * fq;
        const float* bb = b_up + (size_t)u.e * 4096 + col0;
        const f32x4 bg0 = *(const f32x4*)bb, bg1 = *(const f32x4*)(bb + 4), bl0 = *(const f32x4*)(bb + 2048), bl1 = *(const f32x4*)(bb + 2052);
#pragma unroll
        for (int ai = 0; ai < 2; ++ai)
#pragma unroll
            for (int m = 0; m < 4; ++m) {
                const f32x4 g0 = acc[ai][0][m][0] * WSC + bg0, g1 = acc[ai][0][m][1] * WSC + bg1, l0 = acc[ai][1][m][0] * WSC + bl0, l1 = acc[ai][1][m][1] * WSC + bl1;
                if constexpr (MOE_FP8) { u32x2 w; w.x = cvt4_fp8(swiglu_(g0[0], l0[0]), swiglu_(g0[1], l0[1]), swiglu_(g0[2], l0[2]), swiglu_(g0[3], l0[3]));
                    w.y = cvt4_fp8(swiglu_(g1[0], l1[0]), swiglu_(g1[1], l1[1]), swiglu_(g1[2], l1[2]), swiglu_(g1[3], l1[3]));
                    *(u32x2*)(act + (size_t)(row0 + ai * 128 + m * 16) * 2048 + col0) = w; }
                else { u32x4 w; w.x = cvt_pk_bf16(swiglu_(g0[0], l0[0]), swiglu_(g0[1], l0[1])); w.y = cvt_pk_bf16(swiglu_(g0[2], l0[2]), swiglu_(g0[3], l0[3]));
                    w.z = cvt_pk_bf16(swiglu_(g1[0], l1[0]), swiglu_(g1[1], l1[1])); w.w = cvt_pk_bf16(swiglu_(g1[2], l1[2]), swiglu_(g1[3], l1[3]));
                    *(u32x4*)((bf16*)act + (size_t)(row0 + ai * 128 + m * 16) * 2048 + col0) = w; } }
    }
};
constexpr float YBS = 8.0f;
struct EpiDown {
    static constexpr bool PERM = true;
    uchar* yb; const float* b_down;
    __device__ __forceinline__ void operator()(const f32x4 (&acc)[2][2][4][2], const pg8::Unit& u, int wr, int wc, int fr, int fq) const {
        const int row0 = u.pm * 256 + wr * 64 + fr, col0 = u.pn * 256 + wc * 32 + 8 * fq;
        const float* bb = b_down + (size_t)u.e * 2048 + col0;
        f32x4 bv[2][2];
#pragma unroll
        for (int bj = 0; bj < 2; ++bj)
#pragma unroll
            for (int n = 0; n < 2; ++n) bv[bj][n] = *(const f32x4*)(bb + bj * 128 + 4 * n) * YBS;
#pragma unroll
        for (int ai = 0; ai < 2; ++ai)
#pragma unroll
            for (int m = 0; m < 4; ++m) { uchar* rowp = yb + (size_t)(row0 + ai * 128 + m * 16) * 2048 + col0;
#pragma unroll
                for (int bj = 0; bj < 2; ++bj) { const f32x4 v0 = acc[ai][bj][m][0] * (WSC * YBS) + bv[bj][0], v1 = acc[ai][bj][m][1] * (WSC * YBS) + bv[bj][1];
                    u32x2 w; w.x = cvt4_fp8(v0[0], v0[1], v0[2], v0[3]); w.y = cvt4_fp8(v1[0], v1[1], v1[2], v1[3]);
                    *(u32x2*)(rowp + bj * 128) = w; } }
    }
};

__device__ __forceinline__ int hperm(int p) { return 32 * (p >> 5) + 8 * ((p >> 2) & 3) + 4 * ((p >> 4) & 1) + (p & 3); }
template <int MODE = 0>
__device__ __forceinline__ void tr_item(const float* W, int ldw, int k0, int n0, bf16* dst, int K, LAS float* scr, int lane) {
    const int kq = lane >> 4, n4 = (lane & 15) * 4;
    f32x4 v[16];
#pragma unroll
    for (int i = 0; i < 16; ++i) v[i] = __builtin_nontemporal_load((const f32x4*)(W + (size_t)(k0 + 4 * i + kq) * ldw + n0 + n4));
#pragma unroll
    for (int i = 0; i < 16; ++i) { LAS float* s = scr + (4 * i + kq) * 65 + n4; s[0] = v[i][0]; s[1] = v[i][1]; s[2] = v[i][2]; s[3] = v[i][3]; }
    LDS_WAIT();
    const int c = lane & 7, nn = lane >> 3;
#pragma unroll
    for (int i = 0; i < 8; ++i) { const int n = nn + 8 * i; const LAS float* s = scr + (8 * c) * 65 + n;
        u32x4 o; o.x = cvt_pk_bf16(s[0], s[65]); o.y = cvt_pk_bf16(s[130], s[195]); o.z = cvt_pk_bf16(s[260], s[325]); o.w = cvt_pk_bf16(s[390], s[455]);
        if (MODE == 2) { bf16* p = dst + (size_t)n * K + hperm(8 * c); *(u32x2*)p = (u32x2){o.x, o.y}; *(u32x2*)(p + 8) = (u32x2){o.z, o.w}; }
        else *(u32x4*)(dst + (size_t)(MODE == 1 ? hperm(n) : n) * K + 8 * c) = o; }
    LDS_WAIT();
}
__device__ __forceinline__ void tr_item_fp8(const float* W, int ldw, int k0, int n0, uchar* dst, int K, LAS float* scr, int lane) {
    const int kq = lane >> 4, n4 = (lane & 15) * 4;
    f32x4 v[16];
#pragma unroll
    for (int i = 0; i < 16; ++i) v[i] = __builtin_nontemporal_load((const f32x4*)(W + (size_t)(k0 + 4 * i + kq) * ldw + n0 + n4));
#pragma unroll
    for (int i = 0; i < 16; ++i) { LAS float* s = scr + (4 * i + kq) * 65 + n4; s[0] = v[i][0]; s[1] = v[i][1]; s[2] = v[i][2]; s[3] = v[i][3]; }
    LDS_WAIT();
    const int c = lane & 3, nn = lane >> 2;
#pragma unroll
    for (int i = 0; i < 4; ++i) { const int n = nn + 16 * i; const LAS float* s = scr + (16 * c) * 65 + n;
        u32x4 o; o.x = cvt4_fp8(s[0] * 32.f, s[65] * 32.f, s[130] * 32.f, s[195] * 32.f); o.y = cvt4_fp8(s[260] * 32.f, s[325] * 32.f, s[390] * 32.f, s[455] * 32.f);
        o.z = cvt4_fp8(s[520] * 32.f, s[585] * 32.f, s[650] * 32.f, s[715] * 32.f); o.w = cvt4_fp8(s[780] * 32.f, s[845] * 32.f, s[910] * 32.f, s[975] * 32.f);
        *(u32x4*)(dst + (size_t)n * K + 16 * c) = o; }
    LDS_WAIT();
}
__device__ __forceinline__ void rms_row_bf16(const f32x4 (&v)[8], const f32x4 (&wv)[8], bf16* orow, uchar* orow8, int lane) {
    float s = 0.f;
#pragma unroll
    for (int j = 0; j < 8; ++j) s += (v[j][0] * v[j][0] + v[j][1] * v[j][1]) + (v[j][2] * v[j][2] + v[j][3] * v[j][3]);
    const float rstd = rsqrtf(wave_sum(s) * (1.f / D) + EPS);
#pragma unroll
    for (int j = 0; j < 8; ++j) { const float a0 = v[j][0] * rstd * wv[j][0], a1 = v[j][1] * rstd * wv[j][1], a2 = v[j][2] * rstd * wv[j][2], a3 = v[j][3] * rstd * wv[j][3];
        u32x2 o; o.x = cvt_pk_bf16(a0, a1); o.y = cvt_pk_bf16(a2, a3);
        *(u32x2*)(orow + 4 * (lane + 64 * j)) = o; *(unsigned*)(orow8 + 4 * (lane + 64 * j)) = cvt4_fp8(a0, a1, a2, a3); }
}
template <int PART>
__device__ __forceinline__ void p0_convert(Frame& F, int gw, int NGW) {
    LAS float* scr = (LAS float*)(F.lds + F.wave * 16640);
    constexpr int I_IN = 32 * 257, I_POOL = 4 * 64, I_SSD = 64 * 32, I_OUT = 32 * 32, I_UP = 32 * 32 * 64, I_DOWN = 32 * 32 * 32;
    constexpr int NEARLY = I_IN + I_POOL + I_SSD + I_OUT, NITEMS = NEARLY + I_UP + I_DOWN;
    constexpr int IT0 = PART == 1 ? I_IN : 0, IT1 = PART == 0 ? I_IN : (PART == 3 ? NITEMS : NEARLY);
    for (int it = IT0 + gw; it < IT1; it += NGW) {
        int r = it;
        if (r < I_IN) { const int kb = r / 257, nb = r % 257, n0 = nb * 64; const int r0 = n0 < 12288 ? n0 : (n0 == 12288 ? 16384 : n0 - 64);
            if (n0 >= 2048 && n0 < 6144) tr_item<1>(F.w_in, INCOLS, kb * 64, n0, WSP(bf16, WS_WIN) + (size_t)r0 * 2048 + kb * 64, 2048, scr, F.lane);
            else if (n0 >= 12352) tr_item_fp8(F.w_in, INCOLS, kb * 64, n0, WSP(uchar, WS_WIN8) + (size_t)(n0 - 12352) * 2048 + kb * 64, 2048, scr, F.lane);
            else tr_item(F.w_in, INCOLS, kb * 64, n0, WSP(bf16, WS_WIN) + (size_t)r0 * 2048 + kb * 64, 2048, scr, F.lane);
            continue; } r -= I_IN;
        if (r < I_POOL) { const int g = r >> 6, kb = (r >> 3) & 7, nb = r & 7;
            tr_item(F.w_pool + (size_t)g * 512 * 512, 512, kb * 64, nb * 64, WSP(bf16, WS_WPOOL) + (size_t)(g * 512 + nb * 64) * 512 + kb * 64, 512, scr, F.lane); continue; } r -= I_POOL;
        if (r < I_SSD) { const int kb = r >> 5, nb = r & 31;
            tr_item<2>(F.w_ssd_out, 2048, kb * 64, nb * 64, WSP(bf16, WS_WSSD) + (size_t)(nb * 64) * 4096 + kb * 64, 4096, scr, F.lane); continue; } r -= I_SSD;
        if (r < I_OUT) { const int kb = r >> 5, nb = r & 31;
            tr_item(F.w_out, 2048, kb * 64, nb * 64, WSP(bf16, WS_WOUT) + (size_t)(nb * 64) * 2048 + kb * 64, 2048, scr, F.lane); continue; } r -= I_OUT;
        if (r < I_UP) { const int e = r >> 11, kb = (r >> 6) & 31, nb = r & 63, n0 = nb * 64; const int j = n0 & 2047; const int r0 = 256 * (j >> 7) + (n0 >= 2048 ? 128 : 0) + (j & 127);
            if constexpr (MOE_FP8) tr_item_fp8(F.w_up + (size_t)e * 2048 * 4096, 4096, kb * 64, n0, WSP(uchar, WS_WUP) + ((size_t)e * 4096 + r0) * 2048 + kb * 64, 2048, scr, F.lane);
            else tr_item(F.w_up + (size_t)e * 2048 * 4096, 4096, kb * 64, n0, WSP(bf16, WS_WUP) + ((size_t)e * 4096 + r0) * 2048 + kb * 64, 2048, scr, F.lane);
            continue; } r -= I_UP;
        { const int e = r >> 10, kb = (r >> 5) & 31, nb = r & 31;
            if constexpr (MOE_FP8) tr_item_fp8(F.w_down + (size_t)e * 2048 * 2048, 2048, kb * 64, nb * 64, WSP(uchar, WS_WDOWN) + ((size_t)e * 2048 + nb * 64) * 2048 + kb * 64, 2048, scr, F.lane);
            else tr_item(F.w_down + (size_t)e * 2048 * 2048, 2048, kb * 64, nb * 64, WSP(bf16, WS_WDOWN) + ((size_t)e * 2048 + nb * 64) * 2048 + kb * 64, 2048, scr, F.lane); }
    }
}

struct LateItem { const float* src; uchar* dst; int ldw; };
__device__ __forceinline__ LateItem late_item(Frame& F, int r) {
    constexpr int I_UP = 32 * 32 * 64;
    LateItem L;
    if (r < I_UP) { const int e = r >> 11, kb = (r >> 6) & 31, nb = r & 63, n0 = nb * 64; const int j = n0 & 2047; const int r0 = 256 * (j >> 7) + (n0 >= 2048 ? 128 : 0) + (j & 127);
        L.src = F.w_up + (size_t)e * 2048 * 4096 + (size_t)(kb * 64) * 4096 + n0; L.ldw = 4096; L.dst = WSP(uchar, WS_WUP) + ((size_t)e * 4096 + r0) * 2048 + kb * 64; }
    else { r -= I_UP; const int e = r >> 10, kb = (r >> 5) & 31, nb = r & 31;
        L.src = F.w_down + (size_t)e * 2048 * 2048 + (size_t)(kb * 64) * 2048 + nb * 64; L.ldw = 2048; L.dst = WSP(uchar, WS_WDOWN) + ((size_t)e * 2048 + nb * 64) * 2048 + kb * 64; }
    return L;
}
#define LATE_LOAD(v, L) do { _Pragma("unroll") for (int i = 0; i < 16; ++i) v[i] = __builtin_nontemporal_load((const f32x4*)((L).src + (size_t)(4 * i + (lane >> 4)) * (L).ldw + (lane & 15) * 4)); } while (0)
#define LATE_PROC(v, L) do { _Pragma("unroll") for (int i = 0; i < 16; ++i) { LAS float* s_ = scr + (4 * i + (lane >> 4)) * 65 + (lane & 15) * 4; s_[0] = v[i][0]; s_[1] = v[i][1]; s_[2] = v[i][2]; s_[3] = v[i][3]; } \
        LDS_WAIT(); \
        _Pragma("unroll") for (int i = 0; i < 4; ++i) { const int n_ = (lane >> 2) + 16 * i; const LAS float* s_ = scr + (16 * (lane & 3)) * 65 + n_; \
            u32x4 o_; o_.x = cvt4_fp8(s_[0] * 32.f, s_[65] * 32.f, s_[130] * 32.f, s_[195] * 32.f); o_.y = cvt4_fp8(s_[260] * 32.f, s_[325] * 32.f, s_[390] * 32.f, s_[455] * 32.f); \
            o_.z = cvt4_fp8(s_[520] * 32.f, s_[585] * 32.f, s_[650] * 32.f, s_[715] * 32.f); o_.w = cvt4_fp8(s_[780] * 32.f, s_[845] * 32.f, s_[910] * 32.f, s_[975] * 32.f); \
            __builtin_nontemporal_store(o_, (u32x4*)((L).dst + (size_t)n_ * 2048 + 16 * (lane & 3))); } \
        LDS_WAIT(); } while (0)
__device__ __forceinline__ void p1_convert_late(Frame& F, int gw, int NGW) {
    static_assert(MOE_FP8, "pipelined converter writes e4m3");
    LAS float* scr = (LAS float*)(F.lds + F.wave * 16640);
    const int lane = F.lane;
    constexpr int NLATE = 32 * 32 * 64 + 32 * 32 * 32;
    f32x4 va[16], vb[16];
    int it = gw; LateItem La, Lb;
    if (it < NLATE) { La = late_item(F, it); LATE_LOAD(va, La); }
    while (it < NLATE) {
        const int it2 = it + NGW; if (it2 < NLATE) { Lb = late_item(F, it2); LATE_LOAD(vb, Lb); }
        LATE_PROC(va, La);
        const int it3 = it2 + NGW; if (it3 < NLATE) { La = late_item(F, it3); LATE_LOAD(va, La); }
        if (it2 < NLATE) LATE_PROC(vb, Lb);
        it = it3;
    }
}
#undef LATE_LOAD
#undef LATE_PROC
__device__ __forceinline__ void p0_prologue(Frame& F, bool with_late) {
    const int gw = blockIdx.x * NWAVES + F.wave, NGW = F.G * NWAVES;
    if (with_late) p0_convert<3>(F, gw, NGW); else p0_convert<0>(F, gw, NGW);
    { u32x4* pad = (u32x4*)(WSP(bf16, WS_WIN) + (size_t)INCOLS * 2048); const int n16 = (NPAD - INCOLS) * 2048 * 2 / 16;
      for (int i = blockIdx.x * 512 + F.tid; i < n16; i += F.G * 512) pad[i] = (u32x4){0u, 0u, 0u, 0u}; }
    f32x4 wv[8];
#pragma unroll
    for (int j = 0; j < 8; ++j) wv[j] = *(const f32x4*)(F.norm_mix_w + 4 * (F.lane + 64 * j));
    f32x4 va[8], vb[8];
    for (int m = gw; m < T; m += 2 * NGW) {
#pragma unroll
        for (int j = 0; j < 8; ++j) va[j] = __builtin_nontemporal_load((const f32x4*)(F.x + (size_t)m * D + 4 * (F.lane + 64 * j)));
        const int m2 = m + NGW;
        if (m2 < T) {
#pragma unroll
            for (int j = 0; j < 8; ++j) vb[j] = __builtin_nontemporal_load((const f32x4*)(F.x + (size_t)m2 * D + 4 * (F.lane + 64 * j))); }
        rms_row_bf16(va, wv, WSP(bf16, WS_U) + (size_t)m * D, WSP(uchar, WS_U8) + (size_t)m * D, F.lane);
        if (m2 < T) rms_row_bf16(vb, wv, WSP(bf16, WS_U) + (size_t)m2 * D, WSP(uchar, WS_U8) + (size_t)m2 * D, F.lane);
    }
}

constexpr int LDP = 136;
constexpr int SOFF_DTS = 0, SOFF_ACS = 4096, SOFF_T0 = 8192;
struct Conv2Regs { u32x4 v[2][7]; f32x4 w[2][4][2]; f32x4 bb[2][2]; };
__device__ __forceinline__ void conv2_load(Frame& F, int tbase, int pos0, int chA, int chB, Conv2Regs& R) {
    const int nb = F.tid & 15, r4 = F.tid >> 4;
    const bf16* xbc = WSP(const bf16, WS_XBC);
    const bool ok0 = pos0 + 4 * r4 - 3 >= 0;
#pragma unroll
    for (int t = 0; t < 2; ++t) { const int ch = (t ? chB : chA) + 8 * nb;
#pragma unroll
        for (int q = 0; q < 7; ++q) { const int rr = 4 * r4 - 3 + q; R.v[t][q] = *(const u32x4*)(xbc + (size_t)(tbase + ((q >= 3 || ok0) ? rr : 0)) * XBCW + ch); }
#pragma unroll
        for (int k = 0; k < 4; ++k) { R.w[t][k][0] = *(const f32x4*)(F.conv_w + (size_t)k * XBCW + ch); R.w[t][k][1] = *(const f32x4*)(F.conv_w + (size_t)k * XBCW + ch + 4); }
        R.bb[t][0] = *(const f32x4*)(F.conv_b + ch); R.bb[t][1] = *(const f32x4*)(F.conv_b + ch + 4); }
}
__device__ __forceinline__ void conv2_store(Frame& F, int pos0, Conv2Regs& R, LAS bf16* dstA, LAS bf16* dstB) {
    const int nb = F.tid & 15, r4 = F.tid >> 4;
#pragma unroll
    for (int t = 0; t < 2; ++t) {
#pragma unroll
        for (int q = 0; q < 3; ++q) { const bool ok = pos0 + 4 * r4 - 3 + q >= 0; R.v[t][q].x = ok ? R.v[t][q].x : 0u; R.v[t][q].y = ok ? R.v[t][q].y : 0u; R.v[t][q].z = ok ? R.v[t][q].z : 0u; R.v[t][q].w = ok ? R.v[t][q].w : 0u; }
        LAS bf16* dst = t ? dstB : dstA;
#pragma unroll
        for (int i = 0; i < 4; ++i) {
            f32x4 a0 = R.bb[t][0], a1 = R.bb[t][1];
#pragma unroll
            for (int k = 0; k < 4; ++k) { const u32x4 x = R.v[t][i + k];
                a0[0] += R.w[t][k][0][0] * bflo(x.x); a0[1] += R.w[t][k][0][1] * bfhi(x.x); a0[2] += R.w[t][k][0][2] * bflo(x.y); a0[3] += R.w[t][k][0][3] * bfhi(x.y);
                a1[0] += R.w[t][k][1][0] * bflo(x.z); a1[1] += R.w[t][k][1][1] * bfhi(x.z); a1[2] += R.w[t][k][1][2] * bflo(x.w); a1[3] += R.w[t][k][1][3] * bfhi(x.w); }
            u32x4 o; o.x = cvt_pk_bf16(siluf_(a0[0]), siluf_(a0[1])); o.y = cvt_pk_bf16(siluf_(a0[2]), siluf_(a0[3])); o.z = cvt_pk_bf16(siluf_(a1[0]), siluf_(a1[1])); o.w = cvt_pk_bf16(siluf_(a1[2]), siluf_(a1[3]));
            *(LAS u32x4*)(dst + (4 * r4 + i) * LDP + 8 * nb) = o;
        }
    }
}
__device__ __forceinline__ void dt2_load(Frame& F, int tbase, int g, float (&raw)[4]) {
    const int h = 8 * g + F.wave; const float* dtp = WSP(const float, WS_DT);
    raw[0] = dtp[(size_t)(tbase + F.lane) * 64 + h]; raw[1] = dtp[(size_t)(tbase + F.lane + 64) * 64 + h]; raw[2] = F.dt_bias[h]; raw[3] = F.a_log[h];
}
__device__ __forceinline__ void dt2_store(Frame& F, const float (&raw)[4]) {
    LAS float* dts = (LAS float*)(F.lds + SOFF_DTS); LAS float* acs = (LAS float*)(F.lds + SOFF_ACS);
    const int j = F.wave, lane = F.lane; const float bias = raw[2], a = -__expf(raw[3]);
    float carry = 0.f;
#pragma unroll
    for (int half = 0; half < 2; ++half) {
        const int s = lane + 64 * half; const float r = raw[half] + bias;
        const float dtv = r > 20.f ? r : log1pf(__expf(r));
        float v = dtv * a;
#pragma unroll
        for (int o = 1; o < 64; o <<= 1) { const float u = __shfl_up(v, o); if (lane >= o) v += u; }
        v += carry; carry = __shfl(v, 63);
        dts[j * 128 + s] = dtv; acs[j * 128 + s] = v;
    }
}
__device__ __forceinline__ void cpair_load_s(Frame& F, int tbase, int pos0, int chg, int sb, unsigned (&u)[11]) {
    const bf16* xbc = WSP(const bf16, WS_XBC);
    const bool ok0 = pos0 + 8 * sb - 3 >= 0;
#pragma unroll
    for (int q = 0; q < 11; ++q) { const int rr = 8 * sb - 3 + q; u[q] = *(const unsigned*)(xbc + (size_t)(tbase + ((q >= 3 || ok0) ? rr : 0)) * XBCW + chg); }
}
__device__ __forceinline__ void cpair_fix(int pos0, int sb, unsigned (&u)[11]) {
#pragma unroll
    for (int q = 0; q < 3; ++q) u[q] = (pos0 + 8 * sb - 3 + q >= 0) ? u[q] : 0u;
}
__device__ __forceinline__ void cpair_loadw(Frame& F, int chg, f32x2 (&xw)[5]) {
#pragma unroll
    for (int k = 0; k < 4; ++k) xw[k] = *(const f32x2*)(F.conv_w + (size_t)k * XBCW + chg);
    xw[4] = *(const f32x2*)(F.conv_b + chg);
}
template <int MODE>
__device__ __forceinline__ void cpair_store_w(int chl, int sb, LAS bf16* dst, const unsigned (&u)[11], const f32x2 (&xw)[5], const LAS float* dts, const LAS float* acs, float aend) {
    float o0[8], o1[8];
#pragma unroll
    for (int i = 0; i < 8; ++i) { float a0 = xw[4][0], a1 = xw[4][1];
#pragma unroll
        for (int k = 0; k < 4; ++k) { a0 += xw[k][0] * bflo(u[i + k]); a1 += xw[k][1] * bfhi(u[i + k]); }
        float sc = 1.f;
        if (MODE >= 1) { const int s = 8 * sb + i; sc = dts[s]; if (MODE == 2) sc *= __expf(aend - acs[s]); }
        o0[i] = siluf_(a0) * sc; o1[i] = siluf_(a1) * sc; }
    u32x4 p0, p1; p0.x = cvt_pk_bf16(o0[0], o0[1]); p0.y = cvt_pk_bf16(o0[2], o0[3]); p0.z = cvt_pk_bf16(o0[4], o0[5]); p0.w = cvt_pk_bf16(o0[6], o0[7]);
    p1.x = cvt_pk_bf16(o1[0], o1[1]); p1.y = cvt_pk_bf16(o1[2], o1[3]); p1.z = cvt_pk_bf16(o1[4], o1[5]); p1.w = cvt_pk_bf16(o1[6], o1[7]);
    *(LAS u32x4*)(dst + chl * LDP + 8 * sb) = p0; *(LAS u32x4*)(dst + (chl + 1) * LDP + 8 * sb) = p1;
}
struct ConvT2Regs { unsigned u[2][11]; f32x2 w[5]; };
__device__ __forceinline__ void convT2_load(Frame& F, int tbase, int pos0, int chg, ConvT2Regs& R) {
    const bf16* xbc = WSP(const bf16, WS_XBC);
#pragma unroll
    for (int it = 0; it < 2; ++it) { const int sb = (F.tid >> 6) + 8 * it; const bool ok0 = pos0 + 8 * sb - 3 >= 0;
#pragma unroll
        for (int q = 0; q < 11; ++q) { const int rr = 8 * sb - 3 + q; R.u[it][q] = *(const unsigned*)(xbc + (size_t)(tbase + ((q >= 3 || ok0) ? rr : 0)) * XBCW + chg); } }
#pragma unroll
    for (int k = 0; k < 4; ++k) R.w[k] = *(const f32x2*)(F.conv_w + (size_t)k * XBCW + chg);
    R.w[4] = *(const f32x2*)(F.conv_b + chg);
}
__device__ __forceinline__ void convT2_store(Frame& F, int pos0, int chl, ConvT2Regs& R, LAS bf16* dst) {
#pragma unroll
    for (int it = 0; it < 2; ++it) { const int sb = (F.tid >> 6) + 8 * it;
#pragma unroll
        for (int q = 0; q < 3; ++q) R.u[it][q] = (pos0 + 8 * sb - 3 + q >= 0) ? R.u[it][q] : 0u;
        float o0[8], o1[8];
#pragma unroll
        for (int i = 0; i < 8; ++i) { float a0 = R.w[4][0], a1 = R.w[4][1];
#pragma unroll
            for (int k = 0; k < 4; ++k) { a0 += R.w[k][0] * bflo(R.u[it][i + k]); a1 += R.w[k][1] * bfhi(R.u[it][i + k]); }
            o0[i] = siluf_(a0); o1[i] = siluf_(a1); }
        u32x4 p0, p1; p0.x = cvt_pk_bf16(o0[0], o0[1]); p0.y = cvt_pk_bf16(o0[2], o0[3]); p0.z = cvt_pk_bf16(o0[4], o0[5]); p0.w = cvt_pk_bf16(o0[6], o0[7]);
        p1.x = cvt_pk_bf16(o1[0], o1[1]); p1.y = cvt_pk_bf16(o1[2], o1[3]); p1.z = cvt_pk_bf16(o1[4], o1[5]); p1.w = cvt_pk_bf16(o1[6], o1[7]);
        *(LAS u32x4*)(dst + chl * LDP + 8 * sb) = p0; *(LAS u32x4*)(dst + (chl + 1) * LDP + 8 * sb) = p1; }
}
__device__ __forceinline__ void p2_states_unit(Frame& F, int unit) {
    const int g = unit & 7, c = (unit >> 3) & 63, b = unit >> 9;
    const int tbase = b * SEQ + c * 128, pos0 = c * 128;
    LAS float* dts = (LAS float*)(F.lds + SOFF_DTS); LAS float* acs = (LAS float*)(F.lds + SOFF_ACS);
    LAS bf16* BMT = (LAS bf16*)(F.lds + SOFF_T0);
    LAS bf16* XT0 = BMT + 128 * LDP; LAS bf16* XT1 = XT0 + 64 * LDP;
    const int lane = F.lane, w = F.wave, c16 = lane & 15, q = lane >> 4;
    const int pp = F.tid & 31, sbx = F.tid >> 5;
    unsigned xu[11]; f32x2 xw[5];
    cpair_load_s(F, tbase, pos0, 512 * g + 2 * pp, sbx, xu); cpair_loadw(F, 512 * g + 2 * pp, xw);
    float dtraw[4]; dt2_load(F, tbase, g, dtraw);
    ConvT2Regs cr; convT2_load(F, tbase, pos0, 4096 + 128 * g + 2 * (F.tid & 63), cr);
    __syncthreads();
    dt2_store(F, dtraw);
    convT2_store(F, pos0, 2 * (F.tid & 63), cr, BMT);
    __syncthreads();
    cpair_fix(pos0, sbx, xu); cpair_store_w<2>(2 * pp, sbx, XT0, xu, xw, dts, acs, acs[127]);
    bf16x8 bmf[4];
#pragma unroll
    for (int kk = 0; kk < 4; ++kk) bmf[kk] = *(const LAS bf16x8*)(BMT + (16 * w + c16) * LDP + 32 * kk + 8 * q);
    __syncthreads();
    bf16* states = WSP(bf16, WS_STATES);
    for (int j = 0; j < 8; ++j) {
        LAS bf16* XT = (j & 1) ? XT1 : XT0;
        const float aend = acs[j * 128 + 127];
        if (j < 7) { cpair_load_s(F, tbase, pos0, 512 * g + 64 * (j + 1) + 2 * pp, sbx, xu); cpair_loadw(F, 512 * g + 64 * (j + 1) + 2 * pp, xw); }
        f32x4 acc[4];
#pragma unroll
        for (int pt = 0; pt < 4; ++pt) acc[pt] = (f32x4){0.f, 0.f, 0.f, 0.f};
        { bf16x8 xa[2][4];
#pragma unroll
          for (int pt = 0; pt < 4; ++pt) xa[0][pt] = *(const LAS bf16x8*)(XT + (16 * pt + c16) * LDP + 8 * q);
#pragma unroll
          for (int kk = 0; kk < 4; ++kk) {
              if (kk < 3) {
#pragma unroll
                  for (int pt = 0; pt < 4; ++pt) xa[(kk + 1) & 1][pt] = *(const LAS bf16x8*)(XT + (16 * pt + c16) * LDP + 32 * (kk + 1) + 8 * q); }
              __builtin_amdgcn_sched_barrier(0);
#pragma unroll
              for (int pt = 0; pt < 4; ++pt) acc[pt] = __builtin_amdgcn_mfma_f32_16x16x32_bf16(bmf[kk], xa[kk & 1][pt], acc[pt], 0, 0, 0);
              __builtin_amdgcn_sched_barrier(0); } }
        const int h = 8 * g + j;
#pragma unroll
        for (int pt = 0; pt < 4; ++pt) { u32x2 o; o.x = cvt_pk_bf16(acc[pt][0], acc[pt][1]); o.y = cvt_pk_bf16(acc[pt][2], acc[pt][3]);
            *(u32x2*)(states + ((((size_t)(b * 64 + c) * 64 + h) * 64 + 16 * pt + c16) * 128 + 16 * w + 4 * q)) = o; }
        if (w == j && lane == 0) WSP(float, WS_CDEC)[(b * 64 + c) * 64 + h] = __expf(aend);
        if (j < 7) { cpair_fix(pos0, sbx, xu); cpair_store_w<2>(2 * pp, sbx, (j & 1) ? XT0 : XT1, xu, xw, dts + (j + 1) * 128, acs + (j + 1) * 128, acs[(j + 1) * 128 + 127]); }
        __syncthreads();
    }
}
template <int W>
__device__ __forceinline__ void pool_item(const bf16* xp, bf16* pooled, int cg, int g, int t0, int p0) {
    u32x4 rows[15 + W];
#pragma unroll
    for (int i = 0; i < 15 + W; ++i) { rows[i] = (u32x4){0u, 0u, 0u, 0u}; const int dq = i - (W - 1); if (p0 + dq >= 0) rows[i] = *(const u32x4*)(xp + (size_t)(t0 + dq) * 2048 + 8 * cg); }
    float S[8];
#pragma unroll
    for (int e = 0; e < 8; ++e) S[e] = 0.f;
#pragma unroll
    for (int i = 0; i < W - 1; ++i) { const u32x4 v = rows[i];
        S[0] += bflo(v.x); S[1] += bfhi(v.x); S[2] += bflo(v.y); S[3] += bfhi(v.y); S[4] += bflo(v.z); S[5] += bfhi(v.z); S[6] += bflo(v.w); S[7] += bfhi(v.w); }
#pragma unroll
    for (int i = 0; i < 16; ++i) {
        const int t = t0 + i, p = p0 + i;
        const u32x4 v = rows[W - 1 + i];
        float xv[8] = {bflo(v.x), bfhi(v.x), bflo(v.y), bfhi(v.y), bflo(v.z), bfhi(v.z), bflo(v.w), bfhi(v.w)};
        const float inv = 1.0f / (float)((p + 1) < W ? (p + 1) : W);
        float o[8];
#pragma unroll
        for (int e = 0; e < 8; ++e) { S[e] += xv[e]; o[e] = S[e] * inv - xv[e]; }
        u32x4 ov; ov.x = cvt_pk_bf16(o[0], o[1]); ov.y = cvt_pk_bf16(o[2], o[3]); ov.z = cvt_pk_bf16(o[4], o[5]); ov.w = cvt_pk_bf16(o[6], o[7]);
        *(u32x4*)(pooled + ((size_t)g * T + t) * 512 + (8 * cg & 511)) = ov;
        const u32x4 u = rows[i];
        S[0] -= bflo(u.x); S[1] -= bfhi(u.x); S[2] -= bflo(u.y); S[3] -= bfhi(u.y); S[4] -= bflo(u.z); S[5] -= bfhi(u.z); S[6] -= bflo(u.w); S[7] -= bfhi(u.w);
    }
}
__device__ __forceinline__ void p2_pool_items(Frame& F) {
    const bf16* xp = WSP(const bf16, WS_XP); bf16* pooled = WSP(bf16, WS_POOLED);
    for (int idx = blockIdx.x * 512 + F.tid; idx < (T / 16) * 256; idx += F.G * 512) {
        const int cg = idx & 255, rb = idx >> 8;
        const int g = __builtin_amdgcn_readfirstlane(cg >> 6);
        const int t0 = rb * 16, p0 = t0 & (SEQ - 1);
        if (g == 0) pool_item<2>(xp, pooled, cg, g, t0, p0); else if (g == 1) pool_item<4>(xp, pooled, cg, g, t0, p0);
        else if (g == 2) pool_item<8>(xp, pooled, cg, g, t0, p0); else pool_item<16>(xp, pooled, cg, g, t0, p0);
    }
}

__device__ __forceinline__ void p3_scan(Frame& F) {
    bf16* states = WSP(bf16, WS_STATES); const float* cdec = WSP(const float, WS_CDEC);
    for (int idx = blockIdx.x * 512 + F.tid; idx < 2 * 64 * 64 * 16; idx += F.G * 512) {
        const int n8 = idx & 15, p = (idx >> 4) & 63, h = (idx >> 10) & 63, b = idx >> 16;
        float run[8];
#pragma unroll
        for (int e = 0; e < 8; ++e) run[e] = 0.f;
        for (int c0 = 0; c0 < 64; c0 += 8) {
            u32x4 v[8]; float dec[8];
#pragma unroll
            for (int cc = 0; cc < 8; ++cc) { const int c = c0 + cc; v[cc] = *(const u32x4*)(states + ((((size_t)(b * 64 + c) * 64 + h) * 64 + p) * 128 + 8 * n8)); dec[cc] = cdec[(b * 64 + c) * 64 + h]; }
#pragma unroll
            for (int cc = 0; cc < 8; ++cc) { const int c = c0 + cc;
                u32x4 o; o.x = cvt_pk_bf16(run[0], run[1]); o.y = cvt_pk_bf16(run[2], run[3]); o.z = cvt_pk_bf16(run[4], run[5]); o.w = cvt_pk_bf16(run[6], run[7]);
                *(u32x4*)(states + ((((size_t)(b * 64 + c) * 64 + h) * 64 + p) * 128 + 8 * n8)) = o;
                const float d = dec[cc];
                run[0] = run[0] * d + bflo(v[cc].x); run[1] = run[1] * d + bfhi(v[cc].x); run[2] = run[2] * d + bflo(v[cc].y); run[3] = run[3] * d + bfhi(v[cc].y);
                run[4] = run[4] * d + bflo(v[cc].z); run[5] = run[5] * d + bfhi(v[cc].z); run[6] = run[6] * d + bflo(v[cc].w); run[7] = run[7] * d + bfhi(v[cc].w); }
        }
    }
}

__device__ __forceinline__ void p4_unit(Frame& F, int unit) {
    const int g = unit & 7, c = (unit >> 3) & 63, b = unit >> 9;
    const int tbase = b * SEQ + c * 128, pos0 = c * 128;
    LAS float* dts = (LAS float*)(F.lds + SOFF_DTS); LAS float* acs = (LAS float*)(F.lds + SOFF_ACS);
    LAS bf16* CMs = (LAS bf16*)(F.lds + SOFF_T0);
    LAS bf16* BMs = CMs + 128 * LDP;
    LAS bf16* XT0 = BMs + 128 * LDP; LAS bf16* PV0 = XT0 + 64 * LDP;
    LAS bf16* XT1 = BMs; LAS bf16* PV1 = BMs + 64 * LDP;
    const int lane = F.lane, w = F.wave, c16 = lane & 15, q = lane >> 4;
    const int l = 16 * w + c16;
    const int pp = F.tid & 31, sbx = F.tid >> 5;
    const bf16* zb = WSP(const bf16, WS_Z); const bf16* states = WSP(const bf16, WS_STATES);
    bf16* yg = WSP(bf16, WS_YG);
    LAS u32x4* parkA = (LAS u32x4*)(F.lds + SOFF_T0) + F.tid; LAS u32x4* parkB = (LAS u32x4*)(F.lds + SOFF_T0 + 384 * LDP * 2) + F.tid;
    unsigned xu[11]; u32x4 pvr[2]; f32x2 xw[5];
    const float dskall = F.d_skip[8 * g + (lane & 7)];
    cpair_load_s(F, tbase, pos0, 512 * g + 2 * pp, sbx, xu); cpair_loadw(F, 512 * g + 2 * pp, xw);
    { const bf16* src = states + (((size_t)(b * 64 + c) * 64 + 8 * g) * 64) * 128;
#pragma unroll
      for (int it = 0; it < 2; ++it) { const int i16 = F.tid + 512 * it; pvr[it] = __builtin_nontemporal_load((const u32x4*)(src + (i16 >> 4) * 128 + 8 * (i16 & 15))); } }
    float dtraw[4]; dt2_load(F, tbase, g, dtraw);
    Conv2Regs cr; conv2_load(F, tbase, pos0, 4096 + 1024 + 128 * g, 4096 + 128 * g, cr);
    __syncthreads();
    dt2_store(F, dtraw);
    conv2_store(F, pos0, cr, CMs, BMs);
    __syncthreads();
    bf16x8 cmf[4];
#pragma unroll
    for (int kn = 0; kn < 4; ++kn) cmf[kn] = *(const LAS bf16x8*)(CMs + l * LDP + 32 * kn + 8 * q);
    f32x4 cb[8];
#pragma unroll
    for (int st = 0; st < 8; ++st) { cb[st] = (f32x4){0.f, 0.f, 0.f, 0.f};
        if (st <= w) {
            bf16x8 ba[4];
#pragma unroll
            for (int kn = 0; kn < 4; ++kn) ba[kn] = *(const LAS bf16x8*)(BMs + (16 * st + c16) * LDP + 32 * kn + 8 * q);
            __builtin_amdgcn_sched_barrier(0);
#pragma unroll
            for (int kn = 0; kn < 4; ++kn) cb[st] = __builtin_amdgcn_mfma_f32_16x16x32_bf16(ba[kn], cmf[kn], cb[st], 0, 0, 0); } }
    cpair_fix(pos0, sbx, xu); cpair_store_w<1>(2 * pp, sbx, XT0, xu, xw, dts, acs, 0.f);
#pragma unroll
    for (int it = 0; it < 2; ++it) { const int i16 = F.tid + 512 * it; *(LAS u32x4*)(PV0 + (i16 >> 4) * LDP + 8 * (i16 & 15)) = pvr[it]; }
    __syncthreads();
    float ssq = 0.f;
    for (int j = 0; j < 8; ++j) {
        LAS bf16* XT = (j & 1) ? XT1 : XT0; LAS bf16* PV = (j & 1) ? PV1 : PV0;
        const int h = 8 * g + j;
        u32x4 zq[2];
#pragma unroll
        for (int i = 0; i < 2; ++i) zq[i] = *(const u32x4*)(zb + (size_t)(tbase + l) * ZI + 512 * g + 64 * j + 32 * i + 8 * q);
        const float al = acs[j * 128 + l], dtl = dts[j * 128 + l], dsk = __builtin_bit_cast(float, __builtin_amdgcn_readlane(__builtin_bit_cast(int, dskall), j)) / dtl;
        f32x4 ad[4], ao[4];
#pragma unroll
        for (int pt = 0; pt < 4; ++pt) { ad[pt] = (f32x4){0.f, 0.f, 0.f, 0.f}; ao[pt] = (f32x4){0.f, 0.f, 0.f, 0.f}; }
#pragma unroll
        for (int kk = 0; kk < 4; ++kk) {
            if (32 * kk <= 16 * w + 15) {
                const f32x4 as0 = *(const LAS f32x4*)(acs + j * 128 + 32 * kk + 4 * q), as1 = *(const LAS f32x4*)(acs + j * 128 + 32 * kk + 16 + 4 * q);
                u32x2 xlo[4], xhi[4];
#pragma unroll
                for (int pt = 0; pt < 4; ++pt) { xlo[pt] = *(const LAS u32x2*)(XT + (16 * pt + c16) * LDP + 32 * kk + 4 * q); xhi[pt] = *(const LAS u32x2*)(XT + (16 * pt + c16) * LDP + 32 * kk + 16 + 4 * q); }
                __builtin_amdgcn_sched_barrier(0);
                float mv[8];
                if (32 * kk + 31 <= 16 * w) {
#pragma unroll
                    for (int i = 0; i < 4; ++i) { mv[i] = cb[2 * kk][i] * __expf(al - as0[i]); mv[4 + i] = cb[2 * kk + 1][i] * __expf(al - as1[i]); }
                } else {
#pragma unroll
                    for (int i = 0; i < 4; ++i) { const int s0 = 32 * kk + 4 * q + i, s1 = s0 + 16;
                        float v0 = cb[2 * kk][i] * __expf(fminf(al - as0[i], 0.f)), v1 = cb[2 * kk + 1][i] * __expf(fminf(al - as1[i], 0.f));
                        v0 = (s0 <= l) ? v0 : 0.f; v1 = (s1 <= l) ? v1 : 0.f; if (s0 == l) v0 += dsk; if (s1 == l) v1 += dsk; mv[i] = v0; mv[4 + i] = v1; }
                }
                u32x4 bw; bw.x = cvt_pk_bf16_v(mv[0], mv[1]); bw.y = cvt_pk_bf16_v(mv[2], mv[3]); bw.z = cvt_pk_bf16_v(mv[4], mv[5]); bw.w = cvt_pk_bf16_v(mv[6], mv[7]);
                const bf16x8 bfrag = __builtin_bit_cast(bf16x8, bw);
#pragma unroll
                for (int pt = 0; pt < 4; ++pt) { const u32x2 lo = xlo[pt], hi = xhi[pt];
                    u32x4 aw; aw.x = lo.x; aw.y = lo.y; aw.z = hi.x; aw.w = hi.y;
                    ad[pt] = __builtin_amdgcn_mfma_f32_16x16x32_bf16(__builtin_bit_cast(bf16x8, aw), bfrag, ad[pt], 0, 0, 0); }
            }
        }
        if (j < 7) { cpair_load_s(F, tbase, pos0, 512 * g + 64 * (j + 1) + 2 * pp, sbx, xu); cpair_loadw(F, 512 * g + 64 * (j + 1) + 2 * pp, xw);
            const bf16* src = states + (((size_t)(b * 64 + c) * 64 + h + 1) * 64) * 128;
#pragma unroll
            for (int it = 0; it < 2; ++it) { const int i16 = F.tid + 512 * it; pvr[it] = __builtin_nontemporal_load((const u32x4*)(src + (i16 >> 4) * 128 + 8 * (i16 & 15))); } }
        { bf16x8 pa[2][4];
#pragma unroll
          for (int pt = 0; pt < 4; ++pt) pa[0][pt] = *(const LAS bf16x8*)(PV + (16 * pt + c16) * LDP + 8 * q);
#pragma unroll
          for (int kn = 0; kn < 4; ++kn) {
              if (kn < 3) {
#pragma unroll
                  for (int pt = 0; pt < 4; ++pt) pa[(kn + 1) & 1][pt] = *(const LAS bf16x8*)(PV + (16 * pt + c16) * LDP + 32 * (kn + 1) + 8 * q); }
              __builtin_amdgcn_sched_barrier(0);
#pragma unroll
              for (int pt = 0; pt < 4; ++pt) ao[pt] = __builtin_amdgcn_mfma_f32_16x16x32_bf16(pa[kn & 1][pt], cmf[kn], ao[pt], 0, 0, 0);
              __builtin_amdgcn_sched_barrier(0); } }
        const float eal = __expf(al);
#pragma unroll
        for (int i = 0; i < 2; ++i) { u32x4 oq;
#pragma unroll
            for (int hh = 0; hh < 2; ++hh) { const int pt = 2 * i + hh; const unsigned z01 = hh ? zq[i].z : zq[i].x, z23 = hh ? zq[i].w : zq[i].y;
                const float y0 = (ad[pt][0] + eal * ao[pt][0]) * siluf_(bflo(z01)), y1 = (ad[pt][1] + eal * ao[pt][1]) * siluf_(bfhi(z01));
                const float y2 = (ad[pt][2] + eal * ao[pt][2]) * siluf_(bflo(z23)), y3 = (ad[pt][3] + eal * ao[pt][3]) * siluf_(bfhi(z23));
                ssq += (y0 * y0 + y1 * y1) + (y2 * y2 + y3 * y3);
                if (hh) { oq.z = cvt_pk_bf16(y0, y1); oq.w = cvt_pk_bf16(y2, y3); } else { oq.x = cvt_pk_bf16(y0, y1); oq.y = cvt_pk_bf16(y2, y3); } }
            if (j < 4) ((j < 2) ? parkA : parkB)[((j & 1) * 2 + i) * 512] = oq;
            else *(u32x4*)(yg + (size_t)(tbase + l) * ZI + 512 * g + 64 * j + 32 * i + 8 * q) = oq; }

        if (j < 7) { cpair_fix(pos0, sbx, xu); cpair_store_w<1>(2 * pp, sbx, (j & 1) ? XT0 : XT1, xu, xw, dts + (j + 1) * 128, acs + (j + 1) * 128, 0.f);
            LAS bf16* PVn = (j & 1) ? PV0 : PV1;
#pragma unroll
            for (int it = 0; it < 2; ++it) { const int i16 = F.tid + 512 * it; *(LAS u32x4*)(PVn + (i16 >> 4) * LDP + 8 * (i16 & 15)) = pvr[it]; } }
        __syncthreads();
    }
    ssq += __shfl_xor(ssq, 16); ssq += __shfl_xor(ssq, 32);
    const float rstd = rsqrtf(ssq * (1.f / 512.f) + EPS);
#define Y_RESCALE(J0, LOADV) do { u32x4 v[8]; f32x4 nw[16]; \
        _Pragma("unroll") for (int i = 0; i < 8; ++i) { const int ch = 512 * g + 64 * ((J0) + (i >> 1)) + 32 * (i & 1); nw[2 * i] = *(const f32x4*)(F.ssd_norm_w + ch + 4 * q); nw[2 * i + 1] = *(const f32x4*)(F.ssd_norm_w + ch + 16 + 4 * q); v[i] = LOADV; } \
        _Pragma("unroll") for (int i = 0; i < 8; ++i) { const int ch = 512 * g + 64 * ((J0) + (i >> 1)) + 32 * (i & 1); u32x4 o; \
            o.x = cvt_pk_bf16(bflo(v[i].x) * rstd * nw[2 * i][0], bfhi(v[i].x) * rstd * nw[2 * i][1]); o.y = cvt_pk_bf16(bflo(v[i].y) * rstd * nw[2 * i][2], bfhi(v[i].y) * rstd * nw[2 * i][3]); \
            o.z = cvt_pk_bf16(bflo(v[i].z) * rstd * nw[2 * i + 1][0], bfhi(v[i].z) * rstd * nw[2 * i + 1][1]); o.w = cvt_pk_bf16(bflo(v[i].w) * rstd * nw[2 * i + 1][2], bfhi(v[i].w) * rstd * nw[2 * i + 1][3]); \
            *(u32x4*)(yg + (size_t)(tbase + l) * ZI + ch + 8 * q) = o; } } while (0)
    Y_RESCALE(0, (((i < 4) ? parkA : parkB)[(((i >> 1) & 1) * 2 + (i & 1)) * 512]));
    asm volatile("s_waitcnt vmcnt(0)" ::: "memory");
    Y_RESCALE(4, (*(const u32x4*)(yg + (size_t)(tbase + l) * ZI + ch + 8 * q)));
#undef Y_RESCALE
}


constexpr int UTP = 2050;
__device__ __forceinline__ void p7_router(Frame& F) {
    LAS float* UT = (LAS float*)F.lds;
    const int lane = F.lane, w = F.wave, c16 = lane & 15, q = lane >> 4;
    float rwa[16][2], rwb[16][2];
    const float* rwp = F.router_w + (size_t)(256 * w + q) * NEXP + c16;
#define P7_LOADRW(buf, sc) do { const float* rp_ = rwp + (sc) * 2048; asm volatile("" : "+v"(rp_));   \
        const GAS float* rg_ = (const GAS float*)rp_;                       \
        _Pragma("unroll") for (int st = 0; st < 16; ++st) _Pragma("unroll") for (int nt = 0; nt < 2; ++nt) buf[st][nt] = rg_[st * 128 + 16 * nt]; } while (0)
#define P7_MMA(buf, sc) do { float av_[16]; _Pragma("unroll") for (int st = 0; st < 16; ++st) av_[st] = UT[c16 * UTP + 256 * w + 64 * (sc) + 4 * st + q];     \
        __builtin_amdgcn_sched_barrier(0); \
        _Pragma("unroll") for (int st = 0; st < 16; ++st) { acc[0] = __builtin_amdgcn_mfma_f32_16x16x4f32(av_[st], buf[st][0], acc[0], 0, 0, 0); acc[1] = __builtin_amdgcn_mfma_f32_16x16x4f32(av_[st], buf[st][1], acc[1], 0, 0, 0); } } while (0)
    const bf16* h1 = WSP(const bf16, WS_H1); uchar* u2 = WSP(uchar, WS_U);
    f32x4 wvn[8];
#pragma unroll
    for (int j = 0; j < 8; ++j) wvn[j] = *(const f32x4*)(F.norm_ffn_w + 4 * (lane + 64 * j));
    for (int grp = blockIdx.x; grp < T / 16; grp += F.G) {
        __syncthreads();
        P7_LOADRW(rwa, 0); asm volatile("" ::: "memory");
#pragma unroll
        for (int tt = 0; tt < 2; ++tt) { const int tl = 2 * w + tt, tok = grp * 16 + tl; const bf16* xr = h1 + (size_t)tok * D;
            f32x4 v[8]; float s = 0.f;
#pragma unroll
            for (int j = 0; j < 8; ++j) { const u32x2 hq = __builtin_nontemporal_load((const u32x2*)(xr + 4 * (lane + 64 * j))); v[j] = (f32x4){bflo(hq.x), bfhi(hq.x), bflo(hq.y), bfhi(hq.y)}; s += (v[j][0] * v[j][0] + v[j][1] * v[j][1]) + (v[j][2] * v[j][2] + v[j][3] * v[j][3]); }
            const float rstd = rsqrtf(wave_sum(s) * (1.f / D) + EPS);
#pragma unroll
            for (int j = 0; j < 8; ++j) { const int col = 4 * (lane + 64 * j); const f32x4 wv = wvn[j];
                const float a0 = v[j][0] * rstd * wv[0], a1 = v[j][1] * rstd * wv[1], a2 = v[j][2] * rstd * wv[2], a3 = v[j][3] * rstd * wv[3];
                if constexpr (MOE_FP8) *(unsigned*)(u2 + (size_t)tok * D + col) = cvt4_fp8(a0, a1, a2, a3);
                else { u32x2 o; o.x = cvt_pk_bf16(a0, a1); o.y = cvt_pk_bf16(a2, a3); *(u32x2*)((bf16*)u2 + (size_t)tok * D + col) = o; }
                LAS float* d = UT + tl * UTP + col; *(LAS f32x2*)d = (f32x2){a0, a1}; *(LAS f32x2*)(d + 2) = (f32x2){a2, a3}; } }
        __syncthreads();
        f32x4 acc[2] = {(f32x4){0.f, 0.f, 0.f, 0.f}, (f32x4){0.f, 0.f, 0.f, 0.f}};
#define P7_FENCE asm volatile("" ::: "memory")
        P7_FENCE; P7_LOADRW(rwb, 1); P7_FENCE; P7_MMA(rwa, 0); P7_FENCE; P7_LOADRW(rwa, 2); P7_FENCE; P7_MMA(rwb, 1); P7_FENCE; P7_LOADRW(rwb, 3); P7_FENCE; P7_MMA(rwa, 2); P7_FENCE; P7_MMA(rwb, 3);
#undef P7_FENCE
        __syncthreads();
        LAS float* PL = UT;
#pragma unroll
        for (int nt = 0; nt < 2; ++nt)
#pragma unroll
            for (int r = 0; r < 4; ++r) PL[(w * 16 + 4 * q + r) * 32 + 16 * nt + c16] = acc[nt][r];
        __syncthreads();
        { const int tl = F.tid >> 5, e = F.tid & 31, tok = grp * 16 + tl;
          float lg = F.router_b[e];
#pragma unroll
          for (int ww = 0; ww < 8; ++ww) lg += PL[(ww * 16 + tl) * 32 + e];
          bool taken = false; float tv[4]; int ti[4];
#pragma unroll
          for (int k = 0; k < 4; ++k) { float cv = taken ? -3.0e38f : lg; int ci = e;
#pragma unroll
              for (int o = 16; o >= 1; o >>= 1) { const float ov = __shfl_xor(cv, o); const int oi = __shfl_xor(ci, o); const bool better = (ov > cv) || (ov == cv && oi < ci); cv = better ? ov : cv; ci = better ? oi : ci; }
              tv[k] = cv; ti[k] = ci; if (e == ci) taken = true; }
          const float e1 = __expf(tv[1] - tv[0]), e2 = __expf(tv[2] - tv[0]), e3 = __expf(tv[3] - tv[0]), inv = 1.0f / (1.0f + e1 + e2 + e3);
          if (e < 4) { const int ex = e == 0 ? ti[0] : (e == 1 ? ti[1] : (e == 2 ? ti[2] : ti[3])); const float gt = (e == 0 ? 1.0f : (e == 1 ? e1 : (e == 2 ? e2 : e3))) * inv;
              const unsigned pos = __hip_atomic_fetch_add((unsigned*)(F.ctl + CW_CNT + 64 * ex), 1u, RLX_AGENT);
              WSP(int, WS_SLOTTOK)[ex * T + (int)pos] = tok; WSP(int, WS_TOKE)[tok * 4 + e] = ex; WSP(int, WS_TOKPOS)[tok * 4 + e] = (int)pos; WSP(float, WS_GATE)[tok * 4 + e] = gt; } }
    }
}

#undef P7_LOADRW
#undef P7_MMA
__device__ __forceinline__ void moe_tables(Frame& F) {
    __syncthreads();
    if (F.tid < NEXP) F.LW[LW_CNT + F.tid] = __hip_atomic_load((unsigned*)(F.ctl + CW_CNT + 64 * F.tid), RLX_AGENT);
    __syncthreads();
    if (F.tid == 0) { unsigned a = 0; for (int e = 0; e < NEXP; ++e) { F.LW[LW_RBS + e] = a; a += (F.LW[LW_CNT + e] + 255u) >> 8; } F.LW[LW_RBS + NEXP] = a; }
    __syncthreads();
}

__device__ __forceinline__ void p10_combine(Frame& F) {
    const int gw = blockIdx.x * NWAVES + F.wave, NGW = F.G * NWAVES, lane = F.lane;
    const bf16* h1 = WSP(const bf16, WS_H1); const uchar* yb = WSP(const uchar, WS_YB);
    const int* toke = WSP(const int, WS_TOKE); const int* tokp = WSP(const int, WS_TOKPOS); const float* gate = WSP(const float, WS_GATE);
    f32x4 nw[4][2];
#pragma unroll
    for (int jj = 0; jj < 4; ++jj) { const int col = 8 * (lane + 64 * jj); nw[jj][0] = *(const f32x4*)(F.norm_final_w + col); nw[jj][1] = *(const f32x4*)(F.norm_final_w + col + 4); }
    int tok = gw;
    i32x4_t en = (i32x4_t){0, 0, 0, 0}, pn = (i32x4_t){0, 0, 0, 0}; f32x4 gn = (f32x4){0.f, 0.f, 0.f, 0.f};
    if (tok < T) { en = *(const i32x4_t*)(toke + tok * 4); pn = *(const i32x4_t*)(tokp + tok * 4); gn = *(const f32x4*)(gate + tok * 4); }
    for (; tok < T; tok += NGW) {
        const i32x4_t ec = en, pc = pn; const f32x4 gc = gn;
        const int tnext = tok + NGW;
        if (tnext < T) { en = *(const i32x4_t*)(toke + tnext * 4); pn = *(const i32x4_t*)(tokp + tnext * 4); gn = *(const f32x4*)(gate + tnext * 4); }
        float hv[4][8];
#pragma unroll
        for (int jj = 0; jj < 4; ++jj) { const u32x4 a = __builtin_nontemporal_load((const u32x4*)(h1 + (size_t)tok * D + 8 * (lane + 64 * jj)));
            hv[jj][0] = bflo(a.x); hv[jj][1] = bfhi(a.x); hv[jj][2] = bflo(a.y); hv[jj][3] = bfhi(a.y); hv[jj][4] = bflo(a.z); hv[jj][5] = bfhi(a.z); hv[jj][6] = bflo(a.w); hv[jj][7] = bfhi(a.w); }
#pragma unroll
        for (int k = 0; k < 4; ++k) { const int e = ec[k], pos = pc[k]; const float gt = gc[k] * (1.0f / YBS);
            const size_t slot = (size_t)F.LW[LW_RBS + e] * 256 + pos;
#pragma unroll
            for (int jj = 0; jj < 4; ++jj) { const u32x2 v = __builtin_nontemporal_load((const u32x2*)(yb + slot * D + 8 * (lane + 64 * jj)));
                const f32x2 p0 = __builtin_amdgcn_cvt_pk_f32_fp8((int)v.x, false), p1 = __builtin_amdgcn_cvt_pk_f32_fp8((int)v.x, true), p2 = __builtin_amdgcn_cvt_pk_f32_fp8((int)v.y, false), p3 = __builtin_amdgcn_cvt_pk_f32_fp8((int)v.y, true);
                hv[jj][0] += gt * p0[0]; hv[jj][1] += gt * p0[1]; hv[jj][2] += gt * p1[0]; hv[jj][3] += gt * p1[1]; hv[jj][4] += gt * p2[0]; hv[jj][5] += gt * p2[1]; hv[jj][6] += gt * p3[0]; hv[jj][7] += gt * p3[1]; } }
        float s = 0.f;
#pragma unroll
        for (int jj = 0; jj < 4; ++jj)
#pragma unroll
            for (int e = 0; e < 8; ++e) s += hv[jj][e] * hv[jj][e];
        const float rstd = rsqrtf(wave_sum(s) * (1.f / D) + EPS);
#pragma unroll
        for (int jj = 0; jj < 4; ++jj) { const int col = 8 * (lane + 64 * jj);
            float* o = F.out + (size_t)tok * D + col;
            __builtin_nontemporal_store((f32x4){hv[jj][0] * rstd * nw[jj][0][0], hv[jj][1] * rstd * nw[jj][0][1], hv[jj][2] * rstd * nw[jj][0][2], hv[jj][3] * rstd * nw[jj][0][3]}, (f32x4*)o);
            __builtin_nontemporal_store((f32x4){hv[jj][4] * rstd * nw[jj][1][0], hv[jj][5] * rstd * nw[jj][1][1], hv[jj][6] * rstd * nw[jj][1][2], hv[jj][7] * rstd * nw[jj][1][3]}, (f32x4*)(o + 4)); }
    }
}

struct Args { const float* in[21]; float* out; unsigned char* ws; int ph_lo, ph_hi, li, pad; };
__global__ void __launch_bounds__(NWAVES * 64, 2) mk_fwd(Args args) {
    extern __shared__ __attribute__((aligned(16))) unsigned char lds[];
    Frame F;
    F.lds = (LAS uchar*)lds; F.LW = (volatile LAS unsigned*)(F.lds + LDSCTL_OFF);
    F.tid = threadIdx.x; F.lane = F.tid & 63; F.wave = __builtin_amdgcn_readfirstlane(F.tid >> 6); F.G = gridDim.x;
    F.ws = args.ws; F.out = args.out; F.ctl = (gu32*)(args.ws + WS_CTL);
    F.x = args.in[0]; F.norm_mix_w = args.in[1]; F.w_in = args.in[2]; F.w_pool = args.in[3]; F.pool_scale = args.in[4]; F.conv_w = args.in[5]; F.conv_b = args.in[6];
    F.dt_bias = args.in[7]; F.a_log = args.in[8]; F.d_skip = args.in[9]; F.ssd_norm_w = args.in[10]; F.w_ssd_out = args.in[11]; F.w_out = args.in[12]; F.norm_ffn_w = args.in[13];
    F.router_w = args.in[14]; F.router_b = args.in[15]; F.w_up = args.in[16]; F.b_up = args.in[17]; F.w_down = args.in[18]; F.b_down = args.in[19]; F.norm_final_w = args.in[20];
    for (int u = F.tid; u < 256; u += NWAVES * 64) F.LW[u] = 0u;
    __syncthreads();
    XcdBarrier bar; bar.bar = (unsigned*)(F.ctl + CW_BAR) + args.li * XCD_BAR_WORDS; bar.x = 0; bar.st = nullptr;
    if (N_LAUNCHES != NPHASES) bar = xcd_barrier_post((unsigned*)(F.ctl + CW_BAR) + args.li * XCD_BAR_WORDS, F.LW + LW_BAR);
    const int lo = args.ph_lo, hi = args.ph_hi;
#define IN(k) (lo <= (k) && (k) < hi)
#define SEAM(k) do { if (IN(k) && IN((k) + 1)) xcd_barrier(bar); } while (0)

    const bool split = (F.G == 256);
    const int bx = (int)blockIdx.x, xcd_ = bx & 7, slot_ = bx >> 3;
    const bool gemm_wg = !split || xcd_ < 6;
    const int G1 = split ? 192 : F.G, c1 = split ? slot_ * 6 + xcd_ : bx;
    if (IN(0)) { REPS(0) p0_prologue(F, !split); } SEAM(0);

    if (IN(1)) {
        if (gemm_wg) {
            { EpiInProj E{WSP(bf16, WS_XP), WSP(bf16, WS_Z), WSP(bf16, WS_XBC), WSP(bf16, WS_GP), WSP(bf16, WS_GS), WSP(float, WS_DT)};
              DenseOrder S; S.to.init(T / 256, 49, G1, c1, split ? 6 : 8); S.skip_lo = 48; S.skip_n = 16; S.Bt = WSP(const bf16, WS_WIN); S.K = D;
              pg8::gemm_phase<EpiInProj, DenseOrder, PG8_ALIGN, PG8_SP2>(F.lds, WSP(const bf16, WS_U), D, S, E); }
            __syncthreads();
            { EpiInProjT<true> E{WSP(bf16, WS_XP), WSP(bf16, WS_Z), WSP(bf16, WS_XBC), WSP(bf16, WS_GP), WSP(bf16, WS_GS), WSP(float, WS_DT)};
              DenseOrder S; S.K = D / 2; S.Bt = (const bf16*)(WSP(const char, WS_WIN8) - (size_t)48 * 256 * 2048);
              if (!split) { S.to.init(T / 256, 16, G1, c1, 8); S.pn0 = 48; }
              else if (c1 < 64) { S.to.init(T / 256, 4, 64, c1, 6); S.pn0 = 60; }
              else { S.to.init(T / 256, 12, 128, c1 - 64, 6); S.pn0 = 48; }
              pg8::gemm_phase<EpiInProjT<true>, DenseOrder, PG8_ALIGN, PG8_SP2, true>(F.lds, WSP(const bf16, WS_U8), D / 2, S, E); }
        } else p1_convert_late(F, (slot_ * 2 + (xcd_ - 6)) * NWAVES + F.wave, 64 * NWAVES);
    } SEAM(1);

    if (IN(2)) {
        if (split) { p0_convert<1>(F, (int)blockIdx.x * NWAVES + F.wave, F.G * NWAVES); __syncthreads(); }
        REPS(12) p2_pool_items(F);
        REPS(3) for (int u = blockIdx.x; u < 1024; u += F.G) p2_states_unit(F, u);
    } SEAM(2);

    if (IN(3)) {
        PoolOrder S{F.G, (int)blockIdx.x, WSP(const bf16, WS_WPOOL)};
        EpiPool E{WSP(bf16, WS_MERGED), WSP(const bf16, WS_GP), F.pool_scale};
        pg8::gemm_phase<EpiPool, PoolOrder, PG8_ALIGN, PG8_SP2>(F.lds, WSP(const bf16, WS_POOLED), 512, S, E);
        p3_scan(F);
    } SEAM(3);

    if (IN(5)) { REPS(5) for (int u = blockIdx.x; u < 1024; u += F.G) p4_unit(F, u); } SEAM(5);

    if (IN(6)) {
        DenseOrder S; S.to.init(T / 256, D / 256, F.G, (int)blockIdx.x); S.Bt = WSP(const bf16, WS_WSSD); S.K = ZI;
        EpiSsdOut E{WSP(bf16, WS_MERGED), WSP(const bf16, WS_GS)};
        pg8::gemm_phase<EpiSsdOut, DenseOrder, PG8_ALIGN, PG8_SP2>(F.lds, WSP(const bf16, WS_YG), ZI, S, E);
    } SEAM(6);

    if (IN(7)) {
        DenseOrder S; S.to.init(T / 256, D / 256, F.G, (int)blockIdx.x); S.Bt = WSP(const bf16, WS_WOUT); S.K = D;
        EpiWout E{F.x, WSP(bf16, WS_H1)};
        pg8::gemm_phase<EpiWout, DenseOrder, PG8_ALIGN, PG8_SP2>(F.lds, WSP(const bf16, WS_MERGED), D, S, E);
    } SEAM(7);

    if (IN(8)) { p7_router(F); } SEAM(8);

    if (IN(9)) {
        moe_tables(F);
        MoeOrder S; S.to.init((int)F.LW[LW_RBS + NEXP], 16, F.G, (int)blockIdx.x); S.Bt = WSP(const bf16, WS_WUP); S.K = MOE_FP8 ? D / 2 : D; S.estride_bytes = (size_t)4096 * 2048 * (MOE_FP8 ? 1 : 2); S.LW = F.LW; S.slot_tok = WSP(const int, WS_SLOTTOK); S.gather = true;
        EpiUp E{WSP(uchar, WS_ACT), F.b_up};
        pg8::gemm_phase<EpiUp, MoeOrder, PG8_ALIGN, PG8_SP2, MOE_FP8 != 0>(F.lds, WSP(const bf16, WS_U), MOE_FP8 ? D / 2 : D, S, E);
    } SEAM(9);

    if (IN(10)) {
        moe_tables(F);
        MoeOrder S; S.to.init((int)F.LW[LW_RBS + NEXP], 8, F.G, (int)blockIdx.x); S.Bt = WSP(const bf16, WS_WDOWN); S.K = MOE_FP8 ? D / 2 : D; S.estride_bytes = (size_t)2048 * 2048 * (MOE_FP8 ? 1 : 2); S.LW = F.LW; S.slot_tok = WSP(const int, WS_SLOTTOK); S.gather = false;
        EpiDown E{WSP(uchar, WS_YB), F.b_down};
        pg8::gemm_phase<EpiDown, MoeOrder, PG8_ALIGN, PG8_SP2, MOE_FP8 != 0>(F.lds, WSP(const bf16, WS_ACT), MOE_FP8 ? D / 2 : D, S, E);
    } SEAM(10);

    if (IN(11)) { moe_tables(F); REPS(11) p10_combine(F); }
#undef IN
#undef SEAM
}

extern "C" void kernel_launch(void* const* d_in, const int* in_sizes, int n_in, void* d_out, int out_size, void* d_ws, size_t ws_size, hipStream_t stream) {
    static int grid = 0;
    if (grid == 0) {
        if (n_in != 21 || in_sizes[0] != T * D || out_size != T * D || ws_size < WS_END) { fprintf(stderr, "kernel_launch: unexpected shapes (n_in %d, in0 %d, out %d, ws %zu < %zu); nothing launched\n", n_in, n_in > 0 ? in_sizes[0] : -1, out_size, ws_size, (size_t)WS_END); grid = -1; return; }
        int dev = 0, cus = 0, per_cu = 0;
        if (hipGetDevice(&dev) != hipSuccess || hipDeviceGetAttribute(&cus, hipDeviceAttributeMultiprocessorCount, dev) != hipSuccess) { grid = -1; return; }
        if (hipFuncSetAttribute((const void*)mk_fwd, hipFuncAttributeMaxDynamicSharedMemorySize, LDS_BYTES) != hipSuccess) { fprintf(stderr, "kernel_launch: hipFuncSetAttribute failed\n"); grid = -1; return; }
        if (hipOccupancyMaxActiveBlocksPerMultiprocessor(&per_cu, (const void*)mk_fwd, NWAVES * 64, LDS_BYTES) != hipSuccess || per_cu < 1)
            fprintf(stderr, "kernel_launch: note: occupancy query reports %d workgroups per CU\n", per_cu);
        (void)hipGetLastError();
        grid = cus;
    }
    if (grid < 0) return;
    if (hipMemsetAsync((char*)d_ws + WS_CTL, 0, CTL_ZERO_BYTES, stream) != hipSuccess) return;
    Args a{};
    for (int i = 0; i < 21; ++i) a.in[i] = (const float*)d_in[i];
    a.out = (float*)d_out; a.ws = (unsigned char*)d_ws;
    int lo = 0, li = 0;
    for (int k = 1; k <= NPHASES; ++k) {
        const bool cut = (k == NPHASES) || (N_LAUNCHES == NPHASES) || (N_LAUNCHES != 1 && ((MK_CUTS >> k) & 1));
        if (!cut) continue;
        a.ph_lo = lo; a.ph_hi = k; a.li = li; lo = k; ++li;
        hipLaunchKernelGGL(mk_fwd, dim3(grid), dim3(NWAVES * 64), LDS_BYTES, stream, a);
        const hipError_t le = hipPeekAtLastError();
        if (le != hipSuccess) { fprintf(stderr, "kernel_launch: launch %d failed: %s\n", li, hipGetErrorName(le)); break; }
    }
}
```

```cpp
#include <hip/hip_runtime.h>
#include <cstdio>
#include <cstdint>

#ifndef MK_N_LAUNCHES
#define MK_N_LAUNCHES 1
#endif

#define LAS __attribute__((address_space(3)))
#define GAS __attribute__((address_space(1)))
typedef unsigned short bf16;
typedef unsigned char uchar;
typedef short bf16x8 __attribute__((ext_vector_type(8)));
typedef float f32x4 __attribute__((ext_vector_type(4)));
typedef float f32x2 __attribute__((ext_vector_type(2)));
typedef unsigned u32x4 __attribute__((ext_vector_type(4)));
typedef unsigned u32x2 __attribute__((ext_vector_type(2)));
typedef int i32x8 __attribute__((ext_vector_type(8)));
typedef int i32x4_t __attribute__((ext_vector_type(4)));
typedef GAS unsigned gu32;
#define RLX_AGENT __ATOMIC_RELAXED, __HIP_MEMORY_SCOPE_AGENT
#define LDS_WAIT() asm volatile("s_waitcnt lgkmcnt(0)" ::: "memory")
#define VM_WAIT() asm volatile("s_waitcnt vmcnt(0)" ::: "memory")

__device__ __forceinline__ unsigned cvt_pk_bf16(float lo, float hi) { unsigned r; asm volatile("v_cvt_pk_bf16_f32 %0, %1, %2" : "=v"(r) : "v"(lo), "v"(hi)); return r; }
typedef __bf16 bf16x2_t __attribute__((ext_vector_type(2)));
__device__ __forceinline__ unsigned cvt_pk_bf16_v(float lo, float hi) { const f32x2 v = {lo, hi}; return __builtin_bit_cast(unsigned, __builtin_convertvector(v, bf16x2_t)); }
__device__ __forceinline__ unsigned cvt4_fp8(float a, float b, float c, float d) { int w = 0; w = __builtin_amdgcn_cvt_pk_fp8_f32(a, b, w, false); w = __builtin_amdgcn_cvt_pk_fp8_f32(c, d, w, true); return (unsigned)w; }
__device__ __forceinline__ float bflo(unsigned u) { return __uint_as_float(u << 16); }
__device__ __forceinline__ float bfhi(unsigned u) { return __uint_as_float(u & 0xffff0000u); }
__device__ __forceinline__ float sigmoidf_(float x) { return __builtin_amdgcn_rcpf(1.0f + __expf(-x)); }
__device__ __forceinline__ float siluf_(float x) { return x * __builtin_amdgcn_rcpf(1.0f + __expf(-x)); }
__device__ __forceinline__ float wave_sum(float v) {
#pragma unroll
    for (int o = 1; o < 64; o <<= 1) v += __shfl_xor(v, o);
    return v;
}

constexpr int T = 16384, D = 2048, SEQ = 8192;
constexpr int ZI = 4096, XBCW = 6144, NH = 64, NPAD = 16640, INCOLS = 16448;
constexpr int NEXP = 32;
constexpr float EPS = 1e-5f;

namespace pg8 {
constexpr int BM = 256, BK = 64, HALF = 128, HTB = HALF * BK * 2, STAGE_BYTES = 8 * HTB, NXCD = 8, WGM = 8;
__host__ __device__ __forceinline__ int lds_byte(int r, int c) { const int st = (r >> 4) * 2 + (c >> 5), rr = r & 15, cc = c & 31, ob = rr * 64 + cc * 2; return st * 1024 + (ob ^ (((ob >> 9) & 1) << 5)); }
__host__ __device__ __forceinline__ void stage_rc(int b, int& R, int& C) { const int st = b / 1024, sb = b % 1024, swz = sb ^ (((sb >> 9) & 1) << 5); R = (st >> 1) * 16 + swz / 64; C = (st & 1) * 32 + (swz % 64) / 2; }
__host__ __device__ __forceinline__ int perm32(int rho) { const int n = rho >> 4, i = rho & 15; return 8 * (i >> 2) + 4 * n + (i & 3); }

struct Unit { int pm, pn, e; };

struct TileOrder {
    int nM, nN, nwg, G, c, nx;
    __device__ __forceinline__ void init(int nM_, int nN_, int G_, int c_, int nx_ = NXCD) { nM = nM_; nN = nN_; nwg = nM * nN; G = G_; c = c_; nx = nx_; }
    __device__ __forceinline__ bool tile(int i, int& pm, int& pn) const {
        const long L = (long)i * G + c; if (L >= nwg) return false;
        int wgid = (int)L; { const int q = nwg / nx, r = nwg % nx, xcd = wgid % nx, off = wgid / nx; wgid = (xcd < r ? xcd * (q + 1) : r * (q + 1) + (xcd - r) * q) + off; }
        const int nig = WGM * nN, gid = wgid / nig, fm = gid * WGM, gsz = (nM - fm) < WGM ? (nM - fm) : WGM;
        pm = fm + ((wgid % nig) % gsz); pn = (wgid % nig) / gsz; return true;
    }
};

template <class Epi, class Sched, bool ALIGN_EPI, bool SP2, bool FP8 = false>
__device__ __forceinline__ void gemm_phase(LAS uchar* lds, const bf16* Abase, const int K, const Sched& S, const Epi& E) {
    const int tid = threadIdx.x, wid = __builtin_amdgcn_readfirstlane(tid >> 6), lane = tid & 63, wr = wid >> 2, wc = wid & 3, fr = lane & 15, fq = lane >> 4;
    const int nt = K / BK;
    unsigned voffB[2];
#pragma unroll
    for (int i = 0; i < 2; ++i) { int R, C; stage_rc(tid * 16 + i * 8192, R, C); const int Rb = Epi::PERM ? ((R & ~31) + perm32(R & 31)) : R;
        voffB[i] = (unsigned)(Rb * K + C) * 2u; }
#define PG8_AOFFS(dst, u) do { _Pragma("unroll") for (int h = 0; h < 2; ++h) _Pragma("unroll") for (int i = 0; i < 2; ++i) { int R, C; stage_rc(tid * 16 + i * 8192, R, C); \
        dst[h][i] = S.arow(u, h * HALF + R) + (unsigned)C * 2u; } } while (0)
    const size_t kstep = (size_t)(BK * 2);
    const size_t hstep = (size_t)HALF * K * 2;
    const unsigned ldsw = (unsigned)wid * 1024u;
    const int aoff = lds_byte(wr * 64 + fr, fq * 8), boff = lds_byte(wc * 32 + fr, fq * 8);
#define PG8_SA(b, h) (((b) * 2 + (h)) * HTB)
#define PG8_SB(b, h) ((4 + (b) * 2 + (h)) * HTB)
#define PG8_STAGE(bufoff, gbase, voff) do { _Pragma("unroll") for (int _i = 0; _i < 2; ++_i) \
        __builtin_amdgcn_global_load_lds((const unsigned*)((const char*)(gbase) + (voff)[_i]), (LAS unsigned*)(lds + (bufoff) + ldsw + _i * 8192), 16, 0, 0); } while (0)
#define PG8_RD(off) (*(const LAS u32x4*)(lds + (off)))
#define PG8_LDA(dst, b, h) do { _Pragma("unroll") for (int m = 0; m < 4; ++m) { if constexpr (FP8) dst##8[m] = __builtin_bit_cast(i32x8, __builtin_shufflevector(PG8_RD(PG8_SA(b, h) + aoff + m * 2048), PG8_RD(PG8_SA(b, h) + aoff + m * 2048 + 1024), 0, 1, 2, 3, 4, 5, 6, 7)); \
        else { _Pragma("unroll") for (int k = 0; k < 2; ++k) dst[m][k] = *(const LAS bf16x8*)(lds + PG8_SA(b, h) + aoff + m * 2048 + k * 1024); } } } while (0)
#define PG8_LDB(dst, b, h) do { _Pragma("unroll") for (int n = 0; n < 2; ++n) { if constexpr (FP8) dst##8[n] = __builtin_bit_cast(i32x8, __builtin_shufflevector(PG8_RD(PG8_SB(b, h) + boff + n * 2048), PG8_RD(PG8_SB(b, h) + boff + n * 2048 + 1024), 0, 1, 2, 3, 4, 5, 6, 7)); \
        else { _Pragma("unroll") for (int k = 0; k < 2; ++k) dst[n][k] = *(const LAS bf16x8*)(lds + PG8_SB(b, h) + boff + n * 2048 + k * 1024); } } } while (0)
#define PG8_MMA(ai, bj, At, Bt) do { __builtin_amdgcn_s_setprio(1); _Pragma("unroll") for (int m = 0; m < 4; ++m) _Pragma("unroll") for (int n = 0; n < 2; ++n) { \
        if constexpr (FP8) { asm volatile("v_mfma_scale_f32_16x16x128_f8f6f4 %0, %1, %2, %0, %3, %4 op_sel_hi:[0,0,0]" : "+v"(acc[ai][bj][m][n]) : "v"(Bt##8[n]), "v"(At##8[m]), "v"(sc_1), "v"(sc_1)); } \
        else { _Pragma("unroll") for (int k = 0; k < 2; ++k) acc[ai][bj][m][n] = __builtin_amdgcn_mfma_f32_16x16x32_bf16(Bt[n][k], At[m][k], acc[ai][bj][m][n], 0, 0, 0); } } \
        __builtin_amdgcn_s_setprio(0); } while (0)
#define PG8_WAIT_V(n) asm volatile("s_waitcnt vmcnt(" #n ")" ::: "memory")
#define PG8_WAIT_L(n) asm volatile("s_waitcnt lgkmcnt(" #n ")" ::: "memory")
#define PG8_BAR __builtin_amdgcn_s_barrier()
#define PG8_SCHED __builtin_amdgcn_sched_barrier(0)
    Unit cur, nxt; int ui = 0;
    if (!S.next(0, cur)) return;
    f32x4 acc[2][2][4][2];
#pragma unroll
    for (int a = 0; a < 2; ++a)
#pragma unroll
        for (int b = 0; b < 2; ++b)
#pragma unroll
            for (int m = 0; m < 4; ++m)
#pragma unroll
                for (int n = 0; n < 2; ++n) acc[a][b][m][n] = (f32x4){0.f, 0.f, 0.f, 0.f};
    bf16x8 At[4][2], B0[2][2], B1[2][2];
    i32x8 At8[4], B08[2], B18[2];
    int sc_1 = 0x7F7F7F7F;
    if constexpr (FP8) asm volatile("" : "+v"(sc_1));
    unsigned vA[2][2];
    LAS u32x4* nva_lds = (LAS u32x4*)(lds + STAGE_BYTES) + tid;
    PG8_AOFFS(vA, cur); *nva_lds = (u32x4){vA[0][0], vA[0][1], vA[1][0], vA[1][1]};
    const char* cA = (const char*)Abase; const char* cB = S.bbase(cur);
    if constexpr (SP2) {
        PG8_STAGE(PG8_SB(0, 0), cB, voffB); PG8_STAGE(PG8_SB(0, 1), cB + hstep, voffB); PG8_STAGE(PG8_SA(0, 0), cA, vA[0]); PG8_STAGE(PG8_SA(0, 1), cA, vA[1]);
        if (wr == 1) PG8_BAR;
        PG8_WAIT_V(2); PG8_BAR;
        PG8_STAGE(PG8_SB(1, 0), cB + kstep, voffB); PG8_STAGE(PG8_SA(1, 0), cA + kstep, vA[0]); PG8_STAGE(PG8_SB(1, 1), cB + hstep + kstep, voffB);
        PG8_WAIT_V(6); PG8_BAR;
    } else {
        PG8_STAGE(PG8_SB(0, 0), cB, voffB); PG8_STAGE(PG8_SA(0, 0), cA, vA[0]); PG8_STAGE(PG8_SB(0, 1), cB + hstep, voffB); PG8_STAGE(PG8_SA(0, 1), cA, vA[1]);
        if (wr == 1) PG8_BAR;
        PG8_WAIT_V(4); PG8_BAR;
        PG8_STAGE(PG8_SB(1, 0), cB + kstep, voffB); PG8_STAGE(PG8_SA(1, 0), cA + kstep, vA[0]); PG8_STAGE(PG8_SB(1, 1), cB + hstep + kstep, voffB);
        PG8_WAIT_V(6); PG8_BAR;
    }
    for (;;) {
        const bool has_next = S.next(ui + 1, nxt);
        const char* nB = has_next ? S.bbase(nxt) : cB;
        if (has_next) { unsigned nvA[2][2]; PG8_AOFFS(nvA, nxt); *nva_lds = (u32x4){nvA[0][0], nvA[0][1], nvA[1][0], nvA[1][1]}; }
        for (int t = 0; t < nt; t += 2) {
            const bool last = (t == nt - 2);
            const char* a1 = cA + (size_t)(t + 1) * kstep;
            const char* a2 = last ? cA : cA + (size_t)(t + 2) * kstep; const char* b2 = last ? nB : cB + (size_t)(t + 2) * kstep;
            const char* a3 = a2 + kstep; const char* b3 = b2 + kstep;
#define PG8_SWAPA do { if (last) { const u32x4 t_ = *nva_lds; vA[0][0] = t_[0]; vA[0][1] = t_[1]; vA[1][0] = t_[2]; vA[1][1] = t_[3]; } } while (0)
            if constexpr (SP2) {
            PG8_LDB(B0, 0, 0); PG8_LDB(B1, 0, 1); PG8_SCHED; PG8_LDA(At, 0, 0); PG8_STAGE(PG8_SA(1, 1), a1, vA[1]); PG8_SWAPA;
            PG8_WAIT_V(8); PG8_WAIT_L(0); PG8_BAR; PG8_MMA(0, 0, At, B0); PG8_MMA(0, 1, At, B1); PG8_BAR; PG8_SCHED;
            PG8_LDA(At, 0, 1); PG8_STAGE(PG8_SB(0, 0), b2, voffB); PG8_STAGE(PG8_SB(0, 1), b2 + hstep, voffB); PG8_STAGE(PG8_SA(0, 0), a2, vA[0]);
            PG8_WAIT_V(8); PG8_WAIT_L(0); PG8_BAR; PG8_MMA(1, 0, At, B0); PG8_MMA(1, 1, At, B1); PG8_BAR; PG8_SCHED;
            PG8_LDB(B0, 1, 0); PG8_LDB(B1, 1, 1); PG8_SCHED; PG8_LDA(At, 1, 0); PG8_STAGE(PG8_SA(0, 1), a2, vA[1]);
            PG8_WAIT_V(8); PG8_WAIT_L(0); PG8_BAR; PG8_MMA(0, 0, At, B0); PG8_MMA(0, 1, At, B1); PG8_BAR; PG8_SCHED;
            PG8_LDA(At, 1, 1); PG8_STAGE(PG8_SB(1, 0), b3, voffB); PG8_STAGE(PG8_SB(1, 1), b3 + hstep, voffB); PG8_STAGE(PG8_SA(1, 0), a3, vA[0]);
            PG8_WAIT_V(8); PG8_WAIT_L(0); PG8_BAR; PG8_MMA(1, 0, At, B0); PG8_MMA(1, 1, At, B1); PG8_BAR; PG8_SCHED;
            } else {
            PG8_LDB(B0, 0, 0); PG8_SCHED; PG8_LDA(At, 0, 0); PG8_STAGE(PG8_SA(1, 1), a1, vA[1]); PG8_SWAPA;
            PG8_WAIT_L(8); PG8_BAR; PG8_WAIT_L(0); PG8_MMA(0, 0, At, B0); PG8_BAR; PG8_SCHED;
            PG8_LDB(B1, 0, 1); PG8_STAGE(PG8_SB(0, 0), b2, voffB);
            PG8_BAR; PG8_WAIT_L(0); PG8_MMA(0, 1, At, B1); PG8_BAR;
            PG8_LDA(At, 0, 1); PG8_STAGE(PG8_SA(0, 0), a2, vA[0]);
            PG8_BAR; PG8_WAIT_L(0); PG8_MMA(1, 0, At, B0); PG8_BAR; PG8_SCHED;
            PG8_STAGE(PG8_SB(0, 1), b2 + hstep, voffB);
            PG8_WAIT_V(6); PG8_BAR; PG8_MMA(1, 1, At, B1); PG8_BAR;
            PG8_LDB(B0, 1, 0); PG8_SCHED; PG8_LDA(At, 1, 0); PG8_STAGE(PG8_SA(0, 1), a2, vA[1]);
            PG8_WAIT_L(8); PG8_BAR; PG8_WAIT_L(0); PG8_MMA(0, 0, At, B0); PG8_BAR; PG8_SCHED;
            PG8_LDB(B1, 1, 1); PG8_STAGE(PG8_SB(1, 0), b3, voffB);
            PG8_BAR; PG8_WAIT_L(0); PG8_MMA(0, 1, At, B1); PG8_BAR;
            PG8_LDA(At, 1, 1); PG8_STAGE(PG8_SA(1, 0), a3, vA[0]);
            PG8_BAR; PG8_WAIT_L(0); PG8_MMA(1, 0, At, B0); PG8_BAR; PG8_SCHED;
            PG8_STAGE(PG8_SB(1, 1), b3 + hstep, voffB);
            PG8_WAIT_V(6); PG8_BAR; PG8_MMA(1, 1, At, B1); PG8_BAR;
            }
        }
        if constexpr (ALIGN_EPI) { if (wr == 0) PG8_BAR; }
        if constexpr (FP8) asm volatile("s_nop 15\n\ts_nop 15" ::: "memory");
        E(acc, cur, wr, wc, fr, fq);
        if constexpr (FP8) asm volatile("s_nop 7" ::: "memory");
        if (!has_next) break;
#pragma unroll
        for (int a = 0; a < 2; ++a)
#pragma unroll
            for (int b = 0; b < 2; ++b)
#pragma unroll
                for (int m = 0; m < 4; ++m)
#pragma unroll
                    for (int n = 0; n < 2; ++n) acc[a][b][m][n] = (f32x4){0.f, 0.f, 0.f, 0.f};
        cur = nxt; cB = nB; ++ui;
        if constexpr (ALIGN_EPI) { if (wr == 1) PG8_BAR; }
    }
    PG8_WAIT_V(0);
    if constexpr (!ALIGN_EPI) { if (wr == 0) PG8_BAR; }
    PG8_BAR;
#undef PG8_SA
#undef PG8_SB
#undef PG8_STAGE
#undef PG8_RD
#undef PG8_AOFFS
#undef PG8_SWAPA
#undef PG8_LDA
#undef PG8_LDB
#undef PG8_MMA
#undef PG8_WAIT_V
#undef PG8_WAIT_L
#undef PG8_BAR
#undef PG8_SCHED
}
}

#ifndef PG8_SP2
#define PG8_SP2 true
#endif
#ifndef PG8_ALIGN
#define PG8_ALIGN true
#endif

constexpr int NWAVES = 8;
constexpr int NPHASES = 12;
constexpr int N_LAUNCHES = MK_N_LAUNCHES;
#ifndef MOE_FP8
#define MOE_FP8 1
#endif
#ifndef MK_DOUBLE
#define MK_DOUBLE -1
#endif
#define REPS(k) for (int rep_ = 0; rep_ < ((MK_DOUBLE) == (k) ? 2 : 1); ++rep_)
#ifndef MK_CUTS
#define MK_CUTS 0x7fe
#endif

constexpr size_t MiB = 1u << 20;
constexpr size_t WS_CTL = 0, CTL_ZERO_BYTES = 256 * 1024;
constexpr size_t WS_WIN = 1 * MiB, WS_WPOOL = 66 * MiB, WS_WSSD = 68 * MiB, WS_WOUT = 84 * MiB, WS_WUP = 92 * MiB, WS_WDOWN = 604 * MiB;
constexpr size_t WS_U = 860 * MiB, WS_XP = 924 * MiB, WS_Z = 988 * MiB, WS_XBC = 1116 * MiB, WS_GP = 1308 * MiB, WS_GS = 1372 * MiB, WS_DT = 1436 * MiB;
constexpr size_t WS_POOLED = 1440 * MiB, WS_STATES = 1504 * MiB, WS_CDEC = 1632 * MiB, WS_YG = 1633 * MiB, WS_MERGED = 1761 * MiB, WS_H1 = 1825 * MiB;
constexpr size_t WS_ACT = 1953 * MiB, WS_YB = 2241 * MiB, WS_SLOTTOK = 2529 * MiB, WS_TOKE = 2531 * MiB, WS_TOKPOS = 2532 * MiB, WS_GATE = 2533 * MiB, WS_XC = 2534 * MiB, WS_U8 = 2534 * MiB  , WS_WIN8 = 2574 * MiB  , WS_END = 2726 * MiB;
static_assert(WS_WIN + (size_t)NPAD * D * 2 <= WS_WPOOL && WS_WUP + (size_t)NEXP * 4096 * 2048 * 2 <= WS_WDOWN && WS_WDOWN + (size_t)NEXP * 2048 * 2048 * 2 <= WS_U, "ws map (weights)");
static_assert(WS_XBC + (size_t)T * XBCW * 2 <= WS_GP && WS_STATES + (size_t)2 * 64 * 64 * 64 * 128 * 2 <= WS_CDEC && WS_ACT + (size_t)288 * 256 * 2048 * 2 <= WS_YB && WS_YB + (size_t)288 * 256 * 2048 * 2 <= WS_SLOTTOK, "ws map");
constexpr int CW_TMO = 0, CW_BAR = 4096, CW_CNT = 49152;
static_assert((CW_CNT + 64 * NEXP) * 4 <= (int)CTL_ZERO_BYTES, "ctl");

constexpr int LDS_BYTES = 147456;
constexpr int LDSCTL_OFF = LDS_BYTES - 1024;
constexpr int LW_BAR = 8, LW_RBS = 16, LW_CNT = 64;

#define XB_TMO      128
#define XB_XCNT(j)  (256  + 64 * (j))
#define XB_XSUB(j)  (1280 + 64 * (j))
#define XB_XGEN(j)  (2304 + 64 * (j))
#define XB_TOP      3328
#define XB_TOPGEN   3392
#define XCD_BAR_WORDS 3456
#define XB_SPIN_CAP (1u << 18)
__device__ __forceinline__ unsigned xb_ld(unsigned* p)              { return __hip_atomic_load(p, __ATOMIC_RELAXED, __HIP_MEMORY_SCOPE_AGENT); }
__device__ __forceinline__ unsigned xb_add(unsigned* p, unsigned v) { return __hip_atomic_fetch_add(p, v, __ATOMIC_RELAXED, __HIP_MEMORY_SCOPE_AGENT); }
__device__ __forceinline__ unsigned xb_xcc_id() { return (unsigned)__builtin_amdgcn_s_getreg((3 << 11) | 20) & 0xFu; }
#define XB_SPIN(cond, bar) do { unsigned _sp = 0; while (cond) { __builtin_amdgcn_s_sleep(1); \
    if ((++_sp & 255u) == 0u) { if (xb_ld(&(bar)[XB_TMO])) break; if (_sp > XB_SPIN_CAP) { atomicAdd(&(bar)[XB_TMO], 1u); break; } } } } while (0)
struct XcdBarrier { unsigned* bar; unsigned x; volatile LAS unsigned* st; };
__device__ __forceinline__ XcdBarrier xcd_barrier_post(unsigned* bar, volatile LAS unsigned* st) {
    XcdBarrier b; b.bar = bar; b.x = xb_xcc_id(); b.st = st;
    if (threadIdx.x == 0) (void)xb_add(&bar[XB_XCNT(b.x)], 1u);
    return b;
}
__device__ __forceinline__ void xcd_barrier_complete(unsigned* bar, unsigned x, unsigned& nloc, unsigned& nx) {
    const unsigned G = gridDim.x * gridDim.y * gridDim.z;
    unsigned sum, cnt, mine, sp = 0u;
    for (;;) {
        sum = 0u; cnt = 0u; mine = 0u;
#pragma unroll
        for (unsigned j = 0; j < 16; ++j) { const unsigned c = xb_ld(&bar[XB_XCNT(j)]); sum += c; cnt += (c > 0u) ? 1u : 0u; mine = (j == x) ? c : mine; }
        if (sum == G) break;
        __builtin_amdgcn_s_sleep(1);
        if ((++sp & 255u) == 0u) { if (xb_ld(&bar[XB_TMO])) break; if (sp > XB_SPIN_CAP) { atomicAdd(&bar[XB_TMO], 1u); break; } }
    }
    nloc = mine > 0u ? mine : 1u; nx = cnt > 0u ? cnt : 1u;
}
__device__ __forceinline__ void xcd_barrier(const XcdBarrier& b) {
    asm volatile("s_waitcnt vmcnt(0)" ::: "memory");
    __syncthreads();
    if (threadIdx.x == 0) {
        unsigned* bar = b.bar;
        __builtin_amdgcn_s_waitcnt(0);
        unsigned nloc = b.st[0], nx = b.st[1];
        if (nloc == 0u) { xcd_barrier_complete(bar, b.x, nloc, nx); b.st[0] = nloc; b.st[1] = nx; }
        const unsigned old = xb_add(&bar[XB_XSUB(b.x)], 1u);
        const unsigned gen = old / nloc;
        if (old + 1u == (gen + 1u) * nloc) {
            __builtin_amdgcn_fence(__ATOMIC_RELEASE, "agent");
            asm volatile("s_waitcnt vmcnt(0)" ::: "memory");
            const unsigned og = xb_add(&bar[XB_TOP], 1u);
            const unsigned tg = og / nx;
            if (og + 1u == (tg + 1u) * nx) xb_add(&bar[XB_TOPGEN], 1u);
            else XB_SPIN(xb_ld(&bar[XB_TOPGEN]) == tg, bar);
            __builtin_amdgcn_fence(__ATOMIC_ACQUIRE, "agent");
            xb_add(&bar[XB_XGEN(b.x)], 1u);
            asm volatile("s_waitcnt vmcnt(0)" ::: "memory");
        } else {
            XB_SPIN(xb_ld(&bar[XB_XGEN(b.x)]) == gen, bar);
            __builtin_amdgcn_fence(__ATOMIC_ACQUIRE, "agent");
            asm volatile("s_waitcnt vmcnt(0)" ::: "memory");
        }
    }
    __syncthreads();
}

struct Frame {
    LAS uchar* lds; volatile LAS unsigned* LW; gu32* ctl;
    int tid, lane, wave, G;
    uchar* ws; float* out;
    const float *x, *norm_mix_w, *w_in, *w_pool, *pool_scale, *conv_w, *conv_b, *dt_bias, *a_log, *d_skip, *ssd_norm_w, *w_ssd_out, *w_out, *norm_ffn_w, *router_w, *router_b, *w_up, *b_up, *w_down, *b_down, *norm_final_w;
};
#define WSP(type, off) ((type*)(F.ws + (off)))

struct DenseOrder {
    pg8::TileOrder to; const bf16* Bt; int K; int pn0 = 0, skip_lo = 1 << 20, skip_n = 0;
    __device__ __forceinline__ bool next(int i, pg8::Unit& u) const { u.e = 0; const bool ok = to.tile(i, u.pm, u.pn); u.pn += pn0; if (u.pn >= skip_lo) u.pn += skip_n; return ok; }
    __device__ __forceinline__ unsigned arow(const pg8::Unit& u, int R) const { return (unsigned)(u.pm * 256 + R) * (unsigned)(K * 2); }
    __device__ __forceinline__ const char* bbase(const pg8::Unit& u) const { return (const char*)Bt + (size_t)u.pn * 256 * K * 2; }
};
struct PoolOrder {
    int G, c; const bf16* Bt;
    __device__ __forceinline__ bool next(int i, pg8::Unit& u) const { const int L = i * G + c; if (L >= 512) return false; u.e = L >> 7; u.pm = (L & 127) >> 1; u.pn = L & 1; return true; }
    __device__ __forceinline__ unsigned arow(const pg8::Unit& u, int R) const { return (unsigned)(u.e * T + u.pm * 256 + R) * 1024u; }
    __device__ __forceinline__ const char* bbase(const pg8::Unit& u) const { return (const char*)Bt + (size_t)(u.e * 512 + u.pn * 256) * 1024; }
};
struct MoeOrder {
    pg8::TileOrder to; const bf16* Bt; int K; size_t estride_bytes; volatile LAS unsigned* LW; const int* slot_tok; bool gather;
    __device__ __forceinline__ bool next(int i, pg8::Unit& u) const {
        if (!to.tile(i, u.pm, u.pn)) return false;
        int e = 0;
#pragma unroll 8
        for (int j = 1; j <= NEXP; ++j) e += ((int)LW[LW_RBS + j] <= u.pm) ? 1 : 0;
        u.e = __builtin_amdgcn_readfirstlane(e); return true;
    }
    __device__ __forceinline__ unsigned arow(const pg8::Unit& u, int R) const {
        if (!gather) return (unsigned)(u.pm * 256 + R) * (unsigned)(K * 2);
        const int idx = (u.pm - (int)LW[LW_RBS + u.e]) * 256 + R, cnt = (int)LW[LW_CNT + u.e];
        const int tok = slot_tok[u.e * T + (idx < cnt ? idx : 0)];
        return (unsigned)(idx < cnt ? tok : 0) * (unsigned)(K * 2);
    }
    __device__ __forceinline__ const char* bbase(const pg8::Unit& u) const { return (const char*)Bt + (size_t)u.e * estride_bytes + (size_t)u.pn * 256 * K * 2; }
};

template <bool F8>
struct EpiInProjT {
    static constexpr bool PERM = true;
    bf16 *xp, *z, *xbc, *gp, *gs; float* dt;
    __device__ __forceinline__ void operator()(const f32x4 (&acc)[2][2][4][2], const pg8::Unit& u, int wr, int wc, int fr, int fq) const {
        const int row0 = u.pm * 256 + wr * 64 + fr, pn = u.pn;
        if (pn == 64) {
            if (wc < 2) {
#pragma unroll
                for (int ai = 0; ai < 2; ++ai)
#pragma unroll
                    for (int m = 0; m < 4; ++m) { float* p = dt + (size_t)(row0 + ai * 128 + m * 16) * 64 + wc * 32 + 8 * fq; *(f32x4*)p = acc[ai][0][m][0]; *(f32x4*)(p + 4) = acc[ai][0][m][1]; }
            }
            return;
        }
        bf16* base; int ldc, colt;
        if (pn < 8) { base = xp; ldc = 2048; colt = pn * 256; } else if (pn < 24) { base = z; ldc = 4096; colt = (pn - 8) * 256; } else if (pn < 48) { base = xbc; ldc = 6144; colt = (pn - 24) * 256; }
        else if (pn < 56) { base = gp; ldc = 2048; colt = (pn - 48) * 256; } else { base = gs; ldc = 2048; colt = (pn - 56) * 256; }
        const int col0 = colt + wc * 32 + 8 * fq;
#pragma unroll
        for (int ai = 0; ai < 2; ++ai)
#pragma unroll
            for (int m = 0; m < 4; ++m) { bf16* rowp = base + (size_t)(row0 + ai * 128 + m * 16) * ldc + col0;
#pragma unroll
                for (int bj = 0; bj < 2; ++bj) { constexpr float sc = F8 ? 1.0f / 32.0f : 1.0f; const f32x4 v0 = acc[ai][bj][m][0] * sc, v1 = acc[ai][bj][m][1] * sc;
                    u32x4 w; w.x = cvt_pk_bf16(v0[0], v0[1]); w.y = cvt_pk_bf16(v0[2], v0[3]); w.z = cvt_pk_bf16(v1[0], v1[1]); w.w = cvt_pk_bf16(v1[2], v1[3]);
                    *(u32x4*)(rowp + bj * 128) = w; } }
    }
};
typedef EpiInProjT<false> EpiInProj;
struct EpiPool {
    static constexpr bool PERM = true;
    bf16* merged; const bf16* gp; const float* ps;
    __device__ __forceinline__ void operator()(const f32x4 (&acc)[2][2][4][2], const pg8::Unit& u, int wr, int wc, int fr, int fq) const {
        const int row0 = u.pm * 256 + wr * 64 + fr, col0 = u.e * 512 + u.pn * 256 + wc * 32 + 8 * fq;
        f32x4 sv[2][2];
#pragma unroll
        for (int bj = 0; bj < 2; ++bj)
#pragma unroll
            for (int n = 0; n < 2; ++n) sv[bj][n] = *(const f32x4*)(ps + col0 + bj * 128 + 4 * n);
#pragma unroll
        for (int ai = 0; ai < 2; ++ai) {
            u32x4 gq[4][2];
#pragma unroll
            for (int m = 0; m < 4; ++m)
#pragma unroll
                for (int bj = 0; bj < 2; ++bj) gq[m][bj] = *(const u32x4*)(gp + (size_t)(row0 + ai * 128 + m * 16) * 2048 + col0 + bj * 128);
#pragma unroll
            for (int m = 0; m < 4; ++m) { const size_t ro = (size_t)(row0 + ai * 128 + m * 16) * 2048 + col0;
#pragma unroll
                for (int bj = 0; bj < 2; ++bj) { const u32x4 g = gq[m][bj];
                    const f32x4 v0 = acc[ai][bj][m][0] * sv[bj][0], v1 = acc[ai][bj][m][1] * sv[bj][1];
                    u32x4 w; w.x = cvt_pk_bf16(v0[0] * sigmoidf_(bflo(g.x)), v0[1] * sigmoidf_(bfhi(g.x))); w.y = cvt_pk_bf16(v0[2] * sigmoidf_(bflo(g.y)), v0[3] * sigmoidf_(bfhi(g.y)));
                    w.z = cvt_pk_bf16(v1[0] * sigmoidf_(bflo(g.z)), v1[1] * sigmoidf_(bfhi(g.z))); w.w = cvt_pk_bf16(v1[2] * sigmoidf_(bflo(g.w)), v1[3] * sigmoidf_(bfhi(g.w)));
                    *(u32x4*)(merged + ro + bj * 128) = w; } } }
    }
};
struct EpiSsdOut {
    static constexpr bool PERM = true;
    bf16* merged; const bf16* gs;
    __device__ __forceinline__ void operator()(const f32x4 (&acc)[2][2][4][2], const pg8::Unit& u, int wr, int wc, int fr, int fq) const {
        const int row0 = u.pm * 256 + wr * 64 + fr, col0 = u.pn * 256 + wc * 32 + 8 * fq;
#pragma unroll
        for (int ai = 0; ai < 2; ++ai) {
            u32x4 gq[4][2], pq[4][2];
#pragma unroll
            for (int m = 0; m < 4; ++m)
#pragma unroll
                for (int bj = 0; bj < 2; ++bj) { const size_t ro = (size_t)(row0 + ai * 128 + m * 16) * 2048 + col0 + bj * 128; gq[m][bj] = *(const u32x4*)(gs + ro); pq[m][bj] = *(const u32x4*)(merged + ro); }
#pragma unroll
            for (int m = 0; m < 4; ++m) { const size_t ro = (size_t)(row0 + ai * 128 + m * 16) * 2048 + col0;
#pragma unroll
                for (int bj = 0; bj < 2; ++bj) { const u32x4 g = gq[m][bj]; const u32x4 p = pq[m][bj];
                    const f32x4 v0 = acc[ai][bj][m][0], v1 = acc[ai][bj][m][1];
                    u32x4 w; w.x = cvt_pk_bf16(v0[0] * sigmoidf_(bflo(g.x)) + bflo(p.x), v0[1] * sigmoidf_(bfhi(g.x)) + bfhi(p.x)); w.y = cvt_pk_bf16(v0[2] * sigmoidf_(bflo(g.y)) + bflo(p.y), v0[3] * sigmoidf_(bfhi(g.y)) + bfhi(p.y));
                    w.z = cvt_pk_bf16(v1[0] * sigmoidf_(bflo(g.z)) + bflo(p.z), v1[1] * sigmoidf_(bfhi(g.z)) + bfhi(p.z)); w.w = cvt_pk_bf16(v1[2] * sigmoidf_(bflo(g.w)) + bflo(p.w), v1[3] * sigmoidf_(bfhi(g.w)) + bfhi(p.w));
                    *(u32x4*)(merged + ro + bj * 128) = w; } } }
    }
};
struct EpiWout {
    static constexpr bool PERM = true;
    const float* x; bf16* h1;
    __device__ __forceinline__ void operator()(const f32x4 (&acc)[2][2][4][2], const pg8::Unit& u, int wr, int wc, int fr, int fq) const {
        const int row0 = u.pm * 256 + wr * 64 + fr, col0 = u.pn * 256 + wc * 32 + 8 * fq;
#pragma unroll
        for (int ai = 0; ai < 2; ++ai) {
            f32x4 xq[4][2][2];
#pragma unroll
            for (int m = 0; m < 4; ++m)
#pragma unroll
                for (int bj = 0; bj < 2; ++bj)
#pragma unroll
                    for (int n = 0; n < 2; ++n) xq[m][bj][n] = *(const f32x4*)(x + (size_t)(row0 + ai * 128 + m * 16) * 2048 + col0 + bj * 128 + n * 4);
#pragma unroll
            for (int m = 0; m < 4; ++m) { const size_t ro = (size_t)(row0 + ai * 128 + m * 16) * 2048 + col0;
#pragma unroll
                for (int bj = 0; bj < 2; ++bj) { const f32x4 v0 = xq[m][bj][0] + acc[ai][bj][m][0], v1 = xq[m][bj][1] + acc[ai][bj][m][1];
                    u32x4 w; w.x = cvt_pk_bf16(v0[0], v0[1]); w.y = cvt_pk_bf16(v0[2], v0[3]); w.z = cvt_pk_bf16(v1[0], v1[1]); w.w = cvt_pk_bf16(v1[2], v1[3]);
                    *(u32x4*)(h1 + ro + bj * 128) = w; } } }
    }
};
constexpr float WSC = MOE_FP8 ? 1.0f / 32.0f : 1.0f;
__device__ __forceinline__ float swiglu_(float glu, float lin) { glu = fminf(glu, 7.0f); lin = fminf(fmaxf(lin, -7.0f), 7.0f); return glu * sigmoidf_(1.702f * glu) * (lin + 1.0f); }
struct EpiUp {
    static constexpr bool PERM = true;
    uchar* act; const float* b_up;
    __device__ __forceinline__ void operator()(const f32x4 (&acc)[2][2][4][2], const pg8::Unit& u, int wr, int wc, int fr, int fq) const {
        const int row0 = u.pm * 256 + wr * 64 + fr, col0 = u.pn * 128 + wc * 32 + 8 * fq;
        const float* bb = b_up + (size_t)u.e * 4096 + col0;
        const f32x4 bg0 = *(const f32x4*)bb, bg1 = *(const f32x4*)(bb + 4), bl0 = *(const f32x4*)(bb + 2048), bl1 = *(const f32x4*)(bb + 2052);
#pragma unroll
        for (int ai = 0; ai < 2; ++ai)
#pragma unroll
            for (int m = 0; m < 4; ++m) {
                const f32x4 g0 = acc[ai][0][m][0] * WSC + bg0, g1 = acc[ai][0][m][1] * WSC + bg1, l0 = acc[ai][1][m][0] * WSC + bl0, l1 = acc[ai][1][m][1] * WSC + bl1;
                if constexpr (MOE_FP8) { u32x2 w; w.x = cvt4_fp8(swiglu_(g0[0], l0[0]), swiglu_(g0[1], l0[1]), swiglu_(g0[2], l0[2]), swiglu_(g0[3], l0[3]));
                    w.y = cvt4_fp8(swiglu_(g1[0], l1[0]), swiglu_(g1[1], l1[1]), swiglu_(g1[2], l1[2]), swiglu_(g1[3], l1[3]));
                    *(u32x2*)(act + (size_t)(row0 + ai * 128 + m * 16) * 2048 + col0) = w; }
                else { u32x4 w; w.x = cvt_pk_bf16(swiglu_(g0[0], l0[0]), swiglu_(g0[1], l0[1])); w.y = cvt_pk_bf16(swiglu_(g0[2], l0[2]), swiglu_(g0[3], l0[3]));
                    w.z = cvt_pk_bf16(swiglu_(g1[0], l1[0]), swiglu_(g1[1], l1[1])); w.w = cvt_pk_bf16(swiglu_(g1[2], l1[2]), swiglu_(g1[3], l1[3]));
                    *(u32x4*)((bf16*)act + (size_t)(row0 + ai * 128 + m * 16) * 2048 + col0) = w; } }
    }
};
constexpr float YBS = 8.0f;
struct EpiDown {
    static constexpr bool PERM = true;
    uchar* yb; const float* b_down;
    __device__ __forceinline__ void operator()(const f32x4 (&acc)[2][2][4][2], const pg8::Unit& u, int wr, int wc, int fr, int fq) const {
        const int row0 = u.pm * 256 + wr * 64 + fr, col0 = u.pn * 256 + wc * 32 + 8 * fq;
        const float* bb = b_down + (size_t)u.e * 2048 + col0;
        f32x4 bv[2][2];
#pragma unroll
        for (int bj = 0; bj < 2; ++bj)
#pragma unroll
            for (int n = 0; n < 2; ++n) bv[bj][n] = *(const f32x4*)(bb + bj * 128 + 4 * n) * YBS;
#pragma unroll
        for (int ai = 0; ai < 2; ++ai)
#pragma unroll
            for (int m = 0; m < 4; ++m) { uchar* rowp = yb + (size_t)(row0 + ai * 128 + m * 16) * 2048 + col0;
#pragma unroll
                for (int bj = 0; bj < 2; ++bj) { const f32x4 v0 = acc[ai][bj][m][0] * (WSC * YBS) + bv[bj][0], v1 = acc[ai][bj][m][1] * (WSC * YBS) + bv[bj][1];
                    u32x2 w; w.x = cvt4_fp8(v0[0], v0[1], v0[2], v0[3]); w.y = cvt4_fp8(v1[0], v1[1], v1[2], v1[3]);
                    *(u32x2*)(rowp + bj * 128) = w; } }
    }
};

__device__ __forceinline__ int hperm(int p) { return 32 * (p >> 5) + 8 * ((p >> 2) & 3) + 4 * ((p >> 4) & 1) + (p & 3); }
template <int MODE = 0>
__device__ __forceinline__ void tr_item(const float* W, int ldw, int k0, int n0, bf16* dst, int K, LAS float* scr, int lane) {
    const int kq = lane >> 4, n4 = (lane & 15) * 4;
    f32x4 v[16];
#pragma unroll
    for (int i = 0; i < 16; ++i) v[i] = __builtin_nontemporal_load((const f32x4*)(W + (size_t)(k0 + 4 * i + kq) * ldw + n0 + n4));
#pragma unroll
    for (int i = 0; i < 16; ++i) { LAS float* s = scr + (4 * i + kq) * 65 + n4; s[0] = v[i][0]; s[1] = v[i][1]; s[2] = v[i][2]; s[3] = v[i][3]; }
    LDS_WAIT();
    const int c = lane & 7, nn = lane >> 3;
#pragma unroll
    for (int i = 0; i < 8; ++i) { const int n = nn + 8 * i; const LAS float* s = scr + (8 * c) * 65 + n;
        u32x4 o; o.x = cvt_pk_bf16(s[0], s[65]); o.y = cvt_pk_bf16(s[130], s[195]); o.z = cvt_pk_bf16(s[260], s[325]); o.w = cvt_pk_bf16(s[390], s[455]);
        if (MODE == 2) { bf16* p = dst + (size_t)n * K + hperm(8 * c); *(u32x2*)p = (u32x2){o.x, o.y}; *(u32x2*)(p + 8) = (u32x2){o.z, o.w}; }
        else *(u32x4*)(dst + (size_t)(MODE == 1 ? hperm(n) : n) * K + 8 * c) = o; }
    LDS_WAIT();
}
__device__ __forceinline__ void tr_item_fp8(const float* W, int ldw, int k0, int n0, uchar* dst, int K, LAS float* scr, int lane) {
    const int kq = lane >> 4, n4 = (lane & 15) * 4;
    f32x4 v[16];
#pragma unroll
    for (int i = 0; i < 16; ++i) v[i] = __builtin_nontemporal_load((const f32x4*)(W + (size_t)(k0 + 4 * i + kq) * ldw + n0 + n4));
#pragma unroll
    for (int i = 0; i < 16; ++i) { LAS float* s = scr + (4 * i + kq) * 65 + n4; s[0] = v[i][0]; s[1] = v[i][1]; s[2] = v[i][2]; s[3] = v[i][3]; }
    LDS_WAIT();
    const int c = lane & 3, nn = lane >> 2;
#pragma unroll
    for (int i = 0; i < 4; ++i) { const int n = nn + 16 * i; const LAS float* s = scr + (16 * c) * 65 + n;
        u32x4 o; o.x = cvt4_fp8(s[0] * 32.f, s[65] * 32.f, s[130] * 32.f, s[195] * 32.f); o.y = cvt4_fp8(s[260] * 32.f, s[325] * 32.f, s[390] * 32.f, s[455] * 32.f);
        o.z = cvt4_fp8(s[520] * 32.f, s[585] * 32.f, s[650] * 32.f, s[715] * 32.f); o.w = cvt4_fp8(s[780] * 32.f, s[845] * 32.f, s[910] * 32.f, s[975] * 32.f);
        *(u32x4*)(dst + (size_t)n * K + 16 * c) = o; }
    LDS_WAIT();
}
__device__ __forceinline__ void rms_row_bf16(const f32x4 (&v)[8], const f32x4 (&wv)[8], bf16* orow, uchar* orow8, int lane) {
    float s = 0.f;
#pragma unroll
    for (int j = 0; j < 8; ++j) s += (v[j][0] * v[j][0] + v[j][1] * v[j][1]) + (v[j][2] * v[j][2] + v[j][3] * v[j][3]);
    const float rstd = rsqrtf(wave_sum(s) * (1.f / D) + EPS);
#pragma unroll
    for (int j = 0; j < 8; ++j) { const float a0 = v[j][0] * rstd * wv[j][0], a1 = v[j][1] * rstd * wv[j][1], a2 = v[j][2] * rstd * wv[j][2], a3 = v[j][3] * rstd * wv[j][3];
        u32x2 o; o.x = cvt_pk_bf16(a0, a1); o.y = cvt_pk_bf16(a2, a3);
        *(u32x2*)(orow + 4 * (lane + 64 * j)) = o; *(unsigned*)(orow8 + 4 * (lane + 64 * j)) = cvt4_fp8(a0, a1, a2, a3); }
}
template <int PART>
__device__ __forceinline__ void p0_convert(Frame& F, int gw, int NGW) {
    LAS float* scr = (LAS float*)(F.lds + F.wave * 16640);
    constexpr int I_IN = 32 * 257, I_POOL = 4 * 64, I_SSD = 64 * 32, I_OUT = 32 * 32, I_UP = 32 * 32 * 64, I_DOWN = 32 * 32 * 32;
    constexpr int NEARLY = I_IN + I_POOL + I_SSD + I_OUT, NITEMS = NEARLY + I_UP + I_DOWN;
    constexpr int IT0 = PART == 1 ? I_IN : 0, IT1 = PART == 0 ? I_IN : (PART == 3 ? NITEMS : NEARLY);
    for (int it = IT0 + gw; it < IT1; it += NGW) {
        int r = it;
        if (r < I_IN) { const int kb = r / 257, nb = r % 257, n0 = nb * 64; const int r0 = n0 < 12288 ? n0 : (n0 == 12288 ? 16384 : n0 - 64);
            if (n0 >= 2048 && n0 < 6144) tr_item<1>(F.w_in, INCOLS, kb * 64, n0, WSP(bf16, WS_WIN) + (size_t)r0 * 2048 + kb * 64, 2048, scr, F.lane);
            else if (n0 >= 12352) tr_item_fp8(F.w_in, INCOLS, kb * 64, n0, WSP(uchar, WS_WIN8) + (size_t)(n0 - 12352) * 2048 + kb * 64, 2048, scr, F.lane);
            else tr_item(F.w_in, INCOLS, kb * 64, n0, WSP(bf16, WS_WIN) + (size_t)r0 * 2048 + kb * 64, 2048, scr, F.lane);
            continue; } r -= I_IN;
        if (r < I_POOL) { const int g = r >> 6, kb = (r >> 3) & 7, nb = r & 7;
            tr_item(F.w_pool + (size_t)g * 512 * 512, 512, kb * 64, nb * 64, WSP(bf16, WS_WPOOL) + (size_t)(g * 512 + nb * 64) * 512 + kb * 64, 512, scr, F.lane); continue; } r -= I_POOL;
        if (r < I_SSD) { const int kb = r >> 5, nb = r & 31;
            tr_item<2>(F.w_ssd_out, 2048, kb * 64, nb * 64, WSP(bf16, WS_WSSD) + (size_t)(nb * 64) * 4096 + kb * 64, 4096, scr, F.lane); continue; } r -= I_SSD;
        if (r < I_OUT) { const int kb = r >> 5, nb = r & 31;
            tr_item(F.w_out, 2048, kb * 64, nb * 64, WSP(bf16, WS_WOUT) + (size_t)(nb * 64) * 2048 + kb * 64, 2048, scr, F.lane); continue; } r -= I_OUT;
        if (r < I_UP) { const int e = r >> 11, kb = (r >> 6) & 31, nb = r & 63, n0 = nb * 64; const int j = n0 & 2047; const int r0 = 256 * (j >> 7) + (n0 >= 2048 ? 128 : 0) + (j & 127);
            if constexpr (MOE_FP8) tr_item_fp8(F.w_up + (size_t)e * 2048 * 4096, 4096, kb * 64, n0, WSP(uchar, WS_WUP) + ((size_t)e * 4096 + r0) * 2048 + kb * 64, 2048, scr, F.lane);
            else tr_item(F.w_up + (size_t)e * 2048 * 4096, 4096, kb * 64, n0, WSP(bf16, WS_WUP) + ((size_t)e * 4096 + r0) * 2048 + kb * 64, 2048, scr, F.lane);
            continue; } r -= I_UP;
        { const int e = r >> 10, kb = (r >> 5) & 31, nb = r & 31;
            if constexpr (MOE_FP8) tr_item_fp8(F.w_down + (size_t)e * 2048 * 2048, 2048, kb * 64, nb * 64, WSP(uchar, WS_WDOWN) + ((size_t)e * 2048 + nb * 64) * 2048 + kb * 64, 2048, scr, F.lane);
            else tr_item(F.w_down + (size_t)e * 2048 * 2048, 2048, kb * 64, nb * 64, WSP(bf16, WS_WDOWN) + ((size_t)e * 2048 + nb * 64) * 2048 + kb * 64, 2048, scr, F.lane); }
    }
}

struct LateItem { const float* src; uchar* dst; int ldw; };
__device__ __forceinline__ LateItem late_item(Frame& F, int r) {
    constexpr int I_UP = 32 * 32 * 64;
    LateItem L;
    if (r < I_UP) { const int e = r >> 11, kb = (r >> 6) & 31, nb = r & 63, n0 = nb * 64; const int j = n0 & 2047; const int r0 = 256 * (j >> 7) + (n0 >= 2048 ? 128 : 0) + (j & 127);
        L.src = F.w_up + (size_t)e * 2048 * 4096 + (size_t)(kb * 64) * 4096 + n0; L.ldw = 4096; L.dst = WSP(uchar, WS_WUP) + ((size_t)e * 4096 + r0) * 2048 + kb * 64; }
    else { r -= I_UP; const int e = r >> 10, kb = (r >> 5) & 31, nb = r & 31;
        L.src = F.w_down + (size_t)e * 2048 * 2048 + (size_t)(kb * 64) * 2048 + nb * 64; L.ldw = 2048; L.dst = WSP(uchar, WS_WDOWN) + ((size_t)e * 2048 + nb * 64) * 2048 + kb * 64; }
    return L;
}
#define LATE_LOAD(v, L) do { _Pragma("unroll") for (int i = 0; i < 16; ++i) v[i] = __builtin_nontemporal_load((const f32x4*)((L).src + (size_t)(4 * i + (lane >> 4)) * (L).ldw + (lane & 15) * 4)); } while (0)
#define LATE_PROC(v, L) do { _Pragma("unroll") for (int i = 0; i < 16; ++i) { LAS float* s_ = scr + (4 * i + (lane >> 4)) * 65 + (lane & 15) * 4; s_[0] = v[i][0]; s_[1] = v[i][1]; s_[2] = v[i][2]; s_[3] = v[i][3]; } \
        LDS_WAIT(); \
        _Pragma("unroll") for (int i = 0; i < 4; ++i) { const int n_ = (lane >> 2) + 16 * i; const LAS float* s_ = scr + (16 * (lane & 3)) * 65 + n_; \
            u32x4 o_; o_.x = cvt4_fp8(s_[0] * 32.f, s_[65] * 32.f, s_[130] * 32.f, s_[195] * 32.f); o_.y = cvt4_fp8(s_[260] * 32.f, s_[325] * 32.f, s_[390] * 32.f, s_[455] * 32.f); \
            o_.z = cvt4_fp8(s_[520] * 32.f, s_[585] * 32.f, s_[650] * 32.f, s_[715] * 32.f); o_.w = cvt4_fp8(s_[780] * 32.f, s_[845] * 32.f, s_[910] * 32.f, s_[975] * 32.f); \
            __builtin_nontemporal_store(o_, (u32x4*)((L).dst + (size_t)n_ * 2048 + 16 * (lane & 3))); } \
        LDS_WAIT(); } while (0)
__device__ __forceinline__ void p1_convert_late(Frame& F, int gw, int NGW) {
    static_assert(MOE_FP8, "pipelined converter writes e4m3");
    LAS float* scr = (LAS float*)(F.lds + F.wave * 16640);
    const int lane = F.lane;
    constexpr int NLATE = 32 * 32 * 64 + 32 * 32 * 32;
    f32x4 va[16], vb[16];
    int it = gw; LateItem La, Lb;
    if (it < NLATE) { La = late_item(F, it); LATE_LOAD(va, La); }
    while (it < NLATE) {
        const int it2 = it + NGW; if (it2 < NLATE) { Lb = late_item(F, it2); LATE_LOAD(vb, Lb); }
        LATE_PROC(va, La);
        const int it3 = it2 + NGW; if (it3 < NLATE) { La = late_item(F, it3); LATE_LOAD(va, La); }
        if (it2 < NLATE) LATE_PROC(vb, Lb);
        it = it3;
    }
}
#undef LATE_LOAD
#undef LATE_PROC
__device__ __forceinline__ void p0_prologue(Frame& F, bool with_late) {
    const int gw = blockIdx.x * NWAVES + F.wave, NGW = F.G * NWAVES;
    if (with_late) p0_convert<3>(F, gw, NGW); else p0_convert<0>(F, gw, NGW);
    { u32x4* pad = (u32x4*)(WSP(bf16, WS_WIN) + (size_t)INCOLS * 2048); const int n16 = (NPAD - INCOLS) * 2048 * 2 / 16;
      for (int i = blockIdx.x * 512 + F.tid; i < n16; i += F.G * 512) pad[i] = (u32x4){0u, 0u, 0u, 0u}; }
    f32x4 wv[8];
#pragma unroll
    for (int j = 0; j < 8; ++j) wv[j] = *(const f32x4*)(F.norm_mix_w + 4 * (F.lane + 64 * j));
    f32x4 va[8], vb[8];
    for (int m = gw; m < T; m += 2 * NGW) {
#pragma unroll
        for (int j = 0; j < 8; ++j) va[j] = __builtin_nontemporal_load((const f32x4*)(F.x + (size_t)m * D + 4 * (F.lane + 64 * j)));
        const int m2 = m + NGW;
        if (m2 < T) {
#pragma unroll
            for (int j = 0; j < 8; ++j) vb[j] = __builtin_nontemporal_load((const f32x4*)(F.x + (size_t)m2 * D + 4 * (F.lane + 64 * j))); }
        rms_row_bf16(va, wv, WSP(bf16, WS_U) + (size_t)m * D, WSP(uchar, WS_U8) + (size_t)m * D, F.lane);
        if (m2 < T) rms_row_bf16(vb, wv, WSP(bf16, WS_U) + (size_t)m2 * D, WSP(uchar, WS_U8) + (size_t)m2 * D, F.lane);
    }
}

constexpr int LDP = 136;
constexpr int SOFF_DTS = 0, SOFF_ACS = 4096, SOFF_T0 = 8192;
struct Conv2Regs { u32x4 v[2][7]; f32x4 w[2][4][2]; f32x4 bb[2][2]; };
__device__ __forceinline__ void conv2_load(Frame& F, int tbase, int pos0, int chA, int chB, Conv2Regs& R) {
    const int nb = F.tid & 15, r4 = F.tid >> 4;
    const bf16* xbc = WSP(const bf16, WS_XBC);
    const bool ok0 = pos0 + 4 * r4 - 3 >= 0;
#pragma unroll
    for (int t = 0; t < 2; ++t) { const int ch = (t ? chB : chA) + 8 * nb;
#pragma unroll
        for (int q = 0; q < 7; ++q) { const int rr = 4 * r4 - 3 + q; R.v[t][q] = *(const u32x4*)(xbc + (size_t)(tbase + ((q >= 3 || ok0) ? rr : 0)) * XBCW + ch); }
#pragma unroll
        for (int k = 0; k < 4; ++k) { R.w[t][k][0] = *(const f32x4*)(F.conv_w + (size_t)k * XBCW + ch); R.w[t][k][1] = *(const f32x4*)(F.conv_w + (size_t)k * XBCW + ch + 4); }
        R.bb[t][0] = *(const f32x4*)(F.conv_b + ch); R.bb[t][1] = *(const f32x4*)(F.conv_b + ch + 4); }
}
__device__ __forceinline__ void conv2_store(Frame& F, int pos0, Conv2Regs& R, LAS bf16* dstA, LAS bf16* dstB) {
    const int nb = F.tid & 15, r4 = F.tid >> 4;
#pragma unroll
    for (int t = 0; t < 2; ++t) {
#pragma unroll
        for (int q = 0; q < 3; ++q) { const bool ok = pos0 + 4 * r4 - 3 + q >= 0; R.v[t][q].x = ok ? R.v[t][q].x : 0u; R.v[t][q].y = ok ? R.v[t][q].y : 0u; R.v[t][q].z = ok ? R.v[t][q].z : 0u; R.v[t][q].w = ok ? R.v[t][q].w : 0u; }
        LAS bf16* dst = t ? dstB : dstA;
#pragma unroll
        for (int i = 0; i < 4; ++i) {
            f32x4 a0 = R.bb[t][0], a1 = R.bb[t][1];
#pragma unroll
            for (int k = 0; k < 4; ++k) { const u32x4 x = R.v[t][i + k];
                a0[0] += R.w[t][k][0][0] * bflo(x.x); a0[1] += R.w[t][k][0][1] * bfhi(x.x); a0[2] += R.w[t][k][0][2] * bflo(x.y); a0[3] += R.w[t][k][0][3] * bfhi(x.y);
                a1[0] += R.w[t][k][1][0] * bflo(x.z); a1[1] += R.w[t][k][1][1] * bfhi(x.z); a1[2] += R.w[t][k][1][2] * bflo(x.w); a1[3] += R.w[t][k][1][3] * bfhi(x.w); }
            u32x4 o; o.x = cvt_pk_bf16(siluf_(a0[0]), siluf_(a0[1])); o.y = cvt_pk_bf16(siluf_(a0[2]), siluf_(a0[3])); o.z = cvt_pk_bf16(siluf_(a1[0]), siluf_(a1[1])); o.w = cvt_pk_bf16(siluf_(a1[2]), siluf_(a1[3]));
            *(LAS u32x4*)(dst + (4 * r4 + i) * LDP + 8 * nb) = o;
        }
    }
}
__device__ __forceinline__ void dt2_load(Frame& F, int tbase, int g, float (&raw)[4]) {
    const int h = 8 * g + F.wave; const float* dtp = WSP(const float, WS_DT);
    raw[0] = dtp[(size_t)(tbase + F.lane) * 64 + h]; raw[1] = dtp[(size_t)(tbase + F.lane + 64) * 64 + h]; raw[2] = F.dt_bias[h]; raw[3] = F.a_log[h];
}
__device__ __forceinline__ void dt2_store(Frame& F, const float (&raw)[4]) {
    LAS float* dts = (LAS float*)(F.lds + SOFF_DTS); LAS float* acs = (LAS float*)(F.lds + SOFF_ACS);
    const int j = F.wave, lane = F.lane; const float bias = raw[2], a = -__expf(raw[3]);
    float carry = 0.f;
#pragma unroll
    for (int half = 0; half < 2; ++half) {
        const int s = lane + 64 * half; const float r = raw[half] + bias;
        const float dtv = r > 20.f ? r : log1pf(__expf(r));
        float v = dtv * a;
#pragma unroll
        for (int o = 1; o < 64; o <<= 1) { const float u = __shfl_up(v, o); if (lane >= o) v += u; }
        v += carry; carry = __shfl(v, 63);
        dts[j * 128 + s] = dtv; acs[j * 128 + s] = v;
    }
}
__device__ __forceinline__ void cpair_load_s(Frame& F, int tbase, int pos0, int chg, int sb, unsigned (&u)[11]) {
    const bf16* xbc = WSP(const bf16, WS_XBC);
    const bool ok0 = pos0 + 8 * sb - 3 >= 0;
#pragma unroll
    for (int q = 0; q < 11; ++q) { const int rr = 8 * sb - 3 + q; u[q] = *(const unsigned*)(xbc + (size_t)(tbase + ((q >= 3 || ok0) ? rr : 0)) * XBCW + chg); }
}
__device__ __forceinline__ void cpair_fix(int pos0, int sb, unsigned (&u)[11]) {
#pragma unroll
    for (int q = 0; q < 3; ++q) u[q] = (pos0 + 8 * sb - 3 + q >= 0) ? u[q] : 0u;
}
__device__ __forceinline__ void cpair_loadw(Frame& F, int chg, f32x2 (&xw)[5]) {
#pragma unroll
    for (int k = 0; k < 4; ++k) xw[k] = *(const f32x2*)(F.conv_w + (size_t)k * XBCW + chg);
    xw[4] = *(const f32x2*)(F.conv_b + chg);
}
template <int MODE>
__device__ __forceinline__ void cpair_store_w(int chl, int sb, LAS bf16* dst, const unsigned (&u)[11], const f32x2 (&xw)[5], const LAS float* dts, const LAS float* acs, float aend) {
    float o0[8], o1[8];
#pragma unroll
    for (int i = 0; i < 8; ++i) { float a0 = xw[4][0], a1 = xw[4][1];
#pragma unroll
        for (int k = 0; k < 4; ++k) { a0 += xw[k][0] * bflo(u[i + k]); a1 += xw[k][1] * bfhi(u[i + k]); }
        float sc = 1.f;
        if (MODE >= 1) { const int s = 8 * sb + i; sc = dts[s]; if (MODE == 2) sc *= __expf(aend - acs[s]); }
        o0[i] = siluf_(a0) * sc; o1[i] = siluf_(a1) * sc; }
    u32x4 p0, p1; p0.x = cvt_pk_bf16(o0[0], o0[1]); p0.y = cvt_pk_bf16(o0[2], o0[3]); p0.z = cvt_pk_bf16(o0[4], o0[5]); p0.w = cvt_pk_bf16(o0[6], o0[7]);
    p1.x = cvt_pk_bf16(o1[0], o1[1]); p1.y = cvt_pk_bf16(o1[2], o1[3]); p1.z = cvt_pk_bf16(o1[4], o1[5]); p1.w = cvt_pk_bf16(o1[6], o1[7]);
    *(LAS u32x4*)(dst + chl * LDP + 8 * sb) = p0; *(LAS u32x4*)(dst + (chl + 1) * LDP + 8 * sb) = p1;
}
struct ConvT2Regs { unsigned u[2][11]; f32x2 w[5]; };
__device__ __forceinline__ void convT2_load(Frame& F, int tbase, int pos0, int chg, ConvT2Regs& R) {
    const bf16* xbc = WSP(const bf16, WS_XBC);
#pragma unroll
    for (int it = 0; it < 2; ++it) { const int sb = (F.tid >> 6) + 8 * it; const bool ok0 = pos0 + 8 * sb - 3 >= 0;
#pragma unroll
        for (int q = 0; q < 11; ++q) { const int rr = 8 * sb - 3 + q; R.u[it][q] = *(const unsigned*)(xbc + (size_t)(tbase + ((q >= 3 || ok0) ? rr : 0)) * XBCW + chg); } }
#pragma unroll
    for (int k = 0; k < 4; ++k) R.w[k] = *(const f32x2*)(F.conv_w + (size_t)k * XBCW + chg);
    R.w[4] = *(const f32x2*)(F.conv_b + chg);
}
__device__ __forceinline__ void convT2_store(Frame& F, int pos0, int chl, ConvT2Regs& R, LAS bf16* dst) {
#pragma unroll
    for (int it = 0; it < 2; ++it) { const int sb = (F.tid >> 6) + 8 * it;
#pragma unroll
        for (int q = 0; q < 3; ++q) R.u[it][q] = (pos0 + 8 * sb - 3 + q >= 0) ? R.u[it][q] : 0u;
        float o0[8], o1[8];
#pragma unroll
        for (int i = 0; i < 8; ++i) { float a0 = R.w[4][0], a1 = R.w[4][1];
#pragma unroll
            for (int k = 0; k < 4; ++k) { a0 += R.w[k][0] * bflo(R.u[it][i + k]); a1 += R.w[k][1] * bfhi(R.u[it][i + k]); }
            o0[i] = siluf_(a0); o1[i] = siluf_(a1); }
        u32x4 p0, p1; p0.x = cvt_pk_bf16(o0[0], o0[1]); p0.y = cvt_pk_bf16(o0[2], o0[3]); p0.z = cvt_pk_bf16(o0[4], o0[5]); p0.w = cvt_pk_bf16(o0[6], o0[7]);
        p1.x = cvt_pk_bf16(o1[0], o1[1]); p1.y = cvt_pk_bf16(o1[2], o1[3]); p1.z = cvt_pk_bf16(o1[4], o1[5]); p1.w = cvt_pk_bf16(o1[6], o1[7]);
        *(LAS u32x4*)(dst + chl * LDP + 8 * sb) = p0; *(LAS u32x4*)(dst + (chl + 1) * LDP + 8 * sb) = p1; }
}
__device__ __forceinline__ void p2_states_unit(Frame& F, int unit) {
    const int g = unit & 7, c = (unit >> 3) & 63, b = unit >> 9;
    const int tbase = b * SEQ + c * 128, pos0 = c * 128;
    LAS float* dts = (LAS float*)(F.lds + SOFF_DTS); LAS float* acs = (LAS float*)(F.lds + SOFF_ACS);
    LAS bf16* BMT = (LAS bf16*)(F.lds + SOFF_T0);
    LAS bf16* XT0 = BMT + 128 * LDP; LAS bf16* XT1 = XT0 + 64 * LDP;
    const int lane = F.lane, w = F.wave, c16 = lane & 15, q = lane >> 4;
    const int pp = F.tid & 31, sbx = F.tid >> 5;
    unsigned xu[11]; f32x2 xw[5];
    cpair_load_s(F, tbase, pos0, 512 * g + 2 * pp, sbx, xu); cpair_loadw(F, 512 * g + 2 * pp, xw);
    float dtraw[4]; dt2_load(F, tbase, g, dtraw);
    ConvT2Regs cr; convT2_load(F, tbase, pos0, 4096 + 128 * g + 2 * (F.tid & 63), cr);
    __syncthreads();
    dt2_store(F, dtraw);
    convT2_store(F, pos0, 2 * (F.tid & 63), cr, BMT);
    __syncthreads();
    cpair_fix(pos0, sbx, xu); cpair_store_w<2>(2 * pp, sbx, XT0, xu, xw, dts, acs, acs[127]);
    bf16x8 bmf[4];
#pragma unroll
    for (int kk = 0; kk < 4; ++kk) bmf[kk] = *(const LAS bf16x8*)(BMT + (16 * w + c16) * LDP + 32 * kk + 8 * q);
    __syncthreads();
    bf16* states = WSP(bf16, WS_STATES);
    for (int j = 0; j < 8; ++j) {
        LAS bf16* XT = (j & 1) ? XT1 : XT0;
        const float aend = acs[j * 128 + 127];
        if (j < 7) { cpair_load_s(F, tbase, pos0, 512 * g + 64 * (j + 1) + 2 * pp, sbx, xu); cpair_loadw(F, 512 * g + 64 * (j + 1) + 2 * pp, xw); }
        f32x4 acc[4];
#pragma unroll
        for (int pt = 0; pt < 4; ++pt) acc[pt] = (f32x4){0.f, 0.f, 0.f, 0.f};
        { bf16x8 xa[2][4];
#pragma unroll
          for (int pt = 0; pt < 4; ++pt) xa[0][pt] = *(const LAS bf16x8*)(XT + (16 * pt + c16) * LDP + 8 * q);
#pragma unroll
          for (int kk = 0; kk < 4; ++kk) {
              if (kk < 3) {
#pragma unroll
                  for (int pt = 0; pt < 4; ++pt) xa[(kk + 1) & 1][pt] = *(const LAS bf16x8*)(XT + (16 * pt + c16) * LDP + 32 * (kk + 1) + 8 * q); }
              __builtin_amdgcn_sched_barrier(0);
#pragma unroll
              for (int pt = 0; pt < 4; ++pt) acc[pt] = __builtin_amdgcn_mfma_f32_16x16x32_bf16(bmf[kk], xa[kk & 1][pt], acc[pt], 0, 0, 0);
              __builtin_amdgcn_sched_barrier(0); } }
        const int h = 8 * g + j;
#pragma unroll
        for (int pt = 0; pt < 4; ++pt) { u32x2 o; o.x = cvt_pk_bf16(acc[pt][0], acc[pt][1]); o.y = cvt_pk_bf16(acc[pt][2], acc[pt][3]);
            *(u32x2*)(states + ((((size_t)(b * 64 + c) * 64 + h) * 64 + 16 * pt + c16) * 128 + 16 * w + 4 * q)) = o; }
        if (w == j && lane == 0) WSP(float, WS_CDEC)[(b * 64 + c) * 64 + h] = __expf(aend);
        if (j < 7) { cpair_fix(pos0, sbx, xu); cpair_store_w<2>(2 * pp, sbx, (j & 1) ? XT0 : XT1, xu, xw, dts + (j + 1) * 128, acs + (j + 1) * 128, acs[(j + 1) * 128 + 127]); }
        __syncthreads();
    }
}
template <int W>
__device__ __forceinline__ void pool_item(const bf16* xp, bf16* pooled, int cg, int g, int t0, int p0) {
    u32x4 rows[15 + W];
#pragma unroll
    for (int i = 0; i < 15 + W; ++i) { rows[i] = (u32x4){0u, 0u, 0u, 0u}; const int dq = i - (W - 1); if (p0 + dq >= 0) rows[i] = *(const u32x4*)(xp + (size_t)(t0 + dq) * 2048 + 8 * cg); }
    float S[8];
#pragma unroll
    for (int e = 0; e < 8; ++e) S[e] = 0.f;
#pragma unroll
    for (int i = 0; i < W - 1; ++i) { const u32x4 v = rows[i];
        S[0] += bflo(v.x); S[1] += bfhi(v.x); S[2] += bflo(v.y); S[3] += bfhi(v.y); S[4] += bflo(v.z); S[5] += bfhi(v.z); S[6] += bflo(v.w); S[7] += bfhi(v.w); }
#pragma unroll
    for (int i = 0; i < 16; ++i) {
        const int t = t0 + i, p = p0 + i;
        const u32x4 v = rows[W - 1 + i];
        float xv[8] = {bflo(v.x), bfhi(v.x), bflo(v.y), bfhi(v.y), bflo(v.z), bfhi(v.z), bflo(v.w), bfhi(v.w)};
        const float inv = 1.0f / (float)((p + 1) < W ? (p + 1) : W);
        float o[8];
#pragma unroll
        for (int e = 0; e < 8; ++e) { S[e] += xv[e]; o[e] = S[e] * inv - xv[e]; }
        u32x4 ov; ov.x = cvt_pk_bf16(o[0], o[1]); ov.y = cvt_pk_bf16(o[2], o[3]); ov.z = cvt_pk_bf16(o[4], o[5]); ov.w = cvt_pk_bf16(o[6], o[7]);
        *(u32x4*)(pooled + ((size_t)g * T + t) * 512 + (8 * cg & 511)) = ov;
        const u32x4 u = rows[i];
        S[0] -= bflo(u.x); S[1] -= bfhi(u.x); S[2] -= bflo(u.y); S[3] -= bfhi(u.y); S[4] -= bflo(u.z); S[5] -= bfhi(u.z); S[6] -= bflo(u.w); S[7] -= bfhi(u.w);
    }
}
__device__ __forceinline__ void p2_pool_items(Frame& F) {
    const bf16* xp = WSP(const bf16, WS_XP); bf16* pooled = WSP(bf16, WS_POOLED);
    for (int idx = blockIdx.x * 512 + F.tid; idx < (T / 16) * 256; idx += F.G * 512) {
        const int cg = idx & 255, rb = idx >> 8;
        const int g = __builtin_amdgcn_readfirstlane(cg >> 6);
        const int t0 = rb * 16, p0 = t0 & (SEQ - 1);
        if (g == 0) pool_item<2>(xp, pooled, cg, g, t0, p0); else if (g == 1) pool_item<4>(xp, pooled, cg, g, t0, p0);
        else if (g == 2) pool_item<8>(xp, pooled, cg, g, t0, p0); else pool_item<16>(xp, pooled, cg, g, t0, p0);
    }
}

__device__ __forceinline__ void p3_scan(Frame& F) {
    bf16* states = WSP(bf16, WS_STATES); const float* cdec = WSP(const float, WS_CDEC);
    for (int idx = blockIdx.x * 512 + F.tid; idx < 2 * 64 * 64 * 16; idx += F.G * 512) {
        const int n8 = idx & 15, p = (idx >> 4) & 63, h = (idx >> 10) & 63, b = idx >> 16;
        float run[8];
#pragma unroll
        for (int e = 0; e < 8; ++e) run[e] = 0.f;
        for (int c0 = 0; c0 < 64; c0 += 8) {
            u32x4 v[8]; float dec[8];
#pragma unroll
            for (int cc = 0; cc < 8; ++cc) { const int c = c0 + cc; v[cc] = *(const u32x4*)(states + ((((size_t)(b * 64 + c) * 64 + h) * 64 + p) * 128 + 8 * n8)); dec[cc] = cdec[(b * 64 + c) * 64 + h]; }
#pragma unroll
            for (int cc = 0; cc < 8; ++cc) { const int c = c0 + cc;
                u32x4 o; o.x = cvt_pk_bf16(run[0], run[1]); o.y = cvt_pk_bf16(run[2], run[3]); o.z = cvt_pk_bf16(run[4], run[5]); o.w = cvt_pk_bf16(run[6], run[7]);
                *(u32x4*)(states + ((((size_t)(b * 64 + c) * 64 + h) * 64 + p) * 128 + 8 * n8)) = o;
                const float d = dec[cc];
                run[0] = run[0] * d + bflo(v[cc].x); run[1] = run[1] * d + bfhi(v[cc].x); run[2] = run[2] * d + bflo(v[cc].y); run[3] = run[3] * d + bfhi(v[cc].y);
                run[4] = run[4] * d + bflo(v[cc].z); run[5] = run[5] * d + bfhi(v[cc].z); run[6] = run[6] * d + bflo(v[cc].w); run[7] = run[7] * d + bfhi(v[cc].w); }
        }
    }
}

__device__ __forceinline__ void p4_unit(Frame& F, int unit) {
    const int g = unit & 7, c = (unit >> 3) & 63, b = unit >> 9;
    const int tbase = b * SEQ + c * 128, pos0 = c * 128;
    LAS float* dts = (LAS float*)(F.lds + SOFF_DTS); LAS float* acs = (LAS float*)(F.lds + SOFF_ACS);
    LAS bf16* CMs = (LAS bf16*)(F.lds + SOFF_T0);
    LAS bf16* BMs = CMs + 128 * LDP;
    LAS bf16* XT0 = BMs + 128 * LDP; LAS bf16* PV0 = XT0 + 64 * LDP;
    LAS bf16* XT1 = BMs; LAS bf16* PV1 = BMs + 64 * LDP;
    const int lane = F.lane, w = F.wave, c16 = lane & 15, q = lane >> 4;
    const int l = 16 * w + c16;
    const int pp = F.tid & 31, sbx = F.tid >> 5;
    const bf16* zb = WSP(const bf16, WS_Z); const bf16* states = WSP(const bf16, WS_STATES);
    bf16* yg = WSP(bf16, WS_YG);
    LAS u32x4* parkA = (LAS u32x4*)(F.lds + SOFF_T0) + F.tid; LAS u32x4* parkB = (LAS u32x4*)(F.lds + SOFF_T0 + 384 * LDP * 2) + F.tid;
    unsigned xu[11]; u32x4 pvr[2]; f32x2 xw[5];
    const float dskall = F.d_skip[8 * g + (lane & 7)];
    cpair_load_s(F, tbase, pos0, 512 * g + 2 * pp, sbx, xu); cpair_loadw(F, 512 * g + 2 * pp, xw);
    { const bf16* src = states + (((size_t)(b * 64 + c) * 64 + 8 * g) * 64) * 128;
#pragma unroll
      for (int it = 0; it < 2; ++it) { const int i16 = F.tid + 512 * it; pvr[it] = *(const u32x4*)(src + (i16 >> 4) * 128 + 8 * (i16 & 15)); } }
    float dtraw[4]; dt2_load(F, tbase, g, dtraw);
    Conv2Regs cr; conv2_load(F, tbase, pos0, 4096 + 1024 + 128 * g, 4096 + 128 * g, cr);
    __syncthreads();
    dt2_store(F, dtraw);
    conv2_store(F, pos0, cr, CMs, BMs);
    __syncthreads();
    bf16x8 cmf[4];
#pragma unroll
    for (int kn = 0; kn < 4; ++kn) cmf[kn] = *(const LAS bf16x8*)(CMs + l * LDP + 32 * kn + 8 * q);
    f32x4 cb[8];
#pragma unroll
    for (int st = 0; st < 8; ++st) { cb[st] = (f32x4){0.f, 0.f, 0.f, 0.f};
        if (st <= w) {
            bf16x8 ba[4];
#pragma unroll
            for (int kn = 0; kn < 4; ++kn) ba[kn] = *(const LAS bf16x8*)(BMs + (16 * st + c16) * LDP + 32 * kn + 8 * q);
            __builtin_amdgcn_sched_barrier(0);
#pragma unroll
            for (int kn = 0; kn < 4; ++kn) cb[st] = __builtin_amdgcn_mfma_f32_16x16x32_bf16(ba[kn], cmf[kn], cb[st], 0, 0, 0); } }
    cpair_fix(pos0, sbx, xu); cpair_store_w<1>(2 * pp, sbx, XT0, xu, xw, dts, acs, 0.f);
#pragma unroll
    for (int it = 0; it < 2; ++it) { const int i16 = F.tid + 512 * it; *(LAS u32x4*)(PV0 + (i16 >> 4) * LDP + 8 * (i16 & 15)) = pvr[it]; }
    __syncthreads();
    float ssq = 0.f;
    for (int j = 0; j < 8; ++j) {
        LAS bf16* XT = (j & 1) ? XT1 : XT0; LAS bf16* PV = (j & 1) ? PV1 : PV0;
        const int h = 8 * g + j;
        u32x4 zq[2];
#pragma unroll
        for (int i = 0; i < 2; ++i) zq[i] = *(const u32x4*)(zb + (size_t)(tbase + l) * ZI + 512 * g + 64 * j + 32 * i + 8 * q);
        const float al = acs[j * 128 + l], dtl = dts[j * 128 + l], dsk = __builtin_bit_cast(float, __builtin_amdgcn_readlane(__builtin_bit_cast(int, dskall), j)) / dtl;
        f32x4 ad[4], ao[4];
#pragma unroll
        for (int pt = 0; pt < 4; ++pt) { ad[pt] = (f32x4){0.f, 0.f, 0.f, 0.f}; ao[pt] = (f32x4){0.f, 0.f, 0.f, 0.f}; }
#pragma unroll
        for (int kk = 0; kk < 4; ++kk) {
            if (32 * kk <= 16 * w + 15) {
                const f32x4 as0 = *(const LAS f32x4*)(acs + j * 128 + 32 * kk + 4 * q), as1 = *(const LAS f32x4*)(acs + j * 128 + 32 * kk + 16 + 4 * q);
                u32x2 xlo[4], xhi[4];
#pragma unroll
                for (int pt = 0; pt < 4; ++pt) { xlo[pt] = *(const LAS u32x2*)(XT + (16 * pt + c16) * LDP + 32 * kk + 4 * q); xhi[pt] = *(const LAS u32x2*)(XT + (16 * pt + c16) * LDP + 32 * kk + 16 + 4 * q); }
                __builtin_amdgcn_sched_barrier(0);
                float mv[8];
                if (32 * kk + 31 <= 16 * w) {
#pragma unroll
                    for (int i = 0; i < 4; ++i) { mv[i] = cb[2 * kk][i] * __expf(al - as0[i]); mv[4 + i] = cb[2 * kk + 1][i] * __expf(al - as1[i]); }
                } else {
#pragma unroll
                    for (int i = 0; i < 4; ++i) { const int s0 = 32 * kk + 4 * q + i, s1 = s0 + 16;
                        float v0 = cb[2 * kk][i] * __expf(fminf(al - as0[i], 0.f)), v1 = cb[2 * kk + 1][i] * __expf(fminf(al - as1[i], 0.f));
                        v0 = (s0 <= l) ? v0 : 0.f; v1 = (s1 <= l) ? v1 : 0.f; if (s0 == l) v0 += dsk; if (s1 == l) v1 += dsk; mv[i] = v0; mv[4 + i] = v1; }
                }
                u32x4 bw; bw.x = cvt_pk_bf16_v(mv[0], mv[1]); bw.y = cvt_pk_bf16_v(mv[2], mv[3]); bw.z = cvt_pk_bf16_v(mv[4], mv[5]); bw.w = cvt_pk_bf16_v(mv[6], mv[7]);
                const bf16x8 bfrag = __builtin_bit_cast(bf16x8, bw);
#pragma unroll
                for (int pt = 0; pt < 4; ++pt) { const u32x2 lo = xlo[pt], hi = xhi[pt];
                    u32x4 aw; aw.x = lo.x; aw.y = lo.y; aw.z = hi.x; aw.w = hi.y;
                    ad[pt] = __builtin_amdgcn_mfma_f32_16x16x32_bf16(__builtin_bit_cast(bf16x8, aw), bfrag, ad[pt], 0, 0, 0); }
            }
        }
        if (j < 7) { cpair_load_s(F, tbase, pos0, 512 * g + 64 * (j + 1) + 2 * pp, sbx, xu); cpair_loadw(F, 512 * g + 64 * (j + 1) + 2 * pp, xw);
            const bf16* src = states + (((size_t)(b * 64 + c) * 64 + h + 1) * 64) * 128;
#pragma unroll
            for (int it = 0; it < 2; ++it) { const int i16 = F.tid + 512 * it; pvr[it] = *(const u32x4*)(src + (i16 >> 4) * 128 + 8 * (i16 & 15)); } }
        { bf16x8 pa[2][4];
#pragma unroll
          for (int pt = 0; pt < 4; ++pt) pa[0][pt] = *(const LAS bf16x8*)(PV + (16 * pt + c16) * LDP + 8 * q);
#pragma unroll
          for (int kn = 0; kn < 4; ++kn) {
              if (kn < 3) {
#pragma unroll
                  for (int pt = 0; pt < 4; ++pt) pa[(kn + 1) & 1][pt] = *(const LAS bf16x8*)(PV + (16 * pt + c16) * LDP + 32 * (kn + 1) + 8 * q); }
              __builtin_amdgcn_sched_barrier(0);
#pragma unroll
              for (int pt = 0; pt < 4; ++pt) ao[pt] = __builtin_amdgcn_mfma_f32_16x16x32_bf16(pa[kn & 1][pt], cmf[kn], ao[pt], 0, 0, 0);
              __builtin_amdgcn_sched_barrier(0); } }
        const float eal = __expf(al);
#pragma unroll
        for (int i = 0; i < 2; ++i) { u32x4 oq;
#pragma unroll
            for (int hh = 0; hh < 2; ++hh) { const int pt = 2 * i + hh; const unsigned z01 = hh ? zq[i].z : zq[i].x, z23 = hh ? zq[i].w : zq[i].y;
                const float y0 = (ad[pt][0] + eal * ao[pt][0]) * siluf_(bflo(z01)), y1 = (ad[pt][1] + eal * ao[pt][1]) * siluf_(bfhi(z01));
                const float y2 = (ad[pt][2] + eal * ao[pt][2]) * siluf_(bflo(z23)), y3 = (ad[pt][3] + eal * ao[pt][3]) * siluf_(bfhi(z23));
                ssq += (y0 * y0 + y1 * y1) + (y2 * y2 + y3 * y3);
                if (hh) { oq.z = cvt_pk_bf16(y0, y1); oq.w = cvt_pk_bf16(y2, y3); } else { oq.x = cvt_pk_bf16(y0, y1); oq.y = cvt_pk_bf16(y2, y3); } }
            if (j < 4) ((j < 2) ? parkA : parkB)[((j & 1) * 2 + i) * 512] = oq;
            else *(u32x4*)(yg + (size_t)(tbase + l) * ZI + 512 * g + 64 * j + 32 * i + 8 * q) = oq; }

        if (j < 7) { cpair_fix(pos0, sbx, xu); cpair_store_w<1>(2 * pp, sbx, (j & 1) ? XT0 : XT1, xu, xw, dts + (j + 1) * 128, acs + (j + 1) * 128, 0.f);
            LAS bf16* PVn = (j & 1) ? PV0 : PV1;
#pragma unroll
            for (int it = 0; it < 2; ++it) { const int i16 = F.tid + 512 * it; *(LAS u32x4*)(PVn + (i16 >> 4) * LDP + 8 * (i16 & 15)) = pvr[it]; } }
        __syncthreads();
    }
    ssq += __shfl_xor(ssq, 16); ssq += __shfl_xor(ssq, 32);
    const float rstd = rsqrtf(ssq * (1.f / 512.f) + EPS);
#define Y_RESCALE(J0, LOADV) do { u32x4 v[8]; f32x4 nw[16]; \
        _Pragma("unroll") for (int i = 0; i < 8; ++i) { const int ch = 512 * g + 64 * ((J0) + (i >> 1)) + 32 * (i & 1); nw[2 * i] = *(const f32x4*)(F.ssd_norm_w + ch + 4 * q); nw[2 * i + 1] = *(const f32x4*)(F.ssd_norm_w + ch + 16 + 4 * q); v[i] = LOADV; } \
        _Pragma("unroll") for (int i = 0; i < 8; ++i) { const int ch = 512 * g + 64 * ((J0) + (i >> 1)) + 32 * (i & 1); u32x4 o; \
            o.x = cvt_pk_bf16(bflo(v[i].x) * rstd * nw[2 * i][0], bfhi(v[i].x) * rstd * nw[2 * i][1]); o.y = cvt_pk_bf16(bflo(v[i].y) * rstd * nw[2 * i][2], bfhi(v[i].y) * rstd * nw[2 * i][3]); \
            o.z = cvt_pk_bf16(bflo(v[i].z) * rstd * nw[2 * i + 1][0], bfhi(v[i].z) * rstd * nw[2 * i + 1][1]); o.w = cvt_pk_bf16(bflo(v[i].w) * rstd * nw[2 * i + 1][2], bfhi(v[i].w) * rstd * nw[2 * i + 1][3]); \
            *(u32x4*)(yg + (size_t)(tbase + l) * ZI + ch + 8 * q) = o; } } while (0)
    Y_RESCALE(0, (((i < 4) ? parkA : parkB)[(((i >> 1) & 1) * 2 + (i & 1)) * 512]));
    asm volatile("s_waitcnt vmcnt(0)" ::: "memory");
    Y_RESCALE(4, (*(const u32x4*)(yg + (size_t)(tbase + l) * ZI + ch + 8 * q)));
#undef Y_RESCALE
}


constexpr int UTP = 2050;
__device__ __forceinline__ void p7_router(Frame& F) {
    LAS float* UT = (LAS float*)F.lds;
    const int lane = F.lane, w = F.wave, c16 = lane & 15, q = lane >> 4;
    float rwa[16][2], rwb[16][2];
    const float* rwp = F.router_w + (size_t)(256 * w + q) * NEXP + c16;
#define P7_LOADRW(buf, sc) do { const float* rp_ = rwp + (sc) * 2048; asm volatile("" : "+v"(rp_));   \
        const GAS float* rg_ = (const GAS float*)rp_;                       \
        _Pragma("unroll") for (int st = 0; st < 16; ++st) _Pragma("unroll") for (int nt = 0; nt < 2; ++nt) buf[st][nt] = rg_[st * 128 + 16 * nt]; } while (0)
#define P7_MMA(buf, sc) do { float av_[16]; _Pragma("unroll") for (int st = 0; st < 16; ++st) av_[st] = UT[c16 * UTP + 256 * w + 64 * (sc) + 4 * st + q];     \
        __builtin_amdgcn_sched_barrier(0); \
        _Pragma("unroll") for (int st = 0; st < 16; ++st) { acc[0] = __builtin_amdgcn_mfma_f32_16x16x4f32(av_[st], buf[st][0], acc[0], 0, 0, 0); acc[1] = __builtin_amdgcn_mfma_f32_16x16x4f32(av_[st], buf[st][1], acc[1], 0, 0, 0); } } while (0)
    const bf16* h1 = WSP(const bf16, WS_H1); uchar* u2 = WSP(uchar, WS_U);
    f32x4 wvn[8];
#pragma unroll
    for (int j = 0; j < 8; ++j) wvn[j] = *(const f32x4*)(F.norm_ffn_w + 4 * (lane + 64 * j));
    for (int grp = blockIdx.x; grp < T / 16; grp += F.G) {
        __syncthreads();
        P7_LOADRW(rwa, 0); asm volatile("" ::: "memory");
#pragma unroll
        for (int tt = 0; tt < 2; ++tt) { const int tl = 2 * w + tt, tok = grp * 16 + tl; const bf16* xr = h1 + (size_t)tok * D;
            f32x4 v[8]; float s = 0.f;
#pragma unroll
            for (int j = 0; j < 8; ++j) { const u32x2 hq = *(const u32x2*)(xr + 4 * (lane + 64 * j)); v[j] = (f32x4){bflo(hq.x), bfhi(hq.x), bflo(hq.y), bfhi(hq.y)}; s += (v[j][0] * v[j][0] + v[j][1] * v[j][1]) + (v[j][2] * v[j][2] + v[j][3] * v[j][3]); }
            const float rstd = rsqrtf(wave_sum(s) * (1.f / D) + EPS);
#pragma unroll
            for (int j = 0; j < 8; ++j) { const int col = 4 * (lane + 64 * j); const f32x4 wv = wvn[j];
                const float a0 = v[j][0] * rstd * wv[0], a1 = v[j][1] * rstd * wv[1], a2 = v[j][2] * rstd * wv[2], a3 = v[j][3] * rstd * wv[3];
                if constexpr (MOE_FP8) *(unsigned*)(u2 + (size_t)tok * D + col) = cvt4_fp8(a0, a1, a2, a3);
                else { u32x2 o; o.x = cvt_pk_bf16(a0, a1); o.y = cvt_pk_bf16(a2, a3); *(u32x2*)((bf16*)u2 + (size_t)tok * D + col) = o; }
                LAS float* d = UT + tl * UTP + col; *(LAS f32x2*)d = (f32x2){a0, a1}; *(LAS f32x2*)(d + 2) = (f32x2){a2, a3}; } }
        __syncthreads();
        f32x4 acc[2] = {(f32x4){0.f, 0.f, 0.f, 0.f}, (f32x4){0.f, 0.f, 0.f, 0.f}};
#define P7_FENCE asm volatile("" ::: "memory")
        P7_FENCE; P7_LOADRW(rwb, 1); P7_FENCE; P7_MMA(rwa, 0); P7_FENCE; P7_LOADRW(rwa, 2); P7_FENCE; P7_MMA(rwb, 1); P7_FENCE; P7_LOADRW(rwb, 3); P7_FENCE; P7_MMA(rwa, 2); P7_FENCE; P7_MMA(rwb, 3);
#undef P7_FENCE
        __syncthreads();
        LAS float* PL = UT;
#pragma unroll
        for (int nt = 0; nt < 2; ++nt)
#pragma unroll
            for (int r = 0; r < 4; ++r) PL[(w * 16 + 4 * q + r) * 32 + 16 * nt + c16] = acc[nt][r];
        __syncthreads();
        { const int tl = F.tid >> 5, e = F.tid & 31, tok = grp * 16 + tl;
          float lg = F.router_b[e];
#pragma unroll
          for (int ww = 0; ww < 8; ++ww) lg += PL[(ww * 16 + tl) * 32 + e];
          bool taken = false; float tv[4]; int ti[4];
#pragma unroll
          for (int k = 0; k < 4; ++k) { float cv = taken ? -3.0e38f : lg; int ci = e;
#pragma unroll
              for (int o = 16; o >= 1; o >>= 1) { const float ov = __shfl_xor(cv, o); const int oi = __shfl_xor(ci, o); const bool better = (ov > cv) || (ov == cv && oi < ci); cv = better ? ov : cv; ci = better ? oi : ci; }
              tv[k] = cv; ti[k] = ci; if (e == ci) taken = true; }
          const float e1 = __expf(tv[1] - tv[0]), e2 = __expf(tv[2] - tv[0]), e3 = __expf(tv[3] - tv[0]), inv = 1.0f / (1.0f + e1 + e2 + e3);
          if (e < 4) { const int ex = e == 0 ? ti[0] : (e == 1 ? ti[1] : (e == 2 ? ti[2] : ti[3])); const float gt = (e == 0 ? 1.0f : (e == 1 ? e1 : (e == 2 ? e2 : e3))) * inv;
              const unsigned pos = __hip_atomic_fetch_add((unsigned*)(F.ctl + CW_CNT + 64 * ex), 1u, RLX_AGENT);
              WSP(int, WS_SLOTTOK)[ex * T + (int)pos] = tok; WSP(int, WS_TOKE)[tok * 4 + e] = ex; WSP(int, WS_TOKPOS)[tok * 4 + e] = (int)pos; WSP(float, WS_GATE)[tok * 4 + e] = gt; } }
    }
}

#undef P7_LOADRW
#undef P7_MMA
__device__ __forceinline__ void moe_tables(Frame& F) {
    __syncthreads();
    if (F.tid < NEXP) F.LW[LW_CNT + F.tid] = __hip_atomic_load((unsigned*)(F.ctl + CW_CNT + 64 * F.tid), RLX_AGENT);
    __syncthreads();
    if (F.tid == 0) { unsigned a = 0; for (int e = 0; e < NEXP; ++e) { F.LW[LW_RBS + e] = a; a += (F.LW[LW_CNT + e] + 255u) >> 8; } F.LW[LW_RBS + NEXP] = a; }
    __syncthreads();
}

__device__ __forceinline__ void p10_combine(Frame& F) {
    const int gw = blockIdx.x * NWAVES + F.wave, NGW = F.G * NWAVES, lane = F.lane;
    const bf16* h1 = WSP(const bf16, WS_H1); const uchar* yb = WSP(const uchar, WS_YB);
    const int* toke = WSP(const int, WS_TOKE); const int* tokp = WSP(const int, WS_TOKPOS); const float* gate = WSP(const float, WS_GATE);
    f32x4 nw[4][2];
#pragma unroll
    for (int jj = 0; jj < 4; ++jj) { const int col = 8 * (lane + 64 * jj); nw[jj][0] = *(const f32x4*)(F.norm_final_w + col); nw[jj][1] = *(const f32x4*)(F.norm_final_w + col + 4); }
    int tok = gw;
    i32x4_t en = (i32x4_t){0, 0, 0, 0}, pn = (i32x4_t){0, 0, 0, 0}; f32x4 gn = (f32x4){0.f, 0.f, 0.f, 0.f};
    if (tok < T) { en = *(const i32x4_t*)(toke + tok * 4); pn = *(const i32x4_t*)(tokp + tok * 4); gn = *(const f32x4*)(gate + tok * 4); }
    for (; tok < T; tok += NGW) {
        const i32x4_t ec = en, pc = pn; const f32x4 gc = gn;
        const int tnext = tok + NGW;
        if (tnext < T) { en = *(const i32x4_t*)(toke + tnext * 4); pn = *(const i32x4_t*)(tokp + tnext * 4); gn = *(const f32x4*)(gate + tnext * 4); }
        float hv[4][8];
#pragma unroll
        for (int jj = 0; jj < 4; ++jj) { const u32x4 a = *(const u32x4*)(h1 + (size_t)tok * D + 8 * (lane + 64 * jj));
            hv[jj][0] = bflo(a.x); hv[jj][1] = bfhi(a.x); hv[jj][2] = bflo(a.y); hv[jj][3] = bfhi(a.y); hv[jj][4] = bflo(a.z); hv[jj][5] = bfhi(a.z); hv[jj][6] = bflo(a.w); hv[jj][7] = bfhi(a.w); }
#pragma unroll
        for (int k = 0; k < 4; ++k) { const int e = ec[k], pos = pc[k]; const float gt = gc[k] * (1.0f / YBS);
            const size_t slot = (size_t)F.LW[LW_RBS + e] * 256 + pos;
#pragma unroll
            for (int jj = 0; jj < 4; ++jj) { const u32x2 v = *(const u32x2*)(yb + slot * D + 8 * (lane + 64 * jj));
                const f32x2 p0 = __builtin_amdgcn_cvt_pk_f32_fp8((int)v.x, false), p1 = __builtin_amdgcn_cvt_pk_f32_fp8((int)v.x, true), p2 = __builtin_amdgcn_cvt_pk_f32_fp8((int)v.y, false), p3 = __builtin_amdgcn_cvt_pk_f32_fp8((int)v.y, true);
                hv[jj][0] += gt * p0[0]; hv[jj][1] += gt * p0[1]; hv[jj][2] += gt * p1[0]; hv[jj][3] += gt * p1[1]; hv[jj][4] += gt * p2[0]; hv[jj][5] += gt * p2[1]; hv[jj][6] += gt * p3[0]; hv[jj][7] += gt * p3[1]; } }
        float s = 0.f;
#pragma unroll
        for (int jj = 0; jj < 4; ++jj)
#pragma unroll
            for (int e = 0; e < 8; ++e) s += hv[jj][e] * hv[jj][e];
        const float rstd = rsqrtf(wave_sum(s) * (1.f / D) + EPS);
#pragma unroll
        for (int jj = 0; jj < 4; ++jj) { const int col = 8 * (lane + 64 * jj);
            float* o = F.out + (size_t)tok * D + col;
            *(f32x4*)o = (f32x4){hv[jj][0] * rstd * nw[jj][0][0], hv[jj][1] * rstd * nw[jj][0][1], hv[jj][2] * rstd * nw[jj][0][2], hv[jj][3] * rstd * nw[jj][0][3]};
            *(f32x4*)(o + 4) = (f32x4){hv[jj][4] * rstd * nw[jj][1][0], hv[jj][5] * rstd * nw[jj][1][1], hv[jj][6] * rstd * nw[jj][1][2], hv[jj][7] * rstd * nw[jj][1][3]}; }
    }
}

struct Args { const float* in[21]; float* out; unsigned char* ws; int ph_lo, ph_hi, li, pad; };
__global__ void __launch_bounds__(NWAVES * 64, 2) mk_fwd(Args args) {
    extern __shared__ __attribute__((aligned(16))) unsigned char lds[];
    Frame F;
    F.lds = (LAS uchar*)lds; F.LW = (volatile LAS unsigned*)(F.lds + LDSCTL_OFF);
    F.tid = threadIdx.x; F.lane = F.tid & 63; F.wave = __builtin_amdgcn_readfirstlane(F.tid >> 6); F.G = gridDim.x;
    F.ws = args.ws; F.out = args.out; F.ctl = (gu32*)(args.ws + WS_CTL);
    F.x = args.in[0]; F.norm_mix_w = args.in[1]; F.w_in = args.in[2]; F.w_pool = args.in[3]; F.pool_scale = args.in[4]; F.conv_w = args.in[5]; F.conv_b = args.in[6];
    F.dt_bias = args.in[7]; F.a_log = args.in[8]; F.d_skip = args.in[9]; F.ssd_norm_w = args.in[10]; F.w_ssd_out = args.in[11]; F.w_out = args.in[12]; F.norm_ffn_w = args.in[13];
    F.router_w = args.in[14]; F.router_b = args.in[15]; F.w_up = args.in[16]; F.b_up = args.in[17]; F.w_down = args.in[18]; F.b_down = args.in[19]; F.norm_final_w = args.in[20];
    for (int u = F.tid; u < 256; u += NWAVES * 64) F.LW[u] = 0u;
    __syncthreads();
    XcdBarrier bar; bar.bar = (unsigned*)(F.ctl + CW_BAR) + args.li * XCD_BAR_WORDS; bar.x = 0; bar.st = nullptr;
    if (N_LAUNCHES != NPHASES) bar = xcd_barrier_post((unsigned*)(F.ctl + CW_BAR) + args.li * XCD_BAR_WORDS, F.LW + LW_BAR);
    const int lo = args.ph_lo, hi = args.ph_hi;
#define IN(k) (lo <= (k) && (k) < hi)
#define SEAM(k) do { if (IN(k) && IN((k) + 1)) xcd_barrier(bar); } while (0)

    const bool split = (F.G == 256);
    const int bx = (int)blockIdx.x, xcd_ = bx & 7, slot_ = bx >> 3;
    const bool gemm_wg = !split || xcd_ < 6;
    const int G1 = split ? 192 : F.G, c1 = split ? slot_ * 6 + xcd_ : bx;
    if (IN(0)) { REPS(0) p0_prologue(F, !split); } SEAM(0);

    if (IN(1)) {
        if (gemm_wg) {
            { EpiInProj E{WSP(bf16, WS_XP), WSP(bf16, WS_Z), WSP(bf16, WS_XBC), WSP(bf16, WS_GP), WSP(bf16, WS_GS), WSP(float, WS_DT)};
              DenseOrder S; S.to.init(T / 256, 49, G1, c1, split ? 6 : 8); S.skip_lo = 48; S.skip_n = 16; S.Bt = WSP(const bf16, WS_WIN); S.K = D;
              pg8::gemm_phase<EpiInProj, DenseOrder, PG8_ALIGN, PG8_SP2>(F.lds, WSP(const bf16, WS_U), D, S, E); }
            __syncthreads();
            { EpiInProjT<true> E{WSP(bf16, WS_XP), WSP(bf16, WS_Z), WSP(bf16, WS_XBC), WSP(bf16, WS_GP), WSP(bf16, WS_GS), WSP(float, WS_DT)};
              DenseOrder S; S.K = D / 2; S.Bt = (const bf16*)(WSP(const char, WS_WIN8) - (size_t)48 * 256 * 2048);
              if (!split) { S.to.init(T / 256, 16, G1, c1, 8); S.pn0 = 48; }
              else if (c1 < 64) { S.to.init(T / 256, 4, 64, c1, 6); S.pn0 = 60; }
              else { S.to.init(T / 256, 12, 128, c1 - 64, 6); S.pn0 = 48; }
              pg8::gemm_phase<EpiInProjT<true>, DenseOrder, PG8_ALIGN, PG8_SP2, true>(F.lds, WSP(const bf16, WS_U8), D / 2, S, E); }
        } else p1_convert_late(F, (slot_ * 2 + (xcd_ - 6)) * NWAVES + F.wave, 64 * NWAVES);
    } SEAM(1);

    if (IN(2)) {
        if (split) { p0_convert<1>(F, (int)blockIdx.x * NWAVES + F.wave, F.G * NWAVES); __syncthreads(); }
        REPS(12) p2_pool_items(F);
        REPS(3) for (int u = blockIdx.x; u < 1024; u += F.G) p2_states_unit(F, u);
    } SEAM(2);

    if (IN(3)) {
        PoolOrder S{F.G, (int)blockIdx.x, WSP(const bf16, WS_WPOOL)};
        EpiPool E{WSP(bf16, WS_MERGED), WSP(const bf16, WS_GP), F.pool_scale};
        pg8::gemm_phase<EpiPool, PoolOrder, PG8_ALIGN, PG8_SP2>(F.lds, WSP(const bf16, WS_POOLED), 512, S, E);
        p3_scan(F);
    } SEAM(3);

    if (IN(5)) { REPS(5) for (int u = blockIdx.x; u < 1024; u += F.G) p4_unit(F, u); } SEAM(5);

    if (IN(6)) {
        DenseOrder S; S.to.init(T / 256, D / 256, F.G, (int)blockIdx.x); S.Bt = WSP(const bf16, WS_WSSD); S.K = ZI;
        EpiSsdOut E{WSP(bf16, WS_MERGED), WSP(const bf16, WS_GS)};
        pg8::gemm_phase<EpiSsdOut, DenseOrder, PG8_ALIGN, PG8_SP2>(F.lds, WSP(const bf16, WS_YG), ZI, S, E);
    } SEAM(6);

    if (IN(7)) {
        DenseOrder S; S.to.init(T / 256, D / 256, F.G, (int)blockIdx.x); S.Bt = WSP(const bf16, WS_WOUT); S.K = D;
        EpiWout E{F.x, WSP(bf16, WS_H1)};
        pg8::gemm_phase<EpiWout, DenseOrder, PG8_ALIGN, PG8_SP2>(F.lds, WSP(const bf16, WS_MERGED), D, S, E);
    } SEAM(7);

    if (IN(8)) { p7_router(F); } SEAM(8);

    if (IN(9)) {
        moe_tables(F);
        MoeOrder S; S.to.init((int)F.LW[LW_RBS + NEXP], 16, F.G, (int)blockIdx.x); S.Bt = WSP(const bf16, WS_WUP); S.K = MOE_FP8 ? D / 2 : D; S.estride_bytes = (size_t)4096 * 2048 * (MOE_FP8 ? 1 : 2); S.LW = F.LW; S.slot_tok = WSP(const int, WS_SLOTTOK); S.gather = true;
        EpiUp E{WSP(uchar, WS_ACT), F.b_up};
        pg8::gemm_phase<EpiUp, MoeOrder, PG8_ALIGN, PG8_SP2, MOE_FP8 != 0>(F.lds, WSP(const bf16, WS_U), MOE_FP8 ? D / 2 : D, S, E);
    } SEAM(9);

    if (IN(10)) {
        moe_tables(F);
        MoeOrder S; S.to.init((int)F.LW[LW_RBS + NEXP], 8, F.G, (int)blockIdx.x); S.Bt = WSP(const bf16, WS_WDOWN); S.K = MOE_FP8 ? D / 2 : D; S.estride_bytes = (size_t)2048 * 2048 * (MOE_FP8 ? 1 : 2); S.LW = F.LW; S.slot_tok = WSP(const int, WS_SLOTTOK); S.gather = false;
        EpiDown E{WSP(uchar, WS_YB), F.b_down};
        pg8::gemm_phase<EpiDown, MoeOrder, PG8_ALIGN, PG8_SP2, MOE_FP8 != 0>(F.lds, WSP(const bf16, WS_ACT), MOE_FP8 ? D / 2 : D, S, E);
    } SEAM(10);

    if (IN(11)) { moe_tables(F); REPS(11) p10_combine(F); }
#undef IN
#undef SEAM
}

extern "C" void kernel_launch(void* const* d_in, const int* in_sizes, int n_in, void* d_out, int out_size, void* d_ws, size_t ws_size, hipStream_t stream) {
    static int grid = 0;
    if (grid == 0) {
        if (n_in != 21 || in_sizes[0] != T * D || out_size != T * D || ws_size < WS_END) { fprintf(stderr, "kernel_launch: unexpected shapes (n_in %d, in0 %d, out %d, ws %zu < %zu); nothing launched\n", n_in, n_in > 0 ? in_sizes[0] : -1, out_size, ws_size, (size_t)WS_END); grid = -1; return; }
        int dev = 0, cus = 0, per_cu = 0;
        if (hipGetDevice(&dev) != hipSuccess || hipDeviceGetAttribute(&cus, hipDeviceAttributeMultiprocessorCount, dev) != hipSuccess) { grid = -1; return; }
        if (hipFuncSetAttribute((const void*)mk_fwd, hipFuncAttributeMaxDynamicSharedMemorySize, LDS_BYTES) != hipSuccess) { fprintf(stderr, "kernel_launch: hipFuncSetAttribute failed\n"); grid = -1; return; }
        if (hipOccupancyMaxActiveBlocksPerMultiprocessor(&per_cu, (const void*)mk_fwd, NWAVES * 64, LDS_BYTES) != hipSuccess || per_cu < 1)
            fprintf(stderr, "kernel_launch: note: occupancy query reports %d workgroups per CU\n", per_cu);
        (void)hipGetLastError();
        grid = cus;
    }
    if (grid < 0) return;
    if (hipMemsetAsync((char*)d_ws + WS_CTL, 0, CTL_ZERO_BYTES, stream) != hipSuccess) return;
    Args a{};
    for (int i = 0; i < 21; ++i) a.in[i] = (const float*)d_in[i];
    a.out = (float*)d_out; a.ws = (unsigned char*)d_ws;
    int lo = 0, li = 0;
    for (int k = 1; k <= NPHASES; ++k) {
        const bool cut = (k == NPHASES) || (N_LAUNCHES == NPHASES) || (N_LAUNCHES != 1 && ((MK_CUTS >> k) & 1));
        if (!cut) continue;
        a.ph_lo = lo; a.ph_hi = k; a.li = li; lo = k; ++li;
        hipLaunchKernelGGL(mk_fwd, dim3(grid), dim3(NWAVES * 64), LDS_BYTES, stream, a);
        const hipError_t le = hipPeekAtLastError();
        if (le != hipSuccess) { fprintf(stderr, "kernel_launch: launch %d failed: %s\n", li, hipGetErrorName(le)); break; }
    }
}
```

```cpp
#include <hip/hip_runtime.h>
#include <cstdio>
#include <cstdint>

#ifndef MK_N_LAUNCHES
#define MK_N_LAUNCHES 1
#endif

#define LAS __attribute__((address_space(3)))
#define GAS __attribute__((address_space(1)))
typedef unsigned short bf16;
typedef unsigned char uchar;
typedef short bf16x8 __attribute__((ext_vector_type(8)));
typedef float f32x4 __attribute__((ext_vector_type(4)));
typedef float f32x2 __attribute__((ext_vector_type(2)));
typedef unsigned u32x4 __attribute__((ext_vector_type(4)));
typedef unsigned u32x2 __attribute__((ext_vector_type(2)));
typedef int i32x8 __attribute__((ext_vector_type(8)));
typedef int i32x4_t __attribute__((ext_vector_type(4)));
typedef GAS unsigned gu32;
#define RLX_AGENT __ATOMIC_RELAXED, __HIP_MEMORY_SCOPE_AGENT
#define LDS_WAIT() asm volatile("s_waitcnt lgkmcnt(0)" ::: "memory")
#define VM_WAIT() asm volatile("s_waitcnt vmcnt(0)" ::: "memory")

__device__ __forceinline__ unsigned cvt_pk_bf16(float lo, float hi) { unsigned r; asm volatile("v_cvt_pk_bf16_f32 %0, %1, %2" : "=v"(r) : "v"(lo), "v"(hi)); return r; }
typedef __bf16 bf16x2_t __attribute__((ext_vector_type(2)));
__device__ __forceinline__ unsigned cvt_pk_bf16_v(float lo, float hi) { const f32x2 v = {lo, hi}; return __builtin_bit_cast(unsigned, __builtin_convertvector(v, bf16x2_t)); }
__device__ __forceinline__ unsigned cvt4_fp8(float a, float b, float c, float d) { int w = 0; w = __builtin_amdgcn_cvt_pk_fp8_f32(a, b, w, false); w = __builtin_amdgcn_cvt_pk_fp8_f32(c, d, w, true); return (unsigned)w; }
__device__ __forceinline__ float bflo(unsigned u) { return __uint_as_float(u << 16); }
__device__ __forceinline__ float bfhi(unsigned u) { return __uint_as_float(u & 0xffff0000u); }
__device__ __forceinline__ float sigmoidf_(float x) { return __builtin_amdgcn_rcpf(1.0f + __expf(-x)); }
__device__ __forceinline__ float siluf_(float x) { return x * __builtin_amdgcn_rcpf(1.0f + __expf(-x)); }
__device__ __forceinline__ float wave_sum(float v) {
#pragma unroll
    for (int o = 1; o < 64; o <<= 1) v += __shfl_xor(v, o);
    return v;
}

constexpr int T = 16384, D = 2048, SEQ = 8192;
constexpr int ZI = 4096, XBCW = 6144, NH = 64, NPAD = 16640, INCOLS = 16448;
constexpr int NEXP = 32;
constexpr float EPS = 1e-5f;

namespace pg8 {
constexpr int BM = 256, BK = 64, HALF = 128, HTB = HALF * BK * 2, STAGE_BYTES = 8 * HTB, NXCD = 8, WGM = 8;
__host__ __device__ __forceinline__ int lds_byte(int r, int c) { const int st = (r >> 4) * 2 + (c >> 5), rr = r & 15, cc = c & 31, ob = rr * 64 + cc * 2; return st * 1024 + (ob ^ (((ob >> 9) & 1) << 5)); }
__host__ __device__ __forceinline__ void stage_rc(int b, int& R, int& C) { const int st = b / 1024, sb = b % 1024, swz = sb ^ (((sb >> 9) & 1) << 5); R = (st >> 1) * 16 + swz / 64; C = (st & 1) * 32 + (swz % 64) / 2; }
__host__ __device__ __forceinline__ int perm32(int rho) { const int n = rho >> 4, i = rho & 15; return 8 * (i >> 2) + 4 * n + (i & 3); }

struct Unit { int pm, pn, e; };

struct TileOrder {
    int nM, nN, nwg, G, c, nx;
    __device__ __forceinline__ void init(int nM_, int nN_, int G_, int c_, int nx_ = NXCD) { nM = nM_; nN = nN_; nwg = nM * nN; G = G_; c = c_; nx = nx_; }
    __device__ __forceinline__ bool tile(int i, int& pm, int& pn) const {
        const long L = (long)i * G + c; if (L >= nwg) return false;
        int wgid = (int)L; { const int q = nwg / nx, r = nwg % nx, xcd = wgid % nx, off = wgid / nx; wgid = (xcd < r ? xcd * (q + 1) : r * (q + 1) + (xcd - r) * q) + off; }
        const int nig = WGM * nN, gid = wgid / nig, fm = gid * WGM, gsz = (nM - fm) < WGM ? (nM - fm) : WGM;
        pm = fm + ((wgid % nig) % gsz); pn = (wgid % nig) / gsz; return true;
    }
};

template <class Epi, class Sched, bool ALIGN_EPI, bool SP2, bool FP8 = false>
__device__ __forceinline__ void gemm_phase(LAS uchar* lds, const bf16* Abase, const int K, const Sched& S, const Epi& E) {
    const int tid = threadIdx.x, wid = __builtin_amdgcn_readfirstlane(tid >> 6), lane = tid & 63, wr = wid >> 2, wc = wid & 3, fr = lane & 15, fq = lane >> 4;
    const int nt = K / BK;
    unsigned voffB[2];
#pragma unroll
    for (int i = 0; i < 2; ++i) { int R, C; stage_rc(tid * 16 + i * 8192, R, C); const int Rb = Epi::PERM ? ((R & ~31) + perm32(R & 31)) : R;
        voffB[i] = (unsigned)(Rb * K + C) * 2u; }
#define PG8_AOFFS(dst, u) do { _Pragma("unroll") for (int h = 0; h < 2; ++h) _Pragma("unroll") for (int i = 0; i < 2; ++i) { int R, C; stage_rc(tid * 16 + i * 8192, R, C); \
        dst[h][i] = S.arow(u, h * HALF + R) + (unsigned)C * 2u; } } while (0)
    const size_t kstep = (size_t)(BK * 2);
    const size_t hstep = (size_t)HALF * K * 2;
    const unsigned ldsw = (unsigned)wid * 1024u;
    const int aoff = lds_byte(wr * 64 + fr, fq * 8), boff = lds_byte(wc * 32 + fr, fq * 8);
#define PG8_SA(b, h) (((b) * 2 + (h)) * HTB)
#define PG8_SB(b, h) ((4 + (b) * 2 + (h)) * HTB)
#define PG8_STAGE(bufoff, gbase, voff) do { _Pragma("unroll") for (int _i = 0; _i < 2; ++_i) \
        __builtin_amdgcn_global_load_lds((const unsigned*)((const char*)(gbase) + (voff)[_i]), (LAS unsigned*)(lds + (bufoff) + ldsw + _i * 8192), 16, 0, 0); } while (0)
#define PG8_RD(off) (*(const LAS u32x4*)(lds + (off)))
#define PG8_LDA(dst, b, h) do { _Pragma("unroll") for (int m = 0; m < 4; ++m) { if constexpr (FP8) dst##8[m] = __builtin_bit_cast(i32x8, __builtin_shufflevector(PG8_RD(PG8_SA(b, h) + aoff + m * 2048), PG8_RD(PG8_SA(b, h) + aoff + m * 2048 + 1024), 0, 1, 2, 3, 4, 5, 6, 7)); \
        else { _Pragma("unroll") for (int k = 0; k < 2; ++k) dst[m][k] = *(const LAS bf16x8*)(lds + PG8_SA(b, h) + aoff + m * 2048 + k * 1024); } } } while (0)
#define PG8_LDB(dst, b, h) do { _Pragma("unroll") for (int n = 0; n < 2; ++n) { if constexpr (FP8) dst##8[n] = __builtin_bit_cast(i32x8, __builtin_shufflevector(PG8_RD(PG8_SB(b, h) + boff + n * 2048), PG8_RD(PG8_SB(b, h) + boff + n * 2048 + 1024), 0, 1, 2, 3, 4, 5, 6, 7)); \
        else { _Pragma("unroll") for (int k = 0; k < 2; ++k) dst[n][k] = *(const LAS bf16x8*)(lds + PG8_SB(b, h) + boff + n * 2048 + k * 1024); } } } while (0)
#define PG8_MMA(ai, bj, At, Bt) do { __builtin_amdgcn_s_setprio(1); _Pragma("unroll") for (int m = 0; m < 4; ++m) _Pragma("unroll") for (int n = 0; n < 2; ++n) { \
        if constexpr (FP8) { asm volatile("v_mfma_scale_f32_16x16x128_f8f6f4 %0, %1, %2, %0, %3, %4 op_sel_hi:[0,0,0]" : "+v"(acc[ai][bj][m][n]) : "v"(Bt##8[n]), "v"(At##8[m]), "v"(sc_1), "v"(sc_1)); } \
        else { _Pragma("unroll") for (int k = 0; k < 2; ++k) acc[ai][bj][m][n] = __builtin_amdgcn_mfma_f32_16x16x32_bf16(Bt[n][k], At[m][k], acc[ai][bj][m][n], 0, 0, 0); } } \
        __builtin_amdgcn_s_setprio(0); } while (0)
#define PG8_WAIT_V(n) asm volatile("s_waitcnt vmcnt(" #n ")" ::: "memory")
#define PG8_WAIT_L(n) asm volatile("s_waitcnt lgkmcnt(" #n ")" ::: "memory")
#define PG8_BAR __builtin_amdgcn_s_barrier()
#define PG8_SCHED __builtin_amdgcn_sched_barrier(0)
    Unit cur, nxt; int ui = 0;
    if (!S.next(0, cur)) return;
    f32x4 acc[2][2][4][2];
#pragma unroll
    for (int a = 0; a < 2; ++a)
#pragma unroll
        for (int b = 0; b < 2; ++b)
#pragma unroll
            for (int m = 0; m < 4; ++m)
#pragma unroll
                for (int n = 0; n < 2; ++n) acc[a][b][m][n] = (f32x4){0.f, 0.f, 0.f, 0.f};
    bf16x8 At[4][2], B0[2][2], B1[2][2];
    i32x8 At8[4], B08[2], B18[2];
    int sc_1 = 0x7F7F7F7F;
    if constexpr (FP8) asm volatile("" : "+v"(sc_1));
    unsigned vA[2][2];
    LAS u32x4* nva_lds = (LAS u32x4*)(lds + STAGE_BYTES) + tid;
    PG8_AOFFS(vA, cur); *nva_lds = (u32x4){vA[0][0], vA[0][1], vA[1][0], vA[1][1]};
    const char* cA = (const char*)Abase; const char* cB = S.bbase(cur);
    if constexpr (SP2) {
        PG8_STAGE(PG8_SB(0, 0), cB, voffB); PG8_STAGE(PG8_SB(0, 1), cB + hstep, voffB); PG8_STAGE(PG8_SA(0, 0), cA, vA[0]); PG8_STAGE(PG8_SA(0, 1), cA, vA[1]);
        if (wr == 1) PG8_BAR;
        PG8_WAIT_V(2); PG8_BAR;
        PG8_STAGE(PG8_SB(1, 0), cB + kstep, voffB); PG8_STAGE(PG8_SA(1, 0), cA + kstep, vA[0]); PG8_STAGE(PG8_SB(1, 1), cB + hstep + kstep, voffB);
        PG8_WAIT_V(6); PG8_BAR;
    } else {
        PG8_STAGE(PG8_SB(0, 0), cB, voffB); PG8_STAGE(PG8_SA(0, 0), cA, vA[0]); PG8_STAGE(PG8_SB(0, 1), cB + hstep, voffB); PG8_STAGE(PG8_SA(0, 1), cA, vA[1]);
        if (wr == 1) PG8_BAR;
        PG8_WAIT_V(4); PG8_BAR;
        PG8_STAGE(PG8_SB(1, 0), cB + kstep, voffB); PG8_STAGE(PG8_SA(1, 0), cA + kstep, vA[0]); PG8_STAGE(PG8_SB(1, 1), cB + hstep + kstep, voffB);
        PG8_WAIT_V(6); PG8_BAR;
    }
    for (;;) {
        const bool has_next = S.next(ui + 1, nxt);
        const char* nB = has_next ? S.bbase(nxt) : cB;
        if (has_next) { unsigned nvA[2][2]; PG8_AOFFS(nvA, nxt); *nva_lds = (u32x4){nvA[0][0], nvA[0][1], nvA[1][0], nvA[1][1]}; }
        for (int t = 0; t < nt; t += 2) {
            const bool last = (t == nt - 2);
            const char* a1 = cA + (size_t)(t + 1) * kstep;
            const char* a2 = last ? cA : cA + (size_t)(t + 2) * kstep; const char* b2 = last ? nB : cB + (size_t)(t + 2) * kstep;
            const char* a3 = a2 + kstep; const char* b3 = b2 + kstep;
#define PG8_SWAPA do { if (last) { const u32x4 t_ = *nva_lds; vA[0][0] = t_[0]; vA[0][1] = t_[1]; vA[1][0] = t_[2]; vA[1][1] = t_[3]; } } while (0)
            if constexpr (SP2) {
            PG8_LDB(B0, 0, 0); PG8_LDB(B1, 0, 1); PG8_SCHED; PG8_LDA(At, 0, 0); PG8_STAGE(PG8_SA(1, 1), a1, vA[1]); PG8_SWAPA;
            PG8_WAIT_V(8); PG8_WAIT_L(0); PG8_BAR; PG8_MMA(0, 0, At, B0); PG8_MMA(0, 1, At, B1); PG8_BAR; PG8_SCHED;
            PG8_LDA(At, 0, 1); PG8_STAGE(PG8_SB(0, 0), b2, voffB); PG8_STAGE(PG8_SB(0, 1), b2 + hstep, voffB); PG8_STAGE(PG8_SA(0, 0), a2, vA[0]);
            PG8_WAIT_V(8); PG8_WAIT_L(0); PG8_BAR; PG8_MMA(1, 0, At, B0); PG8_MMA(1, 1, At, B1); PG8_BAR; PG8_SCHED;
            PG8_LDB(B0, 1, 0); PG8_LDB(B1, 1, 1); PG8_SCHED; PG8_LDA(At, 1, 0); PG8_STAGE(PG8_SA(0, 1), a2, vA[1]);
            PG8_WAIT_V(8); PG8_WAIT_L(0); PG8_BAR; PG8_MMA(0, 0, At, B0); PG8_MMA(0, 1, At, B1); PG8_BAR; PG8_SCHED;
            PG8_LDA(At, 1, 1); PG8_STAGE(PG8_SB(1, 0), b3, voffB); PG8_STAGE(PG8_SB(1, 1), b3 + hstep, voffB); PG8_STAGE(PG8_SA(1, 0), a3, vA[0]);
            PG8_WAIT_V(8); PG8_WAIT_L(0); PG8_BAR; PG8_MMA(1, 0, At, B0); PG8_MMA(1, 1, At, B1); PG8_BAR; PG8_SCHED;
            } else {
            PG8_LDB(B0, 0, 0); PG8_SCHED; PG8_LDA(At, 0, 0); PG8_STAGE(PG8_SA(1, 1), a1, vA[1]); PG8_SWAPA;
            PG8_WAIT_L(8); PG8_BAR; PG8_WAIT_L(0); PG8_MMA(0, 0, At, B0); PG8_BAR; PG8_SCHED;
            PG8_LDB(B1, 0, 1); PG8_STAGE(PG8_SB(0, 0), b2, voffB);
            PG8_BAR; PG8_WAIT_L(0); PG8_MMA(0, 1, At, B1); PG8_BAR;
            PG8_LDA(At, 0, 1); PG8_STAGE(PG8_SA(0, 0), a2, vA[0]);
            PG8_BAR; PG8_WAIT_L(0); PG8_MMA(1, 0, At, B0); PG8_BAR; PG8_SCHED;
            PG8_STAGE(PG8_SB(0, 1), b2 + hstep, voffB);
            PG8_WAIT_V(6); PG8_BAR; PG8_MMA(1, 1, At, B1); PG8_BAR;
            PG8_LDB(B0, 1, 0); PG8_SCHED; PG8_LDA(At, 1, 0); PG8_STAGE(PG8_SA(0, 1), a2, vA[1]);
            PG8_WAIT_L(8); PG8_BAR; PG8_WAIT_L(0); PG8_MMA(0, 0, At, B0); PG8_BAR; PG8_SCHED;
            PG8_LDB(B1, 1, 1); PG8_STAGE(PG8_SB(1, 0), b3, voffB);
            PG8_BAR; PG8_WAIT_L(0); PG8_MMA(0, 1, At, B1); PG8_BAR;
            PG8_LDA(At, 1, 1); PG8_STAGE(PG8_SA(1, 0), a3, vA[0]);
            PG8_BAR; PG8_WAIT_L(0); PG8_MMA(1, 0, At, B0); PG8_BAR; PG8_SCHED;
            PG8_STAGE(PG8_SB(1, 1), b3 + hstep, voffB);
            PG8_WAIT_V(6); PG8_BAR; PG8_MMA(1, 1, At, B1); PG8_BAR;
            }
        }
        if constexpr (ALIGN_EPI) { if (wr == 0) PG8_BAR; }
        if constexpr (FP8) asm volatile("s_nop 15\n\ts_nop 15" ::: "memory");
        E(acc, cur, wr, wc, fr, fq);
        if constexpr (FP8) asm volatile("s_nop 7" ::: "memory");
        if (!has_next) break;
#pragma unroll
        for (int a = 0; a < 2; ++a)
#pragma unroll
            for (int b = 0; b < 2; ++b)
#pragma unroll
                for (int m = 0; m < 4; ++m)
#pragma unroll
                    for (int n = 0; n < 2; ++n) acc[a][b][m][n] = (f32x4){0.f, 0.f, 0.f, 0.f};
        cur = nxt; cB = nB; ++ui;
        if constexpr (ALIGN_EPI) { if (wr == 1) PG8_BAR; }
    }
    PG8_WAIT_V(0);
    if constexpr (!ALIGN_EPI) { if (wr == 0) PG8_BAR; }
    PG8_BAR;
#undef PG8_SA
#undef PG8_SB
#undef PG8_STAGE
#undef PG8_RD
#undef PG8_AOFFS
#undef PG8_SWAPA
#undef PG8_LDA
#undef PG8_LDB
#undef PG8_MMA
#undef PG8_WAIT_V
#undef PG8_WAIT_L
#undef PG8_BAR
#undef PG8_SCHED
}
}

#ifndef PG8_SP2
#define PG8_SP2 true
#endif
#ifndef PG8_ALIGN
#define PG8_ALIGN true
#endif

constexpr int NWAVES = 8;
constexpr int NPHASES = 12;
constexpr int N_LAUNCHES = MK_N_LAUNCHES;
#ifndef MOE_FP8
#define MOE_FP8 1
#endif
#ifndef MK_DOUBLE
#define MK_DOUBLE -1
#endif
#define REPS(k) for (int rep_ = 0; rep_ < ((MK_DOUBLE) == (k) ? 2 : 1); ++rep_)
#ifndef MK_CUTS
#define MK_CUTS 0x7fe
#endif

constexpr size_t MiB = 1u << 20;
constexpr size_t WS_CTL = 0, CTL_ZERO_BYTES = 256 * 1024;
constexpr size_t WS_WIN = 1 * MiB, WS_WPOOL = 66 * MiB, WS_WSSD = 68 * MiB, WS_WOUT = 84 * MiB, WS_WUP = 92 * MiB, WS_WDOWN = 604 * MiB;
constexpr size_t WS_U = 860 * MiB, WS_XP = 924 * MiB, WS_Z = 988 * MiB, WS_XBC = 1116 * MiB, WS_GP = 1308 * MiB, WS_GS = 1372 * MiB, WS_DT = 1436 * MiB;
constexpr size_t WS_POOLED = 1440 * MiB, WS_STATES = 1504 * MiB, WS_CDEC = 1632 * MiB, WS_YG = 1633 * MiB, WS_MERGED = 1761 * MiB, WS_H1 = 1825 * MiB;
constexpr size_t WS_ACT = 1953 * MiB, WS_YB = 2241 * MiB, WS_SLOTTOK = 2529 * MiB, WS_TOKE = 2531 * MiB, WS_TOKPOS = 2532 * MiB, WS_GATE = 2533 * MiB, WS_XC = 2534 * MiB, WS_U8 = 2534 * MiB  , WS_WIN8 = 2574 * MiB  , WS_END = 2726 * MiB;
static_assert(WS_WIN + (size_t)NPAD * D * 2 <= WS_WPOOL && WS_WUP + (size_t)NEXP * 4096 * 2048 * 2 <= WS_WDOWN && WS_WDOWN + (size_t)NEXP * 2048 * 2048 * 2 <= WS_U, "ws map (weights)");
static_assert(WS_XBC + (size_t)T * XBCW * 2 <= WS_GP && WS_STATES + (size_t)2 * 64 * 64 * 64 * 128 * 2 <= WS_CDEC && WS_ACT + (size_t)288 * 256 * 2048 * 2 <= WS_YB && WS_YB + (size_t)288 * 256 * 2048 * 2 <= WS_SLOTTOK, "ws map");
constexpr int CW_TMO = 0, CW_BAR = 4096, CW_CNT = 49152;
static_assert((CW_CNT + 64 * NEXP) * 4 <= (int)CTL_ZERO_BYTES, "ctl");

constexpr int LDS_BYTES = 147456;
constexpr int LDSCTL_OFF = LDS_BYTES - 1024;
constexpr int LW_BAR = 8, LW_RBS = 16, LW_CNT = 64;

#define XB_TMO      128
#define XB_XCNT(j)  (256  + 64 * (j))
#define XB_XSUB(j)  (1280 + 64 * (j))
#define XB_XGEN(j)  (2304 + 64 * (j))
#define XB_TOP      3328
#define XB_TOPGEN   3392
#define XCD_BAR_WORDS 3456
#define XB_SPIN_CAP (1u << 18)
__device__ __forceinline__ unsigned xb_ld(unsigned* p)              { return __hip_atomic_load(p, __ATOMIC_RELAXED, __HIP_MEMORY_SCOPE_AGENT); }
__device__ __forceinline__ unsigned xb_add(unsigned* p, unsigned v) { return __hip_atomic_fetch_add(p, v, __ATOMIC_RELAXED, __HIP_MEMORY_SCOPE_AGENT); }
__device__ __forceinline__ unsigned xb_xcc_id() { return (unsigned)__builtin_amdgcn_s_getreg((3 << 11) | 20) & 0xFu; }
#define XB_SPIN(cond, bar) do { unsigned _sp = 0; while (cond) { __builtin_amdgcn_s_sleep(1); \
    if ((++_sp & 255u) == 0u) { if (xb_ld(&(bar)[XB_TMO])) break; if (_sp > XB_SPIN_CAP) { atomicAdd(&(bar)[XB_TMO], 1u); break; } } } } while (0)
struct XcdBarrier { unsigned* bar; unsigned x; volatile LAS unsigned* st; };
__device__ __forceinline__ XcdBarrier xcd_barrier_post(unsigned* bar, volatile LAS unsigned* st) {
    XcdBarrier b; b.bar = bar; b.x = xb_xcc_id(); b.st = st;
    if (threadIdx.x == 0) (void)xb_add(&bar[XB_XCNT(b.x)], 1u);
    return b;
}
__device__ __forceinline__ void xcd_barrier_complete(unsigned* bar, unsigned x, unsigned& nloc, unsigned& nx) {
    const unsigned G = gridDim.x * gridDim.y * gridDim.z;
    unsigned sum, cnt, mine, sp = 0u;
    for (;;) {
        sum = 0u; cnt = 0u; mine = 0u;
#pragma unroll
        for (unsigned j = 0; j < 16; ++j) { const unsigned c = xb_ld(&bar[XB_XCNT(j)]); sum += c; cnt += (c > 0u) ? 1u : 0u; mine = (j == x) ? c : mine; }
        if (sum == G) break;
        __builtin_amdgcn_s_sleep(1);
        if ((++sp & 255u) == 0u) { if (xb_ld(&bar[XB_TMO])) break; if (sp > XB_SPIN_CAP) { atomicAdd(&bar[XB_TMO], 1u); break; } }
    }
    nloc = mine > 0u ? mine : 1u; nx = cnt > 0u ? cnt : 1u;
}
__device__ __forceinline__ void xcd_barrier(const XcdBarrier& b) {
    asm volatile("s_waitcnt vmcnt(0)" ::: "memory");
    __syncthreads();
    if (threadIdx.x == 0) {
        unsigned* bar = b.bar;
        __builtin_amdgcn_s_waitcnt(0);
        unsigned nloc = b.st[0], nx = b.st[1];
        if (nloc == 0u) { xcd_barrier_complete(bar, b.x, nloc, nx); b.st[0] = nloc; b.st[1] = nx; }
        const unsigned old = xb_add(&bar[XB_XSUB(b.x)], 1u);
        const unsigned gen = old / nloc;
        if (old + 1u == (gen + 1u) * nloc) {
            __builtin_amdgcn_fence(__ATOMIC_RELEASE, "agent");
            asm volatile("s_waitcnt vmcnt(0)" ::: "memory");
            const unsigned og = xb_add(&bar[XB_TOP], 1u);
            const unsigned tg = og / nx;
            if (og + 1u == (tg + 1u) * nx) xb_add(&bar[XB_TOPGEN], 1u);
            else XB_SPIN(xb_ld(&bar[XB_TOPGEN]) == tg, bar);
            __builtin_amdgcn_fence(__ATOMIC_ACQUIRE, "agent");
            xb_add(&bar[XB_XGEN(b.x)], 1u);
            asm volatile("s_waitcnt vmcnt(0)" ::: "memory");
        } else {
            XB_SPIN(xb_ld(&bar[XB_XGEN(b.x)]) == gen, bar);
            __builtin_amdgcn_fence(__ATOMIC_ACQUIRE, "agent");
            asm volatile("s_waitcnt vmcnt(0)" ::: "memory");
        }
    }
    __syncthreads();
}

struct Frame {
    LAS uchar* lds; volatile LAS unsigned* LW; gu32* ctl;
    int tid, lane, wave, G;
    uchar* ws; float* out;
    const float *x, *norm_mix_w, *w_in, *w_pool, *pool_scale, *conv_w, *conv_b, *dt_bias, *a_log, *d_skip, *ssd_norm_w, *w_ssd_out, *w_out, *norm_ffn_w, *router_w, *router_b, *w_up, *b_up, *w_down, *b_down, *norm_final_w;
};
#define WSP(type, off) ((type*)(F.ws + (off)))

struct DenseOrder {
    pg8::TileOrder to; const bf16* Bt; int K; int pn0 = 0, skip_lo = 1 << 20, skip_n = 0;
    __device__ __forceinline__ bool next(int i, pg8::Unit& u) const { u.e = 0; const bool ok = to.tile(i, u.pm, u.pn); u.pn += pn0; if (u.pn >= skip_lo) u.pn += skip_n; return ok; }
    __device__ __forceinline__ unsigned arow(const pg8::Unit& u, int R) const { return (unsigned)(u.pm * 256 + R) * (unsigned)(K * 2); }
    __device__ __forceinline__ const char* bbase(const pg8::Unit& u) const { return (const char*)Bt + (size_t)u.pn * 256 * K * 2; }
};
struct PoolOrder {
    int G, c; const bf16* Bt;
    __device__ __forceinline__ bool next(int i, pg8::Unit& u) const { const int L = i * G + c; if (L >= 512) return false; u.e = L >> 7; u.pm = (L & 127) >> 1; u.pn = L & 1; return true; }
    __device__ __forceinline__ unsigned arow(const pg8::Unit& u, int R) const { return (unsigned)(u.e * T + u.pm * 256 + R) * 1024u; }
    __device__ __forceinline__ const char* bbase(const pg8::Unit& u) const { return (const char*)Bt + (size_t)(u.e * 512 + u.pn * 256) * 1024; }
};
struct MoeOrder {
    pg8::TileOrder to; const bf16* Bt; int K; size_t estride_bytes; volatile LAS unsigned* LW; const int* slot_tok; bool gather;
    __device__ __forceinline__ bool next(int i, pg8::Unit& u) const {
        if (!to.tile(i, u.pm, u.pn)) return false;
        int e = 0;
#pragma unroll 8
        for (int j = 1; j <= NEXP; ++j) e += ((int)LW[LW_RBS + j] <= u.pm) ? 1 : 0;
        u.e = __builtin_amdgcn_readfirstlane(e); return true;
    }
    __device__ __forceinline__ unsigned arow(const pg8::Unit& u, int R) const {
        if (!gather) return (unsigned)(u.pm * 256 + R) * (unsigned)(K * 2);
        const int idx = (u.pm - (int)LW[LW_RBS + u.e]) * 256 + R, cnt = (int)LW[LW_CNT + u.e];
        const int tok = slot_tok[u.e * T + (idx < cnt ? idx : 0)];
        return (unsigned)(idx < cnt ? tok : 0) * (unsigned)(K * 2);
    }
    __device__ __forceinline__ const char* bbase(const pg8::Unit& u) const { return (const char*)Bt + (size_t)u.e * estride_bytes + (size_t)u.pn * 256 * K * 2; }
};

template <bool F8>
struct EpiInProjT {
    static constexpr bool PERM = true;
    bf16 *xp, *z, *xbc, *gp, *gs; float* dt;
    __device__ __forceinline__ void operator()(const f32x4 (&acc)[2][2][4][2], const pg8::Unit& u, int wr, int wc, int fr, int fq) const {
        const int row0 = u.pm * 256 + wr * 64 + fr, pn = u.pn;
        if (pn == 64) {
            if (wc < 2) {
#pragma unroll
                for (int ai = 0; ai < 2; ++ai)
#pragma unroll
                    for (int m = 0; m < 4; ++m) { float* p = dt + (size_t)(row0 + ai * 128 + m * 16) * 64 + wc * 32 + 8 * fq; *(f32x4*)p = acc[ai][0][m][0]; *(f32x4*)(p + 4) = acc[ai][0][m][1]; }
            }
            return;
        }
        bf16* base; int ldc, colt;
        if (pn < 8) { base = xp; ldc = 2048; colt = pn * 256; } else if (pn < 24) { base = z; ldc = 4096; colt = (pn - 8) * 256; } else if (pn < 48) { base = xbc; ldc = 6144; colt = (pn - 24) * 256; }
        else if (pn < 56) { base = gp; ldc = 2048; colt = (pn - 48) * 256; } else { base = gs; ldc = 2048; colt = (pn - 56) * 256; }
        const int col0 = colt + wc * 32 + 8 * fq;
#pragma unroll
        for (int ai = 0; ai < 2; ++ai)
#pragma unroll
            for (int m = 0; m < 4; ++m) { bf16* rowp = base + (size_t)(row0 + ai * 128 + m * 16) * ldc + col0;
#pragma unroll
                for (int bj = 0; bj < 2; ++bj) { constexpr float sc = F8 ? 1.0f / 32.0f : 1.0f; const f32x4 v0 = acc[ai][bj][m][0] * sc, v1 = acc[ai][bj][m][1] * sc;
                    u32x4 w; w.x = cvt_pk_bf16(v0[0], v0[1]); w.y = cvt_pk_bf16(v0[2], v0[3]); w.z = cvt_pk_bf16(v1[0], v1[1]); w.w = cvt_pk_bf16(v1[2], v1[3]);
                    *(u32x4*)(rowp + bj * 128) = w; } }
    }
};
typedef EpiInProjT<false> EpiInProj;
struct EpiPool {
    static constexpr bool PERM = true;
    bf16* merged; const bf16* gp; const float* ps;
    __device__ __forceinline__ void operator()(const f32x4 (&acc)[2][2][4][2], const pg8::Unit& u, int wr, int wc, int fr, int fq) const {
        const int row0 = u.pm * 256 + wr * 64 + fr, col0 = u.e * 512 + u.pn * 256 + wc * 32 + 8 * fq;
        f32x4 sv[2][2];
#pragma unroll
        for (int bj = 0; bj < 2; ++bj)
#pragma unroll
            for (int n = 0; n < 2; ++n) sv[bj][n] = *(const f32x4*)(ps + col0 + bj * 128 + 4 * n);
#pragma unroll
        for (int ai = 0; ai < 2; ++ai) {
            u32x4 gq[4][2];
#pragma unroll
            for (int m = 0; m < 4; ++m)
#pragma unroll
                for (int bj = 0; bj < 2; ++bj) gq[m][bj] = *(const u32x4*)(gp + (size_t)(row0 + ai * 128 + m * 16) * 2048 + col0 + bj * 128);
#pragma unroll
            for (int m = 0; m < 4; ++m) { const size_t ro = (size_t)(row0 + ai * 128 + m * 16) * 2048 + col0;
#pragma unroll
                for (int bj = 0; bj < 2; ++bj) { const u32x4 g = gq[m][bj];
                    const f32x4 v0 = acc[ai][bj][m][0] * sv[bj][0], v1 = acc[ai][bj][m][1] * sv[bj][1];
                    u32x4 w; w.x = cvt_pk_bf16(v0[0] * sigmoidf_(bflo(g.x)), v0[1] * sigmoidf_(bfhi(g.x))); w.y = cvt_pk_bf16(v0[2] * sigmoidf_(bflo(g.y)), v0[3] * sigmoidf_(bfhi(g.y)));
                    w.z = cvt_pk_bf16(v1[0] * sigmoidf_(bflo(g.z)), v1[1] * sigmoidf_(bfhi(g.z))); w.w = cvt_pk_bf16(v1[2] * sigmoidf_(bflo(g.w)), v1[3] * sigmoidf_(bfhi(g.w)));
                    *(u32x4*)(merged + ro + bj * 128) = w; } } }
    }
};
struct EpiSsdOut {
    static constexpr bool PERM = true;
    bf16* merged; const bf16* gs;
    __device__ __forceinline__ void operator()(const f32x4 (&acc)[2][2][4][2], const pg8::Unit& u, int wr, int wc, int fr, int fq) const {
        const int row0 = u.pm * 256 + wr * 64 + fr, col0 = u.pn * 256 + wc * 32 + 8 * fq;
#pragma unroll
        for (int ai = 0; ai < 2; ++ai) {
            u32x4 gq[4][2], pq[4][2];
#pragma unroll
            for (int m = 0; m < 4; ++m)
#pragma unroll
                for (int bj = 0; bj < 2; ++bj) { const size_t ro = (size_t)(row0 + ai * 128 + m * 16) * 2048 + col0 + bj * 128; gq[m][bj] = *(const u32x4*)(gs + ro); pq[m][bj] = *(const u32x4*)(merged + ro); }
#pragma unroll
            for (int m = 0; m < 4; ++m) { const size_t ro = (size_t)(row0 + ai * 128 + m * 16) * 2048 + col0;
#pragma unroll
                for (int bj = 0; bj < 2; ++bj) { const u32x4 g = gq[m][bj]; const u32x4 p = pq[m][bj];
                    const f32x4 v0 = acc[ai][bj][m][0], v1 = acc[ai][bj][m][1];
                    u32x4 w; w.x = cvt_pk_bf16(v0[0] * sigmoidf_(bflo(g.x)) + bflo(p.x), v0[1] * sigmoidf_(bfhi(g.x)) + bfhi(p.x)); w.y = cvt_pk_bf16(v0[2] * sigmoidf_(bflo(g.y)) + bflo(p.y), v0[3] * sigmoidf_(bfhi(g.y)) + bfhi(p.y));
                    w.z = cvt_pk_bf16(v1[0] * sigmoidf_(bflo(g.z)) + bflo(p.z), v1[1] * sigmoidf_(bfhi(g.z)) + bfhi(p.z)); w.w = cvt_pk_bf16(v1[2] * sigmoidf_(bflo(g.w)) + bflo(p.w), v1[3] * sigmoidf_(bfhi(g.w)) + bfhi(p.w));
                    *(u32x4*)(merged + ro + bj * 128) = w; } } }
    }
};
struct EpiWout {
    static constexpr bool PERM = true;
    const float* x; bf16* h1;
    __device__ __forceinline__ void operator()(const f32x4 (&acc)[2][2][4][2], const pg8::Unit& u, int wr, int wc, int fr, int fq) const {
        const int row0 = u.pm * 256 + wr * 64 + fr, col0 = u.pn * 256 + wc * 32 + 8 * fq;
#pragma unroll
        for (int ai = 0; ai < 2; ++ai) {
            f32x4 xq[4][2][2];
#pragma unroll
            for (int m = 0; m < 4; ++m)
#pragma unroll
                for (int bj = 0; bj < 2; ++bj)
#pragma unroll
                    for (int n = 0; n < 2; ++n) xq[m][bj][n] = *(const f32x4*)(x + (size_t)(row0 + ai * 128 + m * 16) * 2048 + col0 + bj * 128 + n * 4);
#pragma unroll
            for (int m = 0; m < 4; ++m) { const size_t ro = (size_t)(row0 + ai * 128 + m * 16) * 2048 + col0;
#pragma unroll
                for (int bj = 0; bj < 2; ++bj) { const f32x4 v0 = xq[m][bj][0] + acc[ai][bj][m][0], v1 = xq[m][bj][1] + acc[ai][bj][m][1];
                    u32x4 w; w.x = cvt_pk_bf16(v0[0], v0[1]); w.y = cvt_pk_bf16(v0[2], v0[3]); w.z = cvt_pk_bf16(v1[0], v1[1]); w.w = cvt_pk_bf16(v1[2], v1[3]);
                    *(u32x4*)(h1 + ro + bj * 128) = w; } } }
    }
};
constexpr float WSC = MOE_FP8 ? 1.0f / 32.0f : 1.0f;
__device__ __forceinline__ float swiglu_(float glu, float lin) { glu = fminf(glu, 7.0f); lin = fminf(fmaxf(lin, -7.0f), 7.0f); return glu * sigmoidf_(1.702f * glu) * (lin + 1.0f); }
struct EpiUp {
    static constexpr bool PERM = true;
    uchar* act; const float* b_up;
    __device__ __forceinline__ void operator()(const f32x4 (&acc)[2][2][4][2], const pg8::Unit& u, int wr, int wc, int fr, int fq) const {
        const int row0 = u.pm * 256 + wr * 64 + fr, col0 = u.pn * 128 + wc * 32 + 8 * fq;
        const float* bb = b_up + (size_t)u.e * 4096 + col0;
        const f32x4 bg0 = *(const f32x4*)bb, bg1 = *(const f32x4*)(bb + 4), bl0 = *(const f32x4*)(bb + 2048), bl1 = *(const f32x4*)(bb + 2052);
#pragma unroll
        for (int ai = 0; ai < 2; ++ai)
#pragma unroll
            for (int m = 0; m < 4; ++m) {
                const f32x4 g0 = acc[ai][0][m][0] * WSC + bg0, g1 = acc[ai][0][m][1] * WSC + bg1, l0 = acc[ai][1][m][0] * WSC + bl0, l1 = acc[ai][1][m][1] * WSC + bl1;
                if constexpr (MOE_FP8) { u32x2 w; w.x = cvt4_fp8(swiglu_(g0[0], l0[0]), swiglu_(g0[1], l0[1]), swiglu_(g0[2], l0[2]), swiglu_(g0[3], l0[3]));
                    w.y = cvt4_fp8(swiglu_(g1[0], l1[0]), swiglu_(g1[1], l1[1]), swiglu_(g1[2], l1[2]), swiglu_(g1[3], l1[3]));
                    *(u32x2*)(act + (size_t)(row0 + ai * 128 + m * 16) * 2048 + col0) = w; }
                else { u32x4 w; w.x = cvt_pk_bf16(swiglu_(g0[0], l0[0]), swiglu_(g0[1], l0[1])); w.y = cvt_pk_bf16(swiglu_(g0[2], l0[2]), swiglu_(g0[3], l0[3]));
                    w.z = cvt_pk_bf16(swiglu_(g1[0], l1[0]), swiglu_(g1[1], l1[1])); w.w = cvt_pk_bf16(swiglu_(g1[2], l1[2]), swiglu_(g1[3], l1[3]));
                    *(u32x4*)((bf16*)act + (size_t)(row0 + ai * 128 + m * 16) * 2048 + col0) = w; } }
    }
};
constexpr float YBS = 8.0f;
struct EpiDown {
    static constexpr bool PERM = true;
    uchar* yb; const float* b_down;
    __device__ __forceinline__ void operator()(const f32x4 (&acc)[2][2][4][2], const pg8::Unit& u, int wr, int wc, int fr, int fq) const {
        const int row0 = u.pm * 256 + wr * 64 + fr, col0 = u.pn * 256 + wc * 32 + 8 * fq;
        const float* bb = b_down + (size_t)u.e * 2048 + col0;
        f32x4 bv[2][2];
#pragma unroll
        for (int bj = 0; bj < 2; ++bj)
#pragma unroll
            for (int n = 0; n < 2; ++n) bv[bj][n] = *(const f32x4*)(bb + bj * 128 + 4 * n) * YBS;
#pragma unroll
        for (int ai = 0; ai < 2; ++ai)
#pragma unroll
            for (int m = 0; m < 4; ++m) { uchar* rowp = yb + (size_t)(row0 + ai * 128 + m * 16) * 2048 + col0;
#pragma unroll
                for (int bj = 0; bj < 2; ++bj) { const f32x4 v0 = acc[ai][bj][m][0] * (WSC * YBS) + bv[bj][0], v1 = acc[ai][bj][m][1] * (WSC * YBS) + bv[bj][1];
                    u32x2 w; w.x = cvt4_fp8(v0[0], v0[1], v0[2], v0[3]); w.y = cvt4_fp8(v1[0], v1[1], v1[2], v1[3]);
                    *(u32x2*)(rowp + bj * 128) = w; } }
    }
};

__device__ __forceinline__ int hperm(int p) { return 32 * (p >> 5) + 8 * ((p >> 2) & 3) + 4 * ((p >> 4) & 1) + (p & 3); }
template <int MODE = 0>
__device__ __forceinline__ void tr_item(const float* W, int ldw, int k0, int n0, bf16* dst, int K, LAS float* scr, int lane) {
    const int kq = lane >> 4, n4 = (lane & 15) * 4;
    f32x4 v[16];
#pragma unroll
    for (int i = 0; i < 16; ++i) v[i] = __builtin_nontemporal_load((const f32x4*)(W + (size_t)(k0 + 4 * i + kq) * ldw + n0 + n4));
#pragma unroll
    for (int i = 0; i < 16; ++i) { LAS float* s = scr + (4 * i + kq) * 65 + n4; s[0] = v[i][0]; s[1] = v[i][1]; s[2] = v[i][2]; s[3] = v[i][3]; }
    LDS_WAIT();
    const int c = lane & 7, nn = lane >> 3;
#pragma unroll
    for (int i = 0; i < 8; ++i) { const int n = nn + 8 * i; const LAS float* s = scr + (8 * c) * 65 + n;
        u32x4 o; o.x = cvt_pk_bf16(s[0], s[65]); o.y = cvt_pk_bf16(s[130], s[195]); o.z = cvt_pk_bf16(s[260], s[325]); o.w = cvt_pk_bf16(s[390], s[455]);
        if (MODE == 2) { bf16* p = dst + (size_t)n * K + hperm(8 * c); *(u32x2*)p = (u32x2){o.x, o.y}; *(u32x2*)(p + 8) = (u32x2){o.z, o.w}; }
        else *(u32x4*)(dst + (size_t)(MODE == 1 ? hperm(n) : n) * K + 8 * c) = o; }
    LDS_WAIT();
}
__device__ __forceinline__ void tr_item_fp8(const float* W, int ldw, int k0, int n0, uchar* dst, int K, LAS float* scr, int lane) {
    const int kq = lane >> 4, n4 = (lane & 15) * 4;
    f32x4 v[16];
#pragma unroll
    for (int i = 0; i < 16; ++i) v[i] = __builtin_nontemporal_load((const f32x4*)(W + (size_t)(k0 + 4 * i + kq) * ldw + n0 + n4));
#pragma unroll
    for (int i = 0; i < 16; ++i) { LAS float* s = scr + (4 * i + kq) * 65 + n4; s[0] = v[i][0]; s[1] = v[i][1]; s[2] = v[i][2]; s[3] = v[i][3]; }
    LDS_WAIT();
    const int c = lane & 3, nn = lane >> 2;
#pragma unroll
    for (int i = 0; i < 4; ++i) { const int n = nn + 16 * i; const LAS float* s = scr + (16 * c) * 65 + n;
        u32x4 o; o.x = cvt4_fp8(s[0] * 32.f, s[65] * 32.f, s[130] * 32.f, s[195] * 32.f); o.y = cvt4_fp8(s[260] * 32.f, s[325] * 32.f, s[390] * 32.f, s[455] * 32.f);
        o.z = cvt4_fp8(s[520] * 32.f, s[585] * 32.f, s[650] * 32.f, s[715] * 32.f); o.w = cvt4_fp8(s[780] * 32.f, s[845] * 32.f, s[910] * 32.f, s[975] * 32.f);
        *(u32x4*)(dst + (size_t)n * K + 16 * c) = o; }
    LDS_WAIT();
}
__device__ __forceinline__ void rms_row_bf16(const f32x4 (&v)[8], const f32x4 (&wv)[8], bf16* orow, uchar* orow8, int lane) {
    float s = 0.f;
#pragma unroll
    for (int j = 0; j < 8; ++j) s += (v[j][0] * v[j][0] + v[j][1] * v[j][1]) + (v[j][2] * v[j][2] + v[j][3] * v[j][3]);
    const float rstd = rsqrtf(wave_sum(s) * (1.f / D) + EPS);
#pragma unroll
    for (int j = 0; j < 8; ++j) { const float a0 = v[j][0] * rstd * wv[j][0], a1 = v[j][1] * rstd * wv[j][1], a2 = v[j][2] * rstd * wv[j][2], a3 = v[j][3] * rstd * wv[j][3];
        u32x2 o; o.x = cvt_pk_bf16(a0, a1); o.y = cvt_pk_bf16(a2, a3);
        *(u32x2*)(orow + 4 * (lane + 64 * j)) = o; *(unsigned*)(orow8 + 4 * (lane + 64 * j)) = cvt4_fp8(a0, a1, a2, a3); }
}
template <int PART>
__device__ __forceinline__ void p0_convert(Frame& F, int gw, int NGW) {
    LAS float* scr = (LAS float*)(F.lds + F.wave * 16640);
    constexpr int I_IN = 32 * 257, I_POOL = 4 * 64, I_SSD = 64 * 32, I_OUT = 32 * 32, I_UP = 32 * 32 * 64, I_DOWN = 32 * 32 * 32;
    constexpr int NEARLY = I_IN + I_POOL + I_SSD + I_OUT, NITEMS = NEARLY + I_UP + I_DOWN;
    constexpr int IT0 = PART == 1 ? I_IN : 0, IT1 = PART == 0 ? I_IN : (PART == 3 ? NITEMS : NEARLY);
    for (int it = IT0 + gw; it < IT1; it += NGW) {
        int r = it;
        if (r < I_IN) { const int kb = r / 257, nb = r % 257, n0 = nb * 64; const int r0 = n0 < 12288 ? n0 : (n0 == 12288 ? 16384 : n0 - 64);
            if (n0 >= 2048 && n0 < 6144) tr_item<1>(F.w_in, INCOLS, kb * 64, n0, WSP(bf16, WS_WIN) + (size_t)r0 * 2048 + kb * 64, 2048, scr, F.lane);
            else if (n0 >= 12352) tr_item_fp8(F.w_in, INCOLS, kb * 64, n0, WSP(uchar, WS_WIN8) + (size_t)(n0 - 12352) * 2048 + kb * 64, 2048, scr, F.lane);
            else tr_item(F.w_in, INCOLS, kb * 64, n0, WSP(bf16, WS_WIN) + (size_t)r0 * 2048 + kb * 64, 2048, scr, F.lane);
            continue; } r -= I_IN;
        if (r < I_POOL) { const int g = r >> 6, kb = (r >> 3) & 7, nb = r & 7;
            tr_item(F.w_pool + (size_t)g * 512 * 512, 512, kb * 64, nb * 64, WSP(bf16, WS_WPOOL) + (size_t)(g * 512 + nb * 64) * 512 + kb * 64, 512, scr, F.lane); continue; } r -= I_POOL;
        if (r < I_SSD) { const int kb = r >> 5, nb = r & 31;
            tr_item<2>(F.w_ssd_out, 2048, kb * 64, nb * 64, WSP(bf16, WS_WSSD) + (size_t)(nb * 64) * 4096 + kb * 64, 4096, scr, F.lane); continue; } r -= I_SSD;
        if (r < I_OUT) { const int kb = r >> 5, nb = r & 31;
            tr_item(F.w_out, 2048, kb * 64, nb * 64, WSP(bf16, WS_WOUT) + (size_t)(nb * 64) * 2048 + kb * 64, 2048, scr, F.lane); continue; } r -= I_OUT;
        if (r < I_UP) { const int e = r >> 11, kb = (r >> 6) & 31, nb = r & 63, n0 = nb * 64; const int j = n0 & 2047; const int r0 = 256 * (j >> 7) + (n0 >= 2048 ? 128 : 0) + (j & 127);
            if constexpr (MOE_FP8) tr_item_fp8(F.w_up + (size_t)e * 2048 * 4096, 4096, kb * 64, n0, WSP(uchar, WS_WUP) + ((size_t)e * 4096 + r0) * 2048 + kb * 64, 2048, scr, F.lane);
            else tr_item(F.w_up + (size_t)e * 2048 * 4096, 4096, kb * 64, n0, WSP(bf16, WS_WUP) + ((size_t)e * 4096 + r0) * 2048 + kb * 64, 2048, scr, F.lane);
            continue; } r -= I_UP;
        { const int e = r >> 10, kb = (r >> 5) & 31, nb = r & 31;
            if constexpr (MOE_FP8) tr_item_fp8(F.w_down + (size_t)e * 2048 * 2048, 2048, kb * 64, nb * 64, WSP(uchar, WS_WDOWN) + ((size_t)e * 2048 + nb * 64) * 2048 + kb * 64, 2048, scr, F.lane);
            else tr_item(F.w_down + (size_t)e * 2048 * 2048, 2048, kb * 64, nb * 64, WSP(bf16, WS_WDOWN) + ((size_t)e * 2048 + nb * 64) * 2048 + kb * 64, 2048, scr, F.lane); }
    }
}

struct LateItem { const float* src; uchar* dst; int ldw; };
__device__ __forceinline__ LateItem late_item(Frame& F, int r) {
    constexpr int I_UP = 32 * 32 * 64;
    LateItem L;
    if (r < I_UP) { const int e = r >> 11, kb = (r >> 6) & 31, nb = r & 63, n0 = nb * 64; const int j = n0 & 2047; const int r0 = 256 * (j >> 7) + (n0 >= 2048 ? 128 : 0) + (j & 127);
        L.src = F.w_up + (size_t)e * 2048 * 4096 + (size_t)(kb * 64) * 4096 + n0; L.ldw = 4096; L.dst = WSP(uchar, WS_WUP) + ((size_t)e * 4096 + r0) * 2048 + kb * 64; }
    else { r -= I_UP; const int e = r >> 10, kb = (r >> 5) & 31, nb = r & 31;
        L.src = F.w_down + (size_t)e * 2048 * 2048 + (size_t)(kb * 64) * 2048 + nb * 64; L.ldw = 2048; L.dst = WSP(uchar, WS_WDOWN) + ((size_t)e * 2048 + nb * 64) * 2048 + kb * 64; }
    return L;
}
#define LATE_LOAD(v, L) do { _Pragma("unroll") for (int i = 0; i < 16; ++i) v[i] = __builtin_nontemporal_load((const f32x4*)((L).src + (size_t)(4 * i + (lane >> 4)) * (L).ldw + (lane & 15) * 4)); } while (0)
#define LATE_PROC(v, L) do { _Pragma("unroll") for (int i = 0; i < 16; ++i) { LAS float* s_ = scr + (4 * i + (lane >> 4)) * 65 + (lane & 15) * 4; s_[0] = v[i][0]; s_[1] = v[i][1]; s_[2] = v[i][2]; s_[3] = v[i][3]; } \
        LDS_WAIT(); \
        _Pragma("unroll") for (int i = 0; i < 4; ++i) { const int n_ = (lane >> 2) + 16 * i; const LAS float* s_ = scr + (16 * (lane & 3)) * 65 + n_; \
            u32x4 o_; o_.x = cvt4_fp8(s_[0] * 32.f, s_[65] * 32.f, s_[130] * 32.f, s_[195] * 32.f); o_.y = cvt4_fp8(s_[260] * 32.f, s_[325] * 32.f, s_[390] * 32.f, s_[455] * 32.f); \
            o_.z = cvt4_fp8(s_[520] * 32.f, s_[585] * 32.f, s_[650] * 32.f, s_[715] * 32.f); o_.w = cvt4_fp8(s_[780] * 32.f, s_[845] * 32.f, s_[910] * 32.f, s_[975] * 32.f); \
            __builtin_nontemporal_store(o_, (u32x4*)((L).dst + (size_t)n_ * 2048 + 16 * (lane & 3))); } \
        LDS_WAIT(); } while (0)
__device__ __forceinline__ void p1_convert_late(Frame& F, int gw, int NGW) {
    static_assert(MOE_FP8, "pipelined converter writes e4m3");
    LAS float* scr = (LAS float*)(F.lds + F.wave * 16640);
    const int lane = F.lane;
    constexpr int NLATE = 32 * 32 * 64 + 32 * 32 * 32;
    f32x4 va[16], vb[16];
    int it = gw; LateItem La, Lb;
    if (it < NLATE) { La = late_item(F, it); LATE_LOAD(va, La); }
    while (it < NLATE) {
        const int it2 = it + NGW; if (it2 < NLATE) { Lb = late_item(F, it2); LATE_LOAD(vb, Lb); }
        LATE_PROC(va, La);
        const int it3 = it2 + NGW; if (it3 < NLATE) { La = late_item(F, it3); LATE_LOAD(va, La); }
        if (it2 < NLATE) LATE_PROC(vb, Lb);
        it = it3;
    }
}
#undef LATE_LOAD
#undef LATE_PROC
__device__ __forceinline__ void p0_prologue(Frame& F, bool with_late) {
    const int gw = blockIdx.x * NWAVES + F.wave, NGW = F.G * NWAVES;
    if (with_late) p0_convert<3>(F, gw, NGW); else p0_convert<0>(F, gw, NGW);
    { u32x4* pad = (u32x4*)(WSP(bf16, WS_WIN) + (size_t)INCOLS * 2048); const int n16 = (NPAD - INCOLS) * 2048 * 2 / 16;
      for (int i = blockIdx.x * 512 + F.tid; i < n16; i += F.G * 512) pad[i] = (u32x4){0u, 0u, 0u, 0u}; }
    f32x4 wv[8];
#pragma unroll
    for (int j = 0; j < 8; ++j) wv[j] = *(const f32x4*)(F.norm_mix_w + 4 * (F.lane + 64 * j));
    f32x4 va[8], vb[8];
    for (int m = gw; m < T; m += 2 * NGW) {
#pragma unroll
        for (int j = 0; j < 8; ++j) va[j] = __builtin_nontemporal_load((const f32x4*)(F.x + (size_t)m * D + 4 * (F.lane + 64 * j)));
        const int m2 = m + NGW;
        if (m2 < T) {
#pragma unroll
            for (int j = 0; j < 8; ++j) vb[j] = __builtin_nontemporal_load((const f32x4*)(F.x + (size_t)m2 * D + 4 * (F.lane + 64 * j))); }
        rms_row_bf16(va, wv, WSP(bf16, WS_U) + (size_t)m * D, WSP(uchar, WS_U8) + (size_t)m * D, F.lane);
        if (m2 < T) rms_row_bf16(vb, wv, WSP(bf16, WS_U) + (size_t)m2 * D, WSP(uchar, WS_U8) + (size_t)m2 * D, F.lane);
    }
}

constexpr int LDP = 136;
constexpr int SOFF_DTS = 0, SOFF_ACS = 4096, SOFF_T0 = 8192;
struct Conv2Regs { u32x4 v[2][7]; f32x4 w[2][4][2]; f32x4 bb[2][2]; };
__device__ __forceinline__ void conv2_load(Frame& F, int tbase, int pos0, int chA, int chB, Conv2Regs& R) {
    const int nb = F.tid & 15, r4 = F.tid >> 4;
    const bf16* xbc = WSP(const bf16, WS_XBC);
    const bool ok0 = pos0 + 4 * r4 - 3 >= 0;
#pragma unroll
    for (int t = 0; t < 2; ++t) { const int ch = (t ? chB : chA) + 8 * nb;
#pragma unroll
        for (int q = 0; q < 7; ++q) { const int rr = 4 * r4 - 3 + q; R.v[t][q] = *(const u32x4*)(xbc + (size_t)(tbase + ((q >= 3 || ok0) ? rr : 0)) * XBCW + ch); }
#pragma unroll
        for (int k = 0; k < 4; ++k) { R.w[t][k][0] = *(const f32x4*)(F.conv_w + (size_t)k * XBCW + ch); R.w[t][k][1] = *(const f32x4*)(F.conv_w + (size_t)k * XBCW + ch + 4); }
        R.bb[t][0] = *(const f32x4*)(F.conv_b + ch); R.bb[t][1] = *(const f32x4*)(F.conv_b + ch + 4); }
}
__device__ __forceinline__ void conv2_store(Frame& F, int pos0, Conv2Regs& R, LAS bf16* dstA, LAS bf16* dstB) {
    const int nb = F.tid & 15, r4 = F.tid >> 4;
#pragma unroll
    for (int t = 0; t < 2; ++t) {
#pragma unroll
        for (int q = 0; q < 3; ++q) { const bool ok = pos0 + 4 * r4 - 3 + q >= 0; R.v[t][q].x = ok ? R.v[t][q].x : 0u; R.v[t][q].y = ok ? R.v[t][q].y : 0u; R.v[t][q].z = ok ? R.v[t][q].z : 0u; R.v[t][q].w = ok ? R.v[t][q].w : 0u; }
        LAS bf16* dst = t ? dstB : dstA;
#pragma unroll
        for (int i = 0; i < 4; ++i) {
            f32x4 a0 = R.bb[t][0], a1 = R.bb[t][1];
#pragma unroll
            for (int k = 0; k < 4; ++k) { const u32x4 x = R.v[t][i + k];
                a0[0] += R.w[t][k][0][0] * bflo(x.x); a0[1] += R.w[t][k][0][1] * bfhi(x.x); a0[2] += R.w[t][k][0][2] * bflo(x.y); a0[3] += R.w[t][k][0][3] * bfhi(x.y);
                a1[0] += R.w[t][k][1][0] * bflo(x.z); a1[1] += R.w[t][k][1][1] * bfhi(x.z); a1[2] += R.w[t][k][1][2] * bflo(x.w); a1[3] += R.w[t][k][1][3] * bfhi(x.w); }
            u32x4 o; o.x = cvt_pk_bf16(siluf_(a0[0]), siluf_(a0[1])); o.y = cvt_pk_bf16(siluf_(a0[2]), siluf_(a0[3])); o.z = cvt_pk_bf16(siluf_(a1[0]), siluf_(a1[1])); o.w = cvt_pk_bf16(siluf_(a1[2]), siluf_(a1[3]));
            *(LAS u32x4*)(dst + (4 * r4 + i) * LDP + 8 * nb) = o;
        }
    }
}
__device__ __forceinline__ void dt2_load(Frame& F, int tbase, int g, float (&raw)[4]) {
    const int h = 8 * g + F.wave; const float* dtp = WSP(const float, WS_DT);
    raw[0] = dtp[(size_t)(tbase + F.lane) * 64 + h]; raw[1] = dtp[(size_t)(tbase + F.lane + 64) * 64 + h]; raw[2] = F.dt_bias[h]; raw[3] = F.a_log[h];
}
__device__ __forceinline__ void dt2_store(Frame& F, const float (&raw)[4]) {
    LAS float* dts = (LAS float*)(F.lds + SOFF_DTS); LAS float* acs = (LAS float*)(F.lds + SOFF_ACS);
    const int j = F.wave, lane = F.lane; const float bias = raw[2], a = -__expf(raw[3]);
    float carry = 0.f;
#pragma unroll
    for (int half = 0; half < 2; ++half) {
        const int s = lane + 64 * half; const float r = raw[half] + bias;
        const float dtv = r > 20.f ? r : log1pf(__expf(r));
        float v = dtv * a;
#pragma unroll
        for (int o = 1; o < 64; o <<= 1) { const float u = __shfl_up(v, o); if (lane >= o) v += u; }
        v += carry; carry = __shfl(v, 63);
        dts[j * 128 + s] = dtv; acs[j * 128 + s] = v;
    }
}
__device__ __forceinline__ void cpair_load_s(Frame& F, int tbase, int pos0, int chg, int sb, unsigned (&u)[11]) {
    const bf16* xbc = WSP(const bf16, WS_XBC);
    const bool ok0 = pos0 + 8 * sb - 3 >= 0;
#pragma unroll
    for (int q = 0; q < 11; ++q) { const int rr = 8 * sb - 3 + q; u[q] = *(const unsigned*)(xbc + (size_t)(tbase + ((q >= 3 || ok0) ? rr : 0)) * XBCW + chg); }
}
__device__ __forceinline__ void cpair_fix(int pos0, int sb, unsigned (&u)[11]) {
#pragma unroll
    for (int q = 0; q < 3; ++q) u[q] = (pos0 + 8 * sb - 3 + q >= 0) ? u[q] : 0u;
}
__device__ __forceinline__ void cpair_loadw(Frame& F, int chg, f32x2 (&xw)[5]) {
#pragma unroll
    for (int k = 0; k < 4; ++k) xw[k] = *(const f32x2*)(F.conv_w + (size_t)k * XBCW + chg);
    xw[4] = *(const f32x2*)(F.conv_b + chg);
}
template <int MODE>
__device__ __forceinline__ void cpair_store_w(int chl, int sb, LAS bf16* dst, const unsigned (&u)[11], const f32x2 (&xw)[5], const LAS float* dts, const LAS float* acs, float aend) {
    float o0[8], o1[8];
#pragma unroll
    for (int i = 0; i < 8; ++i) { float a0 = xw[4][0], a1 = xw[4][1];
#pragma unroll
        for (int k = 0; k < 4; ++k) { a0 += xw[k][0] * bflo(u[i + k]); a1 += xw[k][1] * bfhi(u[i + k]); }
        float sc = 1.f;
        if (MODE >= 1) { const int s = 8 * sb + i; sc = dts[s]; if (MODE == 2) sc *= __expf(aend - acs[s]); }
        o0[i] = siluf_(a0) * sc; o1[i] = siluf_(a1) * sc; }
    u32x4 p0, p1; p0.x = cvt_pk_bf16(o0[0], o0[1]); p0.y = cvt_pk_bf16(o0[2], o0[3]); p0.z = cvt_pk_bf16(o0[4], o0[5]); p0.w = cvt_pk_bf16(o0[6], o0[7]);
    p1.x = cvt_pk_bf16(o1[0], o1[1]); p1.y = cvt_pk_bf16(o1[2], o1[3]); p1.z = cvt_pk_bf16(o1[4], o1[5]); p1.w = cvt_pk_bf16(o1[6], o1[7]);
    *(LAS u32x4*)(dst + chl * LDP + 8 * sb) = p0; *(LAS u32x4*)(dst + (chl + 1) * LDP + 8 * sb) = p1;
}
struct ConvT2Regs { unsigned u[2][11]; f32x2 w[5]; };
__device__ __forceinline__ void convT2_load(Frame& F, int tbase, int pos0, int chg, ConvT2Regs& R) {
    const bf16* xbc = WSP(const bf16, WS_XBC);
#pragma unroll
    for (int it = 0; it < 2; ++it) { const int sb = (F.tid >> 6) + 8 * it; const bool ok0 = pos0 + 8 * sb - 3 >= 0;
#pragma unroll
        for (int q = 0; q < 11; ++q) { const int rr = 8 * sb - 3 + q; R.u[it][q] = *(const unsigned*)(xbc + (size_t)(tbase + ((q >= 3 || ok0) ? rr : 0)) * XBCW + chg); } }
#pragma unroll
    for (int k = 0; k < 4; ++k) R.w[k] = *(const f32x2*)(F.conv_w + (size_t)k * XBCW + chg);
    R.w[4] = *(const f32x2*)(F.conv_b + chg);
}
__device__ __forceinline__ void convT2_store(Frame& F, int pos0, int chl, ConvT2Regs& R, LAS bf16* dst) {
#pragma unroll
    for (int it = 0; it < 2; ++it) { const int sb = (F.tid >> 6) + 8 * it;
#pragma unroll
        for (int q = 0; q < 3; ++q) R.u[it][q] = (pos0 + 8 * sb - 3 + q >= 0) ? R.u[it][q] : 0u;
        float o0[8], o1[8];
#pragma unroll
        for (int i = 0; i < 8; ++i) { float a0 = R.w[4][0], a1 = R.w[4][1];
#pragma unroll
            for (int k = 0; k < 4; ++k) { a0 += R.w[k][0] * bflo(R.u[it][i + k]); a1 += R.w[k][1] * bfhi(R.u[it][i + k]); }
            o0[i] = siluf_(a0); o1[i] = siluf_(a1); }
        u32x4 p0, p1; p0.x = cvt_pk_bf16(o0[0], o0[1]); p0.y = cvt_pk_bf16(o0[2], o0[3]); p0.z = cvt_pk_bf16(o0[4], o0[5]); p0.w = cvt_pk_bf16(o0[6], o0[7]);
        p1.x = cvt_pk_bf16(o1[0], o1[1]); p1.y = cvt_pk_bf16(o1[2], o1[3]); p1.z = cvt_pk_bf16(o1[4], o1[5]); p1.w = cvt_pk_bf16(o1[6], o1[7]);
        *(LAS u32x4*)(dst + chl * LDP + 8 * sb) = p0; *(LAS u32x4*)(dst + (chl + 1) * LDP + 8 * sb) = p1; }
}
__device__ __forceinline__ void p2_states_unit(Frame& F, int unit) {
    const int g = unit & 7, c = (unit >> 3) & 63, b = unit >> 9;
    const int tbase = b * SEQ + c * 128, pos0 = c * 128;
    LAS float* dts = (LAS float*)(F.lds + SOFF_DTS); LAS float* acs = (LAS float*)(F.lds + SOFF_ACS);
    LAS bf16* BMT = (LAS bf16*)(F.lds + SOFF_T0);
    LAS bf16* XT0 = BMT + 128 * LDP; LAS bf16* XT1 = XT0 + 64 * LDP;
    const int lane = F.lane, w = F.wave, c16 = lane & 15, q = lane >> 4;
    const int pp = F.tid & 31, sbx = F.tid >> 5;
    unsigned xu[11]; f32x2 xw[5];
    cpair_load_s(F, tbase, pos0, 512 * g + 2 * pp, sbx, xu); cpair_loadw(F, 512 * g + 2 * pp, xw);
    float dtraw[4]; dt2_load(F, tbase, g, dtraw);
    ConvT2Regs cr; convT2_load(F, tbase, pos0, 4096 + 128 * g + 2 * (F.tid & 63), cr);
    __syncthreads();
    dt2_store(F, dtraw);
    convT2_store(F, pos0, 2 * (F.tid & 63), cr, BMT);
    __syncthreads();
    cpair_fix(pos0, sbx, xu); cpair_store_w<2>(2 * pp, sbx, XT0, xu, xw, dts, acs, acs[127]);
    bf16x8 bmf[4];
#pragma unroll
    for (int kk = 0; kk < 4; ++kk) bmf[kk] = *(const LAS bf16x8*)(BMT + (16 * w + c16) * LDP + 32 * kk + 8 * q);
    __syncthreads();
    bf16* states = WSP(bf16, WS_STATES);
    for (int j = 0; j < 8; ++j) {
        LAS bf16* XT = (j & 1) ? XT1 : XT0;
        const float aend = acs[j * 128 + 127];
        if (j < 7) { cpair_load_s(F, tbase, pos0, 512 * g + 64 * (j + 1) + 2 * pp, sbx, xu); cpair_loadw(F, 512 * g + 64 * (j + 1) + 2 * pp, xw); }
        f32x4 acc[4];
#pragma unroll
        for (int pt = 0; pt < 4; ++pt) acc[pt] = (f32x4){0.f, 0.f, 0.f, 0.f};
        { bf16x8 xa[2][4];
#pragma unroll
          for (int pt = 0; pt < 4; ++pt) xa[0][pt] = *(const LAS bf16x8*)(XT + (16 * pt + c16) * LDP + 8 * q);
#pragma unroll
          for (int kk = 0; kk < 4; ++kk) {
              if (kk < 3) {
#pragma unroll
                  for (int pt = 0; pt < 4; ++pt) xa[(kk + 1) & 1][pt] = *(const LAS bf16x8*)(XT + (16 * pt + c16) * LDP + 32 * (kk + 1) + 8 * q); }
              __builtin_amdgcn_sched_barrier(0);
#pragma unroll
              for (int pt = 0; pt < 4; ++pt) acc[pt] = __builtin_amdgcn_mfma_f32_16x16x32_bf16(bmf[kk], xa[kk & 1][pt], acc[pt], 0, 0, 0);
              __builtin_amdgcn_sched_barrier(0); } }
        const int h = 8 * g + j;
#pragma unroll
        for (int pt = 0; pt < 4; ++pt) { u32x2 o; o.x = cvt_pk_bf16(acc[pt][0], acc[pt][1]); o.y = cvt_pk_bf16(acc[pt][2], acc[pt][3]);
            *(u32x2*)(states + ((((size_t)(b * 64 + c) * 64 + h) * 64 + 16 * pt + c16) * 128 + 16 * w + 4 * q)) = o; }
        if (w == j && lane == 0) WSP(float, WS_CDEC)[(b * 64 + c) * 64 + h] = __expf(aend);
        if (j < 7) { cpair_fix(pos0, sbx, xu); cpair_store_w<2>(2 * pp, sbx, (j & 1) ? XT0 : XT1, xu, xw, dts + (j + 1) * 128, acs + (j + 1) * 128, acs[(j + 1) * 128 + 127]); }
        __syncthreads();
    }
}
template <int W>
__device__ __forceinline__ void pool_item(const bf16* xp, bf16* pooled, int cg, int g, int t0, int p0) {
    u32x4 rows[15 + W];
#pragma unroll
    for (int i = 0; i < 15 + W; ++i) { rows[i] = (u32x4){0u, 0u, 0u, 0u}; const int dq = i - (W - 1); if (p0 + dq >= 0) rows[i] = *(const u32x4*)(xp + (size_t)(t0 + dq) * 2048 + 8 * cg); }
    float S[8];
#pragma unroll
    for (int e = 0; e < 8; ++e) S[e] = 0.f;
#pragma unroll
    for (int i = 0; i < W - 1; ++i) { const u32x4 v = rows[i];
        S[0] += bflo(v.x); S[1] += bfhi(v.x); S[2] += bflo(v.y); S[3] += bfhi(v.y); S[4] += bflo(v.z); S[5] += bfhi(v.z); S[6] += bflo(v.w); S[7] += bfhi(v.w); }
#pragma unroll
    for (int i = 0; i < 16; ++i) {
        const int t = t0 + i, p = p0 + i;
        const u32x4 v = rows[W - 1 + i];
        float xv[8] = {bflo(v.x), bfhi(v.x), bflo(v.y), bfhi(v.y), bflo(v.z), bfhi(v.z), bflo(v.w), bfhi(v.w)};
        const float inv = 1.0f / (float)((p + 1) < W ? (p + 1) : W);
        float o[8];
#pragma unroll
        for (int e = 0; e < 8; ++e) { S[e] += xv[e]; o[e] = S[e] * inv - xv[e]; }
        u32x4 ov; ov.x = cvt_pk_bf16(o[0], o[1]); ov.y = cvt_pk_bf16(o[2], o[3]); ov.z = cvt_pk_bf16(o[4], o[5]); ov.w = cvt_pk_bf16(o[6], o[7]);
        *(u32x4*)(pooled + ((size_t)g * T + t) * 512 + (8 * cg & 511)) = ov;
        const u32x4 u = rows[i];
        S[0] -= bflo(u.x); S[1] -= bfhi(u.x); S[2] -= bflo(u.y); S[3] -= bfhi(u.y); S[4] -= bflo(u.z); S[5] -= bfhi(u.z); S[6] -= bflo(u.w); S[7] -= bfhi(u.w);
    }
}
__device__ __forceinline__ void p2_pool_items(Frame& F) {
    const bf16* xp = WSP(const bf16, WS_XP); bf16* pooled = WSP(bf16, WS_POOLED);
    for (int idx = blockIdx.x * 512 + F.tid; idx < (T / 16) * 256; idx += F.G * 512) {
        const int cg = idx & 255, rb = idx >> 8;
        const int g = __builtin_amdgcn_readfirstlane(cg >> 6);
        const int t0 = rb * 16, p0 = t0 & (SEQ - 1);
        if (g == 0) pool_item<2>(xp, pooled, cg, g, t0, p0); else if (g == 1) pool_item<4>(xp, pooled, cg, g, t0, p0);
        else if (g == 2) pool_item<8>(xp, pooled, cg, g, t0, p0); else pool_item<16>(xp, pooled, cg, g, t0, p0);
    }
}

__device__ __forceinline__ void p3_scan(Frame& F) {
    bf16* states = WSP(bf16, WS_STATES); const float* cdec = WSP(const float, WS_CDEC);
    for (int idx = blockIdx.x * 512 + F.tid; idx < 2 * 64 * 64 * 16; idx += F.G * 512) {
        const int n8 = idx & 15, p = (idx >> 4) & 63, h = (idx >> 10) & 63, b = idx >> 16;
        float run[8];
#pragma unroll
        for (int e = 0; e < 8; ++e) run[e] = 0.f;
        for (int c0 = 0; c0 < 64; c0 += 8) {
            u32x4 v[8]; float dec[8];
#pragma unroll
            for (int cc = 0; cc < 8; ++cc) { const int c = c0 + cc; v[cc] = *(const u32x4*)(states + ((((size_t)(b * 64 + c) * 64 + h) * 64 + p) * 128 + 8 * n8)); dec[cc] = cdec[(b * 64 + c) * 64 + h]; }
#pragma unroll
            for (int cc = 0; cc < 8; ++cc) { const int c = c0 + cc;
                u32x4 o; o.x = cvt_pk_bf16(run[0], run[1]); o.y = cvt_pk_bf16(run[2], run[3]); o.z = cvt_pk_bf16(run[4], run[5]); o.w = cvt_pk_bf16(run[6], run[7]);
                *(u32x4*)(states + ((((size_t)(b * 64 + c) * 64 + h) * 64 + p) * 128 + 8 * n8)) = o;
                const float d = dec[cc];
                run[0] = run[0] * d + bflo(v[cc].x); run[1] = run[1] * d + bfhi(v[cc].x); run[2] = run[2] * d + bflo(v[cc].y); run[3] = run[3] * d + bfhi(v[cc].y);
                run[4] = run[4] * d + bflo(v[cc].z); run[5] = run[5] * d + bfhi(v[cc].z); run[6] = run[6] * d + bflo(v[cc].w); run[7] = run[7] * d + bfhi(v[cc].w); }
        }
    }
}

__device__ __forceinline__ void p4_unit(Frame& F, int unit) {
    const int g = unit & 7, c = (unit >> 3) & 63, b = unit >> 9;
    const int tbase = b * SEQ + c * 128, pos0 = c * 128;
    LAS float* dts = (LAS float*)(F.lds + SOFF_DTS); LAS float* acs = (LAS float*)(F.lds + SOFF_ACS);
    LAS bf16* CMs = (LAS bf16*)(F.lds + SOFF_T0);
    LAS bf16* BMs = CMs + 128 * LDP;
    LAS bf16* XT0 = BMs + 128 * LDP; LAS bf16* PV0 = XT0 + 64 * LDP;
    LAS bf16* XT1 = BMs; LAS bf16* PV1 = BMs + 64 * LDP;
    const int lane = F.lane, w = F.wave, c16 = lane & 15, q = lane >> 4;
    const int l = 16 * w + c16;
    const int pp = F.tid & 31, sbx = F.tid >> 5;
    const bf16* zb = WSP(const bf16, WS_Z); const bf16* states = WSP(const bf16, WS_STATES);
    bf16* yg = WSP(bf16, WS_YG);
    LAS u32x4* parkA = (LAS u32x4*)(F.lds + SOFF_T0) + F.tid; LAS u32x4* parkB = (LAS u32x4*)(F.lds + SOFF_T0 + 384 * LDP * 2) + F.tid;
    unsigned xu[11]; u32x4 pvr[2]; f32x2 xw[5];
    const float dskall = F.d_skip[8 * g + (lane & 7)];
    cpair_load_s(F, tbase, pos0, 512 * g + 2 * pp, sbx, xu); cpair_loadw(F, 512 * g + 2 * pp, xw);
    { const bf16* src = states + (((size_t)(b * 64 + c) * 64 + 8 * g) * 64) * 128;
#pragma unroll
      for (int it = 0; it < 2; ++it) { const int i16 = F.tid + 512 * it; pvr[it] = *(const u32x4*)(src + (i16 >> 4) * 128 + 8 * (i16 & 15)); } }
    float dtraw[4]; dt2_load(F, tbase, g, dtraw);
    Conv2Regs cr; conv2_load(F, tbase, pos0, 4096 + 1024 + 128 * g, 4096 + 128 * g, cr);
    __syncthreads();
    dt2_store(F, dtraw);
    conv2_store(F, pos0, cr, CMs, BMs);
    __syncthreads();
    bf16x8 cmf[4];
#pragma unroll
    for (int kn = 0; kn < 4; ++kn) cmf[kn] = *(const LAS bf16x8*)(CMs + l * LDP + 32 * kn + 8 * q);
    f32x4 cb[8];
#pragma unroll
    for (int st = 0; st < 8; ++st) { cb[st] = (f32x4){0.f, 0.f, 0.f, 0.f};
        if (st <= w) {
            bf16x8 ba[4];
#pragma unroll
            for (int kn = 0; kn < 4; ++kn) ba[kn] = *(const LAS bf16x8*)(BMs + (16 * st + c16) * LDP + 32 * kn + 8 * q);
            __builtin_amdgcn_sched_barrier(0);
#pragma unroll
            for (int kn = 0; kn < 4; ++kn) cb[st] = __builtin_amdgcn_mfma_f32_16x16x32_bf16(ba[kn], cmf[kn], cb[st], 0, 0, 0); } }
    cpair_fix(pos0, sbx, xu); cpair_store_w<1>(2 * pp, sbx, XT0, xu, xw, dts, acs, 0.f);
#pragma unroll
    for (int it = 0; it < 2; ++it) { const int i16 = F.tid + 512 * it; *(LAS u32x4*)(PV0 + (i16 >> 4) * LDP + 8 * (i16 & 15)) = pvr[it]; }
    __syncthreads();
    float ssq = 0.f;
    for (int j = 0; j < 8; ++j) {
        LAS bf16* XT = (j & 1) ? XT1 : XT0; LAS bf16* PV = (j & 1) ? PV1 : PV0;
        const int h = 8 * g + j;
        u32x4 zq[2];
#pragma unroll
        for (int i = 0; i < 2; ++i) zq[i] = *(const u32x4*)(zb + (size_t)(tbase + l) * ZI + 512 * g + 64 * j + 32 * i + 8 * q);
        const float al = acs[j * 128 + l], dtl = dts[j * 128 + l], dsk = __builtin_bit_cast(float, __builtin_amdgcn_readlane(__builtin_bit_cast(int, dskall), j)) / dtl;
        f32x4 ad[4], ao[4];
#pragma unroll
        for (int pt = 0; pt < 4; ++pt) { ad[pt] = (f32x4){0.f, 0.f, 0.f, 0.f}; ao[pt] = (f32x4){0.f, 0.f, 0.f, 0.f}; }
#pragma unroll
        for (int kk = 0; kk < 4; ++kk) {
            if (32 * kk <= 16 * w + 15) {
                const f32x4 as0 = *(const LAS f32x4*)(acs + j * 128 + 32 * kk + 4 * q), as1 = *(const LAS f32x4*)(acs + j * 128 + 32 * kk + 16 + 4 * q);
                u32x2 xlo[4], xhi[4];
#pragma unroll
                for (int pt = 0; pt < 4; ++pt) { xlo[pt] = *(const LAS u32x2*)(XT + (16 * pt + c16) * LDP + 32 * kk + 4 * q); xhi[pt] = *(const LAS u32x2*)(XT + (16 * pt + c16) * LDP + 32 * kk + 16 + 4 * q); }
                __builtin_amdgcn_sched_barrier(0);
                float mv[8];
                if (32 * kk + 31 <= 16 * w) {
#pragma unroll
                    for (int i = 0; i < 4; ++i) { mv[i] = cb[2 * kk][i] * __expf(al - as0[i]); mv[4 + i] = cb[2 * kk + 1][i] * __expf(al - as1[i]); }
                } else {
#pragma unroll
                    for (int i = 0; i < 4; ++i) { const int s0 = 32 * kk + 4 * q + i, s1 = s0 + 16;
                        float v0 = cb[2 * kk][i] * __expf(fminf(al - as0[i], 0.f)), v1 = cb[2 * kk + 1][i] * __expf(fminf(al - as1[i], 0.f));
                        v0 = (s0 <= l) ? v0 : 0.f; v1 = (s1 <= l) ? v1 : 0.f; if (s0 == l) v0 += dsk; if (s1 == l) v1 += dsk; mv[i] = v0; mv[4 + i] = v1; }
                }
                u32x4 bw; bw.x = cvt_pk_bf16_v(mv[0], mv[1]); bw.y = cvt_pk_bf16_v(mv[2], mv[3]); bw.z = cvt_pk_bf16_v(mv[4], mv[5]); bw.w = cvt_pk_bf16_v(mv[6], mv[7]);
                const bf16x8 bfrag = __builtin_bit_cast(bf16x8, bw);
#pragma unroll
                for (int pt = 0; pt < 4; ++pt) { const u32x2 lo = xlo[pt], hi = xhi[pt];
                    u32x4 aw; aw.x = lo.x; aw.y = lo.y; aw.z = hi.x; aw.w = hi.y;
                    ad[pt] = __builtin_amdgcn_mfma_f32_16x16x32_bf16(__builtin_bit_cast(bf16x8, aw), bfrag, ad[pt], 0, 0, 0); }
            }
        }
        if (j < 7) { cpair_load_s(F, tbase, pos0, 512 * g + 64 * (j + 1) + 2 * pp, sbx, xu); cpair_loadw(F, 512 * g + 64 * (j + 1) + 2 * pp, xw);
            const bf16* src = states + (((size_t)(b * 64 + c) * 64 + h + 1) * 64) * 128;
#pragma unroll
            for (int it = 0; it < 2; ++it) { const int i16 = F.tid + 512 * it; pvr[it] = *(const u32x4*)(src + (i16 >> 4) * 128 + 8 * (i16 & 15)); } }
        { bf16x8 pa[2][4];
#pragma unroll
          for (int pt = 0; pt < 4; ++pt) pa[0][pt] = *(const LAS bf16x8*)(PV + (16 * pt + c16) * LDP + 8 * q);
#pragma unroll
          for (int kn = 0; kn < 4; ++kn) {
              if (kn < 3) {
#pragma unroll
                  for (int pt = 0; pt < 4; ++pt) pa[(kn + 1) & 1][pt] = *(const LAS bf16x8*)(PV + (16 * pt + c16) * LDP + 32 * (kn + 1) + 8 * q); }
              __builtin_amdgcn_sched_barrier(0);
#pragma unroll
              for (int pt = 0; pt < 4; ++pt) ao[pt] = __builtin_amdgcn_mfma_f32_16x16x32_bf16(pa[kn & 1][pt], cmf[kn], ao[pt], 0, 0, 0);
              __builtin_amdgcn_sched_barrier(0); } }
        const float eal = __expf(al);
#pragma unroll
        for (int i = 0; i < 2; ++i) { u32x4 oq;
#pragma unroll
            for (int hh = 0; hh < 2; ++hh) { const int pt = 2 * i + hh; const unsigned z01 = hh ? zq[i].z : zq[i].x, z23 = hh ? zq[i].w : zq[i].y;
                const float y0 = (ad[pt][0] + eal * ao[pt][0]) * siluf_(bflo(z01)), y1 = (ad[pt][1] + eal * ao[pt][1]) * siluf_(bfhi(z01));
                const float y2 = (ad[pt][2] + eal * ao[pt][2]) * siluf_(bflo(z23)), y3 = (ad[pt][3] + eal * ao[pt][3]) * siluf_(bfhi(z23));
                ssq += (y0 * y0 + y1 * y1) + (y2 * y2 + y3 * y3);
                if (hh) { oq.z = cvt_pk_bf16(y0, y1); oq.w = cvt_pk_bf16(y2, y3); } else { oq.x = cvt_pk_bf16(y0, y1); oq.y = cvt_pk_bf16(y2, y3); } }
            if (j < 4) ((j < 2) ? parkA : parkB)[((j & 1) * 2 + i) * 512] = oq;
            else *(u32x4*)(yg + (size_t)(tbase + l) * ZI + 512 * g + 64 * j + 32 * i + 8 * q) = oq; }

        if (j < 7) { cpair_fix(pos0, sbx, xu); cpair_store_w<1>(2 * pp, sbx, (j & 1) ? XT0 : XT1, xu, xw, dts + (j + 1) * 128, acs + (j + 1) * 128, 0.f);
            LAS bf16* PVn = (j & 1) ? PV0 : PV1;
#pragma unroll
            for (int it = 0; it < 2; ++it) { const int i16 = F.tid + 512 * it; *(LAS u32x4*)(PVn + (i16 >> 4) * LDP + 8 * (i16 & 15)) = pvr[it]; } }
        __syncthreads();
    }
    ssq += __shfl_xor(ssq, 16); ssq += __shfl_xor(ssq, 32);
    const float rstd = rsqrtf(ssq * (1.f / 512.f) + EPS);
#define Y_RESCALE(J0, LOADV) do { u32x4 v[8]; f32x4 nw[16]; \
        _Pragma("unroll") for (int i = 0; i < 8; ++i) { const int ch = 512 * g + 64 * ((J0) + (i >> 1)) + 32 * (i & 1); nw[2 * i] = *(const f32x4*)(F.ssd_norm_w + ch + 4 * q); nw[2 * i + 1] = *(const f32x4*)(F.ssd_norm_w + ch + 16 + 4 * q); v[i] = LOADV; } \
        _Pragma("unroll") for (int i = 0; i < 8; ++i) { const int ch = 512 * g + 64 * ((J0) + (i >> 1)) + 32 * (i & 1); u32x4 o; \
            o.x = cvt_pk_bf16(bflo(v[i].x) * rstd * nw[2 * i][0], bfhi(v[i].x) * rstd * nw[2 * i][1]); o.y = cvt_pk_bf16(bflo(v[i].y) * rstd * nw[2 * i][2], bfhi(v[i].y) * rstd * nw[2 * i][3]); \
            o.z = cvt_pk_bf16(bflo(v[i].z) * rstd * nw[2 * i + 1][0], bfhi(v[i].z) * rstd * nw[2 * i + 1][1]); o.w = cvt_pk_bf16(bflo(v[i].w) * rstd * nw[2 * i + 1][2], bfhi(v[i].w) * rstd * nw[2 * i + 1][3]); \
            *(u32x4*)(yg + (size_t)(tbase + l) * ZI + ch + 8 * q) = o; } } while (0)
    Y_RESCALE(0, (((i < 4) ? parkA : parkB)[(((i >> 1) & 1) * 2 + (i & 1)) * 512]));
    asm volatile("s_waitcnt vmcnt(0)" ::: "memory");
    Y_RESCALE(4, (*(const u32x4*)(yg + (size_t)(tbase + l) * ZI + ch + 8 * q)));
#undef Y_RESCALE
}


constexpr int UTP = 2050;
__device__ __forceinline__ void p7_router(Frame& F) {
    LAS float* UT = (LAS float*)F.lds;
    const int lane = F.lane, w = F.wave, c16 = lane & 15, q = lane >> 4;
    float rwa[16][2], rwb[16][2];
    const float* rwp = F.router_w + (size_t)(256 * w + q) * NEXP + c16;
#define P7_LOADRW(buf, sc) do { const float* rp_ = rwp + (sc) * 2048; asm volatile("" : "+v"(rp_));   \
        const GAS float* rg_ = (const GAS float*)rp_;                       \
        _Pragma("unroll") for (int st = 0; st < 16; ++st) _Pragma("unroll") for (int nt = 0; nt < 2; ++nt) buf[st][nt] = rg_[st * 128 + 16 * nt]; } while (0)
#define P7_MMA(buf, sc) do { float av_[16]; _Pragma("unroll") for (int st = 0; st < 16; ++st) av_[st] = UT[c16 * UTP + 256 * w + 64 * (sc) + 4 * st + q];     \
        __builtin_amdgcn_sched_barrier(0); \
        _Pragma("unroll") for (int st = 0; st < 16; ++st) { acc[0] = __builtin_amdgcn_mfma_f32_16x16x4f32(av_[st], buf[st][0], acc[0], 0, 0, 0); acc[1] = __builtin_amdgcn_mfma_f32_16x16x4f32(av_[st], buf[st][1], acc[1], 0, 0, 0); } } while (0)
    const bf16* h1 = WSP(const bf16, WS_H1); uchar* u2 = WSP(uchar, WS_U);
    f32x4 wvn[8];
#pragma unroll
    for (int j = 0; j < 8; ++j) wvn[j] = *(const f32x4*)(F.norm_ffn_w + 4 * (lane + 64 * j));
    for (int grp = blockIdx.x; grp < T / 16; grp += F.G) {
        __syncthreads();
        P7_LOADRW(rwa, 0); asm volatile("" ::: "memory");
#pragma unroll
        for (int tt = 0; tt < 2; ++tt) { const int tl = 2 * w + tt, tok = grp * 16 + tl; const bf16* xr = h1 + (size_t)tok * D;
            f32x4 v[8]; float s = 0.f;
#pragma unroll
            for (int j = 0; j < 8; ++j) { const u32x2 hq = *(const u32x2*)(xr + 4 * (lane + 64 * j)); v[j] = (f32x4){bflo(hq.x), bfhi(hq.x), bflo(hq.y), bfhi(hq.y)}; s += (v[j][0] * v[j][0] + v[j][1] * v[j][1]) + (v[j][2] * v[j][2] + v[j][3] * v[j][3]); }
            const float rstd = rsqrtf(wave_sum(s) * (1.f / D) + EPS);
#pragma unroll
            for (int j = 0; j < 8; ++j) { const int col = 4 * (lane + 64 * j); const f32x4 wv = wvn[j];
                const float a0 = v[j][0] * rstd * wv[0], a1 = v[j][1] * rstd * wv[1], a2 = v[j][2] * rstd * wv[2], a3 = v[j][3] * rstd * wv[3];
                if constexpr (MOE_FP8) *(unsigned*)(u2 + (size_t)tok * D + col) = cvt4_fp8(a0, a1, a2, a3);
                else { u32x2 o; o.x = cvt_pk_bf16(a0, a1); o.y = cvt_pk_bf16(a2, a3); *(u32x2*)((bf16*)u2 + (size_t)tok * D + col) = o; }
                LAS float* d = UT + tl * UTP + col; *(LAS f32x2*)d = (f32x2){a0, a1}; *(LAS f32x2*)(d + 2) = (f32x2){a2, a3}; } }
        __syncthreads();
        f32x4 acc[2] = {(f32x4){0.f, 0.f, 0.f, 0.f}, (f32x4){0.f, 0.f, 0.f, 0.f}};
#define P7_FENCE asm volatile("" ::: "memory")
        P7_FENCE; P7_LOADRW(rwb, 1); P7_FENCE; P7_MMA(rwa, 0); P7_FENCE; P7_LOADRW(rwa, 2); P7_FENCE; P7_MMA(rwb, 1); P7_FENCE; P7_LOADRW(rwb, 3); P7_FENCE; P7_MMA(rwa, 2); P7_FENCE; P7_MMA(rwb, 3);
#undef P7_FENCE
        __syncthreads();
        LAS float* PL = UT;
#pragma unroll
        for (int nt = 0; nt < 2; ++nt)
#pragma unroll
            for (int r = 0; r < 4; ++r) PL[(w * 16 + 4 * q + r) * 32 + 16 * nt + c16] = acc[nt][r];
        __syncthreads();
        { const int tl = F.tid >> 5, e = F.tid & 31, tok = grp * 16 + tl;
          float lg = F.router_b[e];
#pragma unroll
          for (int ww = 0; ww < 8; ++ww) lg += PL[(ww * 16 + tl) * 32 + e];
          bool taken = false; float tv[4]; int ti[4];
#pragma unroll
          for (int k = 0; k < 4; ++k) { float cv = taken ? -3.0e38f : lg; int ci = e;
#pragma unroll
              for (int o = 16; o >= 1; o >>= 1) { const float ov = __shfl_xor(cv, o); const int oi = __shfl_xor(ci, o); const bool better = (ov > cv) || (ov == cv && oi < ci); cv = better ? ov : cv; ci = better ? oi : ci; }
              tv[k] = cv; ti[k] = ci; if (e == ci) taken = true; }
          const float e1 = __expf(tv[1] - tv[0]), e2 = __expf(tv[2] - tv[0]), e3 = __expf(tv[3] - tv[0]), inv = 1.0f / (1.0f + e1 + e2 + e3);
          if (e < 4) { const int ex = e == 0 ? ti[0] : (e == 1 ? ti[1] : (e == 2 ? ti[2] : ti[3])); const float gt = (e == 0 ? 1.0f : (e == 1 ? e1 : (e == 2 ? e2 : e3))) * inv;
              const unsigned pos = __hip_atomic_fetch_add((unsigned*)(F.ctl + CW_CNT + 64 * ex), 1u, RLX_AGENT);
              WSP(int, WS_SLOTTOK)[ex * T + (int)pos] = tok; WSP(int, WS_TOKE)[tok * 4 + e] = ex; WSP(int, WS_TOKPOS)[tok * 4 + e] = (int)pos; WSP(float, WS_GATE)[tok * 4 + e] = gt; } }
    }
}

#undef P7_LOADRW
#undef P7_MMA
__device__ __forceinline__ void moe_tables(Frame& F) {
    __syncthreads();
    if (F.tid < NEXP) F.LW[LW_CNT + F.tid] = __hip_atomic_load((unsigned*)(F.ctl + CW_CNT + 64 * F.tid), RLX_AGENT);
    __syncthreads();
    if (F.tid == 0) { unsigned a = 0; for (int e = 0; e < NEXP; ++e) { F.LW[LW_RBS + e] = a; a += (F.LW[LW_CNT + e] + 255u) >> 8; } F.LW[LW_RBS + NEXP] = a; }
    __syncthreads();
}

__device__ __forceinline__ void p10_combine(Frame& F) {
    const int gw = blockIdx.x * NWAVES + F.wave, NGW = F.G * NWAVES, lane = F.lane;
    const bf16* h1 = WSP(const bf16, WS_H1); const uchar* yb = WSP(const uchar, WS_YB);
    const int* toke = WSP(const int, WS_TOKE); const int* tokp = WSP(const int, WS_TOKPOS); const float* gate = WSP(const float, WS_GATE);
    f32x4 nw[4][2];
#pragma unroll
    for (int jj = 0; jj < 4; ++jj) { const int col = 8 * (lane + 64 * jj); nw[jj][0] = *(const f32x4*)(F.norm_final_w + col); nw[jj][1] = *(const f32x4*)(F.norm_final_w + col + 4); }
    int tok = gw;
    i32x4_t en = (i32x4_t){0, 0, 0, 0}, pn = (i32x4_t){0, 0, 0, 0}; f32x4 gn = (f32x4){0.f, 0.f, 0.f, 0.f};
    if (tok < T) { en = *(const i32x4_t*)(toke + tok * 4); pn = *(const i32x4_t*)(tokp + tok * 4); gn = *(const f32x4*)(gate + tok * 4); }
    for (; tok < T; tok += NGW) {
        const i32x4_t ec = en, pc = pn; const f32x4 gc = gn;
        const int tnext = tok + NGW;
        if (tnext < T) { en = *(const i32x4_t*)(toke + tnext * 4); pn = *(const i32x4_t*)(tokp + tnext * 4); gn = *(const f32x4*)(gate + tnext * 4); }
        float hv[4][8];
#pragma unroll
        for (int jj = 0; jj < 4; ++jj) { const u32x4 a = *(const u32x4*)(h1 + (size_t)tok * D + 8 * (lane + 64 * jj));
            hv[jj][0] = bflo(a.x); hv[jj][1] = bfhi(a.x); hv[jj][2] = bflo(a.y); hv[jj][3] = bfhi(a.y); hv[jj][4] = bflo(a.z); hv[jj][5] = bfhi(a.z); hv[jj][6] = bflo(a.w); hv[jj][7] = bfhi(a.w); }
#pragma unroll
        for (int k = 0; k < 4; ++k) { const int e = ec[k], pos = pc[k]; const float gt = gc[k] * (1.0f / YBS);
            const size_t slot = (size_t)F.LW[LW_RBS + e] * 256 + pos;
#pragma unroll
            for (int jj = 0; jj < 4; ++jj) { const u32x2 v = *(const u32x2*)(yb + slot * D + 8 * (lane + 64 * jj));
                const f32x2 p0 = __builtin_amdgcn_cvt_pk_f32_fp8((int)v.x, false), p1 = __builtin_amdgcn_cvt_pk_f32_fp8((int)v.x, true), p2 = __builtin_amdgcn_cvt_pk_f32_fp8((int)v.y, false), p3 = __builtin_amdgcn_cvt_pk_f32_fp8((int)v.y, true);
                hv[jj][0] += gt * p0[0]; hv[jj][1] += gt * p0[1]; hv[jj][2] += gt * p1[0]; hv[jj][3] += gt * p1[1]; hv[jj][4] += gt * p2[0]; hv[jj][5] += gt * p2[1]; hv[jj][6] += gt * p3[0]; hv[jj][7] += gt * p3[1]; } }
        float s = 0.f;
#pragma unroll
        for (int jj = 0; jj < 4; ++jj)
#pragma unroll
            for (int e = 0; e < 8; ++e) s += hv[jj][e] * hv[jj][e];
        const float rstd = rsqrtf(wave_sum(s) * (1.f / D) + EPS);
#pragma unroll
        for (int jj = 0; jj < 4; ++jj) { const int col = 8 * (lane + 64 * jj);
            float* o = F.out + (size_t)tok * D + col;
            *(f32x4*)o = (f32x4){hv[jj][0] * rstd * nw[jj][0][0], hv[jj][1] * rstd * nw[jj][0][1], hv[jj][2] * rstd * nw[jj][0][2], hv[jj][3] * rstd * nw[jj][0][3]};
            *(f32x4*)(o + 4) = (f32x4){hv[jj][4] * rstd * nw[jj][1][0], hv[jj][5] * rstd * nw[jj][1][1], hv[jj][6] * rstd * nw[jj][1][2], hv[jj][7] * rstd * nw[jj][1][3]}; }
    }
}

struct Args { const float* in[21]; float* out; unsigned char* ws; int ph_lo, ph_hi, li, pad; };
__global__ void __launch_bounds__(NWAVES * 64, 2) mk_fwd(Args args) {
    extern __shared__ __attribute__((aligned(16))) unsigned char lds[];
    Frame F;
    F.lds = (LAS uchar*)lds; F.LW = (volatile LAS unsigned*)(F.lds + LDSCTL_OFF);
    F.tid = threadIdx.x; F.lane = F.tid & 63; F.wave = __builtin_amdgcn_readfirstlane(F.tid >> 6); F.G = gridDim.x;
    F.ws = args.ws; F.out = args.out; F.ctl = (gu32*)(args.ws + WS_CTL);
    F.x = args.in[0]; F.norm_mix_w = args.in[1]; F.w_in = args.in[2]; F.w_pool = args.in[3]; F.pool_scale = args.in[4]; F.conv_w = args.in[5]; F.conv_b = args.in[6];
    F.dt_bias = args.in[7]; F.a_log = args.in[8]; F.d_skip = args.in[9]; F.ssd_norm_w = args.in[10]; F.w_ssd_out = args.in[11]; F.w_out = args.in[12]; F.norm_ffn_w = args.in[13];
    F.router_w = args.in[14]; F.router_b = args.in[15]; F.w_up = args.in[16]; F.b_up = args.in[17]; F.w_down = args.in[18]; F.b_down = args.in[19]; F.norm_final_w = args.in[20];
    for (int u = F.tid; u < 256; u += NWAVES * 64) F.LW[u] = 0u;
    __syncthreads();
    XcdBarrier bar; bar.bar = (unsigned*)(F.ctl + CW_BAR) + args.li * XCD_BAR_WORDS; bar.x = 0; bar.st = nullptr;
    if (N_LAUNCHES != NPHASES) bar = xcd_barrier_post((unsigned*)(F.ctl + CW_BAR) + args.li * XCD_BAR_WORDS, F.LW + LW_BAR);
    const int lo = args.ph_lo, hi = args.ph_hi;
#define IN(k) (lo <= (k) && (k) < hi)
#define SEAM(k) do { if (IN(k) && IN((k) + 1)) xcd_barrier(bar); } while (0)

    const bool split = (F.G == 256);
    const int bx = (int)blockIdx.x, xcd_ = bx & 7, slot_ = bx >> 3;
    const bool gemm_wg = !split || xcd_ < 6;
    const int G1 = split ? 192 : F.G, c1 = split ? slot_ * 6 + xcd_ : bx;
    if (IN(0)) { REPS(0) p0_prologue(F, !split); } SEAM(0);

    if (IN(1)) {
        if (gemm_wg) {
            { EpiInProj E{WSP(bf16, WS_XP), WSP(bf16, WS_Z), WSP(bf16, WS_XBC), WSP(bf16, WS_GP), WSP(bf16, WS_GS), WSP(float, WS_DT)};
              DenseOrder S; S.to.init(T / 256, 49, G1, c1, split ? 6 : 8); S.skip_lo = 48; S.skip_n = 16; S.Bt = WSP(const bf16, WS_WIN); S.K = D;
              pg8::gemm_phase<EpiInProj, DenseOrder, PG8_ALIGN, PG8_SP2>(F.lds, WSP(const bf16, WS_U), D, S, E); }
            __syncthreads();
            { EpiInProjT<true> E{WSP(bf16, WS_XP), WSP(bf16, WS_Z), WSP(bf16, WS_XBC), WSP(bf16, WS_GP), WSP(bf16, WS_GS), WSP(float, WS_DT)};
              DenseOrder S; S.K = D / 2; S.Bt = (const bf16*)(WSP(const char, WS_WIN8) - (size_t)48 * 256 * 2048);
              if (!split) { S.to.init(T / 256, 16, G1, c1, 8); S.pn0 = 48; }
              else if (c1 < 64) { S.to.init(T / 256, 4, 64, c1, 6); S.pn0 = 60; }
              else { S.to.init(T / 256, 12, 128, c1 - 64, 6); S.pn0 = 48; }
              pg8::gemm_phase<EpiInProjT<true>, DenseOrder, PG8_ALIGN, PG8_SP2, true>(F.lds, WSP(const bf16, WS_U8), D / 2, S, E); }
        } else p1_convert_late(F, (slot_ * 2 + (xcd_ - 6)) * NWAVES + F.wave, 64 * NWAVES);
    } SEAM(1);

    if (IN(2)) {
        if (split) { p0_convert<1>(F, (int)blockIdx.x * NWAVES + F.wave, F.G * NWAVES); __syncthreads(); }
        REPS(3) for (int u = blockIdx.x; u < 1024; u += F.G) p2_states_unit(F, u);
        REPS(12) p2_pool_items(F);
    } SEAM(2);

    if (IN(3)) {
        PoolOrder S{F.G, (int)blockIdx.x, WSP(const bf16, WS_WPOOL)};
        EpiPool E{WSP(bf16, WS_MERGED), WSP(const bf16, WS_GP), F.pool_scale};
        pg8::gemm_phase<EpiPool, PoolOrder, PG8_ALIGN, PG8_SP2>(F.lds, WSP(const bf16, WS_POOLED), 512, S, E);
        p3_scan(F);
    } SEAM(3);

    if (IN(5)) { REPS(5) for (int u = blockIdx.x; u < 1024; u += F.G) p4_unit(F, u); } SEAM(5);

    if (IN(6)) {
        DenseOrder S; S.to.init(T / 256, D / 256, F.G, (int)blockIdx.x); S.Bt = WSP(const bf16, WS_WSSD); S.K = ZI;
        EpiSsdOut E{WSP(bf16, WS_MERGED), WSP(const bf16, WS_GS)};
        pg8::gemm_phase<EpiSsdOut, DenseOrder, PG8_ALIGN, PG8_SP2>(F.lds, WSP(const bf16, WS_YG), ZI, S, E);
    } SEAM(6);

    if (IN(7)) {
        DenseOrder S; S.to.init(T / 256, D / 256, F.G, (int)blockIdx.x); S.Bt = WSP(const bf16, WS_WOUT); S.K = D;
        EpiWout E{F.x, WSP(bf16, WS_H1)};
        pg8::gemm_phase<EpiWout, DenseOrder, PG8_ALIGN, PG8_SP2>(F.lds, WSP(const bf16, WS_MERGED), D, S, E);
    } SEAM(7);

    if (IN(8)) { p7_router(F); } SEAM(8);

    if (IN(9)) {
        moe_tables(F);
        MoeOrder S; S.to.init((int)F.LW[LW_RBS + NEXP], 16, F.G, (int)blockIdx.x); S.Bt = WSP(const bf16, WS_WUP); S.K = MOE_FP8 ? D / 2 : D; S.estride_bytes = (size_t)4096 * 2048 * (MOE_FP8 ? 1 : 2); S.LW = F.LW; S.slot_tok = WSP(const int, WS_SLOTTOK); S.gather = true;
        EpiUp E{WSP(uchar, WS_ACT), F.b_up};
        pg8::gemm_phase<EpiUp, MoeOrder, PG8_ALIGN, PG8_SP2, MOE_FP8 != 0>(F.lds, WSP(const bf16, WS_U), MOE_FP8 ? D / 2 : D, S, E);
    } SEAM(9);

    if (IN(10)) {
        moe_tables(F);
        MoeOrder S; S.to.init((int)F.LW[LW_RBS + NEXP], 8, F.G, (int)blockIdx.x); S.Bt = WSP(const bf16, WS_WDOWN); S.K = MOE_FP8 ? D / 2 : D; S.estride_bytes = (size_t)2048 * 2048 * (MOE_FP8 ? 1 : 2); S.LW = F.LW; S.slot_tok = WSP(const int, WS_SLOTTOK); S.gather = false;
        EpiDown E{WSP(uchar, WS_YB), F.b_down};
        pg8::gemm_phase<EpiDown, MoeOrder, PG8_ALIGN, PG8_SP2, MOE_FP8 != 0>(F.lds, WSP(const bf16, WS_ACT), MOE_FP8 ? D / 2 : D, S, E);
    } SEAM(10);

    if (IN(11)) { moe_tables(F); REPS(11) p10_combine(F); }
#undef IN
#undef SEAM
}

extern "C" void kernel_launch(void* const* d_in, const int* in_sizes, int n_in, void* d_out, int out_size, void* d_ws, size_t ws_size, hipStream_t stream) {
    static int grid = 0;
    if (grid == 0) {
        if (n_in != 21 || in_sizes[0] != T * D || out_size != T * D || ws_size < WS_END) { fprintf(stderr, "kernel_launch: unexpected shapes (n_in %d, in0 %d, out %d, ws %zu < %zu); nothing launched\n", n_in, n_in > 0 ? in_sizes[0] : -1, out_size, ws_size, (size_t)WS_END); grid = -1; return; }
        int dev = 0, cus = 0, per_cu = 0;
        if (hipGetDevice(&dev) != hipSuccess || hipDeviceGetAttribute(&cus, hipDeviceAttributeMultiprocessorCount, dev) != hipSuccess) { grid = -1; return; }
        if (hipFuncSetAttribute((const void*)mk_fwd, hipFuncAttributeMaxDynamicSharedMemorySize, LDS_BYTES) != hipSuccess) { fprintf(stderr, "kernel_launch: hipFuncSetAttribute failed\n"); grid = -1; return; }
        if (hipOccupancyMaxActiveBlocksPerMultiprocessor(&per_cu, (const void*)mk_fwd, NWAVES * 64, LDS_BYTES) != hipSuccess || per_cu < 1)
            fprintf(stderr, "kernel_launch: note: occupancy query reports %d workgroups per CU\n", per_cu);
        (void)hipGetLastError();
        grid = cus;
    }
    if (grid < 0) return;
    if (hipMemsetAsync((char*)d_ws + WS_CTL, 0, CTL_ZERO_BYTES, stream) != hipSuccess) return;
    Args a{};
    for (int i = 0; i < 21; ++i) a.in[i] = (const float*)d_in[i];
    a.out = (float*)d_out; a.ws = (unsigned char*)d_ws;
    int lo = 0, li = 0;
    for (int k = 1; k <= NPHASES; ++k) {
        const bool cut = (k == NPHASES) || (N_LAUNCHES == NPHASES) || (N_LAUNCHES != 1 && ((MK_CUTS >> k) & 1));
        if (!cut) continue;
        a.ph_lo = lo; a.ph_hi = k; a.li = li; lo = k; ++li;
        hipLaunchKernelGGL(mk_fwd, dim3(grid), dim3(NWAVES * 64), LDS_BYTES, stream, a);
        const hipError_t le = hipPeekAtLastError();
        if (le != hipSuccess) { fprintf(stderr, "kernel_launch: launch %d failed: %s\n", li, hipGetErrorName(le)); break; }
    }
}
```

```cpp
#include <hip/hip_runtime.h>
#include <cstdio>
#include <cstdint>

#ifndef MK_N_LAUNCHES
#define MK_N_LAUNCHES 1
#endif

#define LAS __attribute__((address_space(3)))
#define GAS __attribute__((address_space(1)))
typedef unsigned short bf16;
typedef unsigned char uchar;
typedef short bf16x8 __attribute__((ext_vector_type(8)));
typedef float f32x4 __attribute__((ext_vector_type(4)));
typedef float f32x2 __attribute__((ext_vector_type(2)));
typedef unsigned u32x4 __attribute__((ext_vector_type(4)));
typedef unsigned u32x2 __attribute__((ext_vector_type(2)));
typedef int i32x8 __attribute__((ext_vector_type(8)));
typedef int i32x4_t __attribute__((ext_vector_type(4)));
typedef GAS unsigned gu32;
#define RLX_AGENT __ATOMIC_RELAXED, __HIP_MEMORY_SCOPE_AGENT
#define LDS_WAIT() asm volatile("s_waitcnt lgkmcnt(0)" ::: "memory")
#define VM_WAIT() asm volatile("s_waitcnt vmcnt(0)" ::: "memory")

__device__ __forceinline__ unsigned cvt_pk_bf16(float lo, float hi) { unsigned r; asm volatile("v_cvt_pk_bf16_f32 %0, %1, %2" : "=v"(r) : "v"(lo), "v"(hi)); return r; }
typedef __bf16 bf16x2_t __attribute__((ext_vector_type(2)));
__device__ __forceinline__ unsigned cvt_pk_bf16_v(float lo, float hi) { const f32x2 v = {lo, hi}; return __builtin_bit_cast(unsigned, __builtin_convertvector(v, bf16x2_t)); }
__device__ __forceinline__ unsigned cvt4_fp8(float a, float b, float c, float d) { int w = 0; w = __builtin_amdgcn_cvt_pk_fp8_f32(a, b, w, false); w = __builtin_amdgcn_cvt_pk_fp8_f32(c, d, w, true); return (unsigned)w; }
__device__ __forceinline__ float bflo(unsigned u) { return __uint_as_float(u << 16); }
__device__ __forceinline__ float bfhi(unsigned u) { return __uint_as_float(u & 0xffff0000u); }
__device__ __forceinline__ float sigmoidf_(float x) { return __builtin_amdgcn_rcpf(1.0f + __expf(-x)); }
__device__ __forceinline__ float siluf_(float x) { return x * __builtin_amdgcn_rcpf(1.0f + __expf(-x)); }
__device__ __forceinline__ float wave_sum(float v) {
#pragma unroll
    for (int o = 1; o < 64; o <<= 1) v += __shfl_xor(v, o);
    return v;
}

constexpr int T = 16384, D = 2048, SEQ = 8192;
constexpr int ZI = 4096, XBCW = 6144, NH = 64, NPAD = 16640, INCOLS = 16448;
constexpr int NEXP = 32;
constexpr float EPS = 1e-5f;

namespace pg8 {
constexpr int BM = 256, BK = 64, HALF = 128, HTB = HALF * BK * 2, STAGE_BYTES = 8 * HTB, NXCD = 8, WGM = 8;
__host__ __device__ __forceinline__ int lds_byte(int r, int c) { const int st = (r >> 4) * 2 + (c >> 5), rr = r & 15, cc = c & 31, ob = rr * 64 + cc * 2; return st * 1024 + (ob ^ (((ob >> 9) & 1) << 5)); }
__host__ __device__ __forceinline__ void stage_rc(int b, int& R, int& C) { const int st = b / 1024, sb = b % 1024, swz = sb ^ (((sb >> 9) & 1) << 5); R = (st >> 1) * 16 + swz / 64; C = (st & 1) * 32 + (swz % 64) / 2; }
__host__ __device__ __forceinline__ int perm32(int rho) { const int n = rho >> 4, i = rho & 15; return 8 * (i >> 2) + 4 * n + (i & 3); }

struct Unit { int pm, pn, e; };

struct TileOrder {
    int nM, nN, nwg, G, c, nx, wgm = WGM;
    __device__ __forceinline__ void init(int nM_, int nN_, int G_, int c_, int nx_ = NXCD) { nM = nM_; nN = nN_; nwg = nM * nN; G = G_; c = c_; nx = nx_; }
    __device__ __forceinline__ bool tile(int i, int& pm, int& pn) const {
        const long L = (long)i * G + c; if (L >= nwg) return false;
        int wgid = (int)L; { const int q = nwg / nx, r = nwg % nx, xcd = wgid % nx, off = wgid / nx; wgid = (xcd < r ? xcd * (q + 1) : r * (q + 1) + (xcd - r) * q) + off; }
        const int nig = wgm * nN, gid = wgid / nig, fm = gid * wgm, gsz = (nM - fm) < wgm ? (nM - fm) : wgm;
        pm = fm + ((wgid % nig) % gsz); pn = (wgid % nig) / gsz; return true;
    }
};

template <class Epi, class Sched, bool ALIGN_EPI, bool SP2, bool FP8 = false>
__device__ __forceinline__ void gemm_phase(LAS uchar* lds, const bf16* Abase, const int K, const Sched& S, const Epi& E) {
    const int tid = threadIdx.x, wid = __builtin_amdgcn_readfirstlane(tid >> 6), lane = tid & 63, wr = wid >> 2, wc = wid & 3, fr = lane & 15, fq = lane >> 4;
    const int nt = K / BK;
    unsigned voffB[2];
#pragma unroll
    for (int i = 0; i < 2; ++i) { int R, C; stage_rc(tid * 16 + i * 8192, R, C); const int Rb = Epi::PERM ? ((R & ~31) + perm32(R & 31)) : R;
        voffB[i] = (unsigned)(Rb * K + C) * 2u; }
#define PG8_AOFFS(dst, u) do { _Pragma("unroll") for (int h = 0; h < 2; ++h) _Pragma("unroll") for (int i = 0; i < 2; ++i) { int R, C; stage_rc(tid * 16 + i * 8192, R, C); \
        dst[h][i] = S.arow(u, h * HALF + R) + (unsigned)C * 2u; } } while (0)
    const size_t kstep = (size_t)(BK * 2);
    const size_t hstep = (size_t)HALF * K * 2;
    const unsigned ldsw = (unsigned)wid * 1024u;
    const int aoff = lds_byte(wr * 64 + fr, fq * 8), boff = lds_byte(wc * 32 + fr, fq * 8);
#define PG8_SA(b, h) (((b) * 2 + (h)) * HTB)
#define PG8_SB(b, h) ((4 + (b) * 2 + (h)) * HTB)
#define PG8_STAGE(bufoff, gbase, voff) do { _Pragma("unroll") for (int _i = 0; _i < 2; ++_i) \
        __builtin_amdgcn_global_load_lds((const unsigned*)((const char*)(gbase) + (voff)[_i]), (LAS unsigned*)(lds + (bufoff) + ldsw + _i * 8192), 16, 0, 0); } while (0)
#define PG8_RD(off) (*(const LAS u32x4*)(lds + (off)))
#define PG8_LDA(dst, b, h) do { _Pragma("unroll") for (int m = 0; m < 4; ++m) { if constexpr (FP8) dst##8[m] = __builtin_bit_cast(i32x8, __builtin_shufflevector(PG8_RD(PG8_SA(b, h) + aoff + m * 2048), PG8_RD(PG8_SA(b, h) + aoff + m * 2048 + 1024), 0, 1, 2, 3, 4, 5, 6, 7)); \
        else { _Pragma("unroll") for (int k = 0; k < 2; ++k) dst[m][k] = *(const LAS bf16x8*)(lds + PG8_SA(b, h) + aoff + m * 2048 + k * 1024); } } } while (0)
#define PG8_LDB(dst, b, h) do { _Pragma("unroll") for (int n = 0; n < 2; ++n) { if constexpr (FP8) dst##8[n] = __builtin_bit_cast(i32x8, __builtin_shufflevector(PG8_RD(PG8_SB(b, h) + boff + n * 2048), PG8_RD(PG8_SB(b, h) + boff + n * 2048 + 1024), 0, 1, 2, 3, 4, 5, 6, 7)); \
        else { _Pragma("unroll") for (int k = 0; k < 2; ++k) dst[n][k] = *(const LAS bf16x8*)(lds + PG8_SB(b, h) + boff + n * 2048 + k * 1024); } } } while (0)
#define PG8_MMA(ai, bj, At, Bt) do { __builtin_amdgcn_s_setprio(1); _Pragma("unroll") for (int m = 0; m < 4; ++m) _Pragma("unroll") for (int n = 0; n < 2; ++n) { \
        if constexpr (FP8) { asm volatile("v_mfma_scale_f32_16x16x128_f8f6f4 %0, %1, %2, %0, %3, %4 op_sel_hi:[0,0,0]" : "+v"(acc[ai][bj][m][n]) : "v"(Bt##8[n]), "v"(At##8[m]), "v"(sc_1), "v"(sc_1)); } \
        else { _Pragma("unroll") for (int k = 0; k < 2; ++k) acc[ai][bj][m][n] = __builtin_amdgcn_mfma_f32_16x16x32_bf16(Bt[n][k], At[m][k], acc[ai][bj][m][n], 0, 0, 0); } } \
        __builtin_amdgcn_s_setprio(0); } while (0)
#define PG8_WAIT_V(n) asm volatile("s_waitcnt vmcnt(" #n ")" ::: "memory")
#define PG8_WAIT_L(n) asm volatile("s_waitcnt lgkmcnt(" #n ")" ::: "memory")
#define PG8_BAR __builtin_amdgcn_s_barrier()
#define PG8_SCHED __builtin_amdgcn_sched_barrier(0)
    Unit cur, nxt; int ui = 0;
    if (!S.next(0, cur)) return;
    f32x4 acc[2][2][4][2];
#pragma unroll
    for (int a = 0; a < 2; ++a)
#pragma unroll
        for (int b = 0; b < 2; ++b)
#pragma unroll
            for (int m = 0; m < 4; ++m)
#pragma unroll
                for (int n = 0; n < 2; ++n) acc[a][b][m][n] = (f32x4){0.f, 0.f, 0.f, 0.f};
    bf16x8 At[4][2], B0[2][2], B1[2][2];
    i32x8 At8[4], B08[2], B18[2];
    int sc_1 = 0x7F7F7F7F;
    if constexpr (FP8) asm volatile("" : "+v"(sc_1));
    unsigned vA[2][2];
    LAS u32x4* nva_lds = (LAS u32x4*)(lds + STAGE_BYTES) + tid;
    PG8_AOFFS(vA, cur); *nva_lds = (u32x4){vA[0][0], vA[0][1], vA[1][0], vA[1][1]};
    const char* cA = (const char*)Abase; const char* cB = S.bbase(cur);
    if constexpr (SP2) {
        PG8_STAGE(PG8_SB(0, 0), cB, voffB); PG8_STAGE(PG8_SB(0, 1), cB + hstep, voffB); PG8_STAGE(PG8_SA(0, 0), cA, vA[0]); PG8_STAGE(PG8_SA(0, 1), cA, vA[1]);
        if (wr == 1) PG8_BAR;
        PG8_WAIT_V(2); PG8_BAR;
        PG8_STAGE(PG8_SB(1, 0), cB + kstep, voffB); PG8_STAGE(PG8_SA(1, 0), cA + kstep, vA[0]); PG8_STAGE(PG8_SB(1, 1), cB + hstep + kstep, voffB);
        PG8_WAIT_V(6); PG8_BAR;
    } else {
        PG8_STAGE(PG8_SB(0, 0), cB, voffB); PG8_STAGE(PG8_SA(0, 0), cA, vA[0]); PG8_STAGE(PG8_SB(0, 1), cB + hstep, voffB); PG8_STAGE(PG8_SA(0, 1), cA, vA[1]);
        if (wr == 1) PG8_BAR;
        PG8_WAIT_V(4); PG8_BAR;
        PG8_STAGE(PG8_SB(1, 0), cB + kstep, voffB); PG8_STAGE(PG8_SA(1, 0), cA + kstep, vA[0]); PG8_STAGE(PG8_SB(1, 1), cB + hstep + kstep, voffB);
        PG8_WAIT_V(6); PG8_BAR;
    }
    for (;;) {
        const bool has_next = S.next(ui + 1, nxt);
        const char* nB = has_next ? S.bbase(nxt) : cB;
        if (has_next) { unsigned nvA[2][2]; PG8_AOFFS(nvA, nxt); *nva_lds = (u32x4){nvA[0][0], nvA[0][1], nvA[1][0], nvA[1][1]}; }
        for (int t = 0; t < nt; t += 2) {
            const bool last = (t == nt - 2);
            const char* a1 = cA + (size_t)(t + 1) * kstep;
            const char* a2 = last ? cA : cA + (size_t)(t + 2) * kstep; const char* b2 = last ? nB : cB + (size_t)(t + 2) * kstep;
            const char* a3 = a2 + kstep; const char* b3 = b2 + kstep;
#define PG8_SWAPA do { if (last) { const u32x4 t_ = *nva_lds; vA[0][0] = t_[0]; vA[0][1] = t_[1]; vA[1][0] = t_[2]; vA[1][1] = t_[3]; } } while (0)
            if constexpr (SP2) {
            PG8_LDB(B0, 0, 0); PG8_LDB(B1, 0, 1); PG8_SCHED; PG8_LDA(At, 0, 0); PG8_STAGE(PG8_SA(1, 1), a1, vA[1]); PG8_SWAPA;
            PG8_WAIT_V(8); PG8_WAIT_L(0); PG8_BAR; PG8_MMA(0, 0, At, B0); PG8_MMA(0, 1, At, B1); PG8_BAR; PG8_SCHED;
            PG8_LDA(At, 0, 1); PG8_STAGE(PG8_SB(0, 0), b2, voffB); PG8_STAGE(PG8_SB(0, 1), b2 + hstep, voffB); PG8_STAGE(PG8_SA(0, 0), a2, vA[0]);
            PG8_WAIT_V(8); PG8_WAIT_L(0); PG8_BAR; PG8_MMA(1, 0, At, B0); PG8_MMA(1, 1, At, B1); PG8_BAR; PG8_SCHED;
            PG8_LDB(B0, 1, 0); PG8_LDB(B1, 1, 1); PG8_SCHED; PG8_LDA(At, 1, 0); PG8_STAGE(PG8_SA(0, 1), a2, vA[1]);
            PG8_WAIT_V(8); PG8_WAIT_L(0); PG8_BAR; PG8_MMA(0, 0, At, B0); PG8_MMA(0, 1, At, B1); PG8_BAR; PG8_SCHED;
            PG8_LDA(At, 1, 1); PG8_STAGE(PG8_SB(1, 0), b3, voffB); PG8_STAGE(PG8_SB(1, 1), b3 + hstep, voffB); PG8_STAGE(PG8_SA(1, 0), a3, vA[0]);
            PG8_WAIT_V(8); PG8_WAIT_L(0); PG8_BAR; PG8_MMA(1, 0, At, B0); PG8_MMA(1, 1, At, B1); PG8_BAR; PG8_SCHED;
            } else {
            PG8_LDB(B0, 0, 0); PG8_SCHED; PG8_LDA(At, 0, 0); PG8_STAGE(PG8_SA(1, 1), a1, vA[1]); PG8_SWAPA;
            PG8_WAIT_L(8); PG8_BAR; PG8_WAIT_L(0); PG8_MMA(0, 0, At, B0); PG8_BAR; PG8_SCHED;
            PG8_LDB(B1, 0, 1); PG8_STAGE(PG8_SB(0, 0), b2, voffB);
            PG8_BAR; PG8_WAIT_L(0); PG8_MMA(0, 1, At, B1); PG8_BAR;
            PG8_LDA(At, 0, 1); PG8_STAGE(PG8_SA(0, 0), a2, vA[0]);
            PG8_BAR; PG8_WAIT_L(0); PG8_MMA(1, 0, At, B0); PG8_BAR; PG8_SCHED;
            PG8_STAGE(PG8_SB(0, 1), b2 + hstep, voffB);
            PG8_WAIT_V(6); PG8_BAR; PG8_MMA(1, 1, At, B1); PG8_BAR;
            PG8_LDB(B0, 1, 0); PG8_SCHED; PG8_LDA(At, 1, 0); PG8_STAGE(PG8_SA(0, 1), a2, vA[1]);
            PG8_WAIT_L(8); PG8_BAR; PG8_WAIT_L(0); PG8_MMA(0, 0, At, B0); PG8_BAR; PG8_SCHED;
            PG8_LDB(B1, 1, 1); PG8_STAGE(PG8_SB(1, 0), b3, voffB);
            PG8_BAR; PG8_WAIT_L(0); PG8_MMA(0, 1, At, B1); PG8_BAR;
            PG8_LDA(At, 1, 1); PG8_STAGE(PG8_SA(1, 0), a3, vA[0]);
            PG8_BAR; PG8_WAIT_L(0); PG8_MMA(1, 0, At, B0); PG8_BAR; PG8_SCHED;
            PG8_STAGE(PG8_SB(1, 1), b3 + hstep, voffB);
            PG8_WAIT_V(6); PG8_BAR; PG8_MMA(1, 1, At, B1); PG8_BAR;
            }
        }
        if constexpr (ALIGN_EPI) { if (wr == 0) PG8_BAR; }
        if constexpr (FP8) asm volatile("s_nop 15\n\ts_nop 15" ::: "memory");
        E(acc, cur, wr, wc, fr, fq);
        if constexpr (FP8) asm volatile("s_nop 7" ::: "memory");
        if (!has_next) break;
#pragma unroll
        for (int a = 0; a < 2; ++a)
#pragma unroll
            for (int b = 0; b < 2; ++b)
#pragma unroll
                for (int m = 0; m < 4; ++m)
#pragma unroll
                    for (int n = 0; n < 2; ++n) acc[a][b][m][n] = (f32x4){0.f, 0.f, 0.f, 0.f};
        cur = nxt; cB = nB; ++ui;
        if constexpr (ALIGN_EPI) { if (wr == 1) PG8_BAR; }
    }
    PG8_WAIT_V(0);
    if constexpr (!ALIGN_EPI) { if (wr == 0) PG8_BAR; }
    PG8_BAR;
#undef PG8_SA
#undef PG8_SB
#undef PG8_STAGE
#undef PG8_RD
#undef PG8_AOFFS
#undef PG8_SWAPA
#undef PG8_LDA
#undef PG8_LDB
#undef PG8_MMA
#undef PG8_WAIT_V
#undef PG8_WAIT_L
#undef PG8_BAR
#undef PG8_SCHED
}
}

#ifndef PG8_SP2
#define PG8_SP2 true
#endif
#ifndef PG8_ALIGN
#define PG8_ALIGN true
#endif

constexpr int NWAVES = 8;
constexpr int NPHASES = 12;
constexpr int N_LAUNCHES = MK_N_LAUNCHES;
#ifndef MOE_FP8
#define MOE_FP8 1
#endif
#ifndef MK_DOUBLE
#define MK_DOUBLE -1
#endif
#define REPS(k) for (int rep_ = 0; rep_ < ((MK_DOUBLE) == (k) ? 2 : 1); ++rep_)
#ifndef MK_CUTS
#define MK_CUTS 0x7fe
#endif

constexpr size_t MiB = 1u << 20;
constexpr size_t WS_CTL = 0, CTL_ZERO_BYTES = 256 * 1024;
constexpr size_t WS_WIN = 1 * MiB, WS_WPOOL = 66 * MiB, WS_WSSD = 68 * MiB, WS_WOUT = 84 * MiB, WS_WUP = 92 * MiB, WS_WDOWN = 604 * MiB;
constexpr size_t WS_U = 860 * MiB, WS_XP = 924 * MiB, WS_Z = 988 * MiB, WS_XBC = 1116 * MiB, WS_GP = 1308 * MiB, WS_GS = 1372 * MiB, WS_DT = 1436 * MiB;
constexpr size_t WS_POOLED = 1440 * MiB, WS_STATES = 1504 * MiB, WS_CDEC = 1632 * MiB, WS_YG = 1633 * MiB, WS_MERGED = 1761 * MiB, WS_H1 = 1825 * MiB;
constexpr size_t WS_ACT = 1953 * MiB, WS_YB = 2241 * MiB, WS_SLOTTOK = 2529 * MiB, WS_TOKE = 2531 * MiB, WS_TOKPOS = 2532 * MiB, WS_GATE = 2533 * MiB, WS_XC = 2534 * MiB, WS_U8 = 2534 * MiB  , WS_WIN8 = 2574 * MiB  , WS_END = 2726 * MiB;
static_assert(WS_WIN + (size_t)NPAD * D * 2 <= WS_WPOOL && WS_WUP + (size_t)NEXP * 4096 * 2048 * 2 <= WS_WDOWN && WS_WDOWN + (size_t)NEXP * 2048 * 2048 * 2 <= WS_U, "ws map (weights)");
static_assert(WS_XBC + (size_t)T * XBCW * 2 <= WS_GP && WS_STATES + (size_t)2 * 64 * 64 * 64 * 128 * 2 <= WS_CDEC && WS_ACT + (size_t)288 * 256 * 2048 * 2 <= WS_YB && WS_YB + (size_t)288 * 256 * 2048 * 2 <= WS_SLOTTOK, "ws map");
constexpr int CW_TMO = 0, CW_BAR = 4096, CW_CNT = 49152;
static_assert((CW_CNT + 64 * NEXP) * 4 <= (int)CTL_ZERO_BYTES, "ctl");

constexpr int LDS_BYTES = 147456;
constexpr int LDSCTL_OFF = LDS_BYTES - 1024;
constexpr int LW_BAR = 8, LW_RBS = 16, LW_CNT = 64;

#define XB_TMO      128
#define XB_XCNT(j)  (256  + 64 * (j))
#define XB_XSUB(j)  (1280 + 64 * (j))
#define XB_XGEN(j)  (2304 + 64 * (j))
#define XB_TOP      3328
#define XB_TOPGEN   3392
#define XCD_BAR_WORDS 3456
#define XB_SPIN_CAP (1u << 18)
__device__ __forceinline__ unsigned xb_ld(unsigned* p)              { return __hip_atomic_load(p, __ATOMIC_RELAXED, __HIP_MEMORY_SCOPE_AGENT); }
__device__ __forceinline__ unsigned xb_add(unsigned* p, unsigned v) { return __hip_atomic_fetch_add(p, v, __ATOMIC_RELAXED, __HIP_MEMORY_SCOPE_AGENT); }
__device__ __forceinline__ unsigned xb_xcc_id() { return (unsigned)__builtin_amdgcn_s_getreg((3 << 11) | 20) & 0xFu; }
#define XB_SPIN(cond, bar) do { unsigned _sp = 0; while (cond) { __builtin_amdgcn_s_sleep(1); \
    if ((++_sp & 255u) == 0u) { if (xb_ld(&(bar)[XB_TMO])) break; if (_sp > XB_SPIN_CAP) { atomicAdd(&(bar)[XB_TMO], 1u); break; } } } } while (0)
struct XcdBarrier { unsigned* bar; unsigned x; volatile LAS unsigned* st; };
__device__ __forceinline__ XcdBarrier xcd_barrier_post(unsigned* bar, volatile LAS unsigned* st) {
    XcdBarrier b; b.bar = bar; b.x = xb_xcc_id(); b.st = st;
    if (threadIdx.x == 0) (void)xb_add(&bar[XB_XCNT(b.x)], 1u);
    return b;
}
__device__ __forceinline__ void xcd_barrier_complete(unsigned* bar, unsigned x, unsigned& nloc, unsigned& nx) {
    const unsigned G = gridDim.x * gridDim.y * gridDim.z;
    unsigned sum, cnt, mine, sp = 0u;
    for (;;) {
        sum = 0u; cnt = 0u; mine = 0u;
#pragma unroll
        for (unsigned j = 0; j < 16; ++j) { const unsigned c = xb_ld(&bar[XB_XCNT(j)]); sum += c; cnt += (c > 0u) ? 1u : 0u; mine = (j == x) ? c : mine; }
        if (sum == G) break;
        __builtin_amdgcn_s_sleep(1);
        if ((++sp & 255u) == 0u) { if (xb_ld(&bar[XB_TMO])) break; if (sp > XB_SPIN_CAP) { atomicAdd(&bar[XB_TMO], 1u); break; } }
    }
    nloc = mine > 0u ? mine : 1u; nx = cnt > 0u ? cnt : 1u;
}
__device__ __forceinline__ void xcd_barrier(const XcdBarrier& b) {
    asm volatile("s_waitcnt vmcnt(0)" ::: "memory");
    __syncthreads();
    if (threadIdx.x == 0) {
        unsigned* bar = b.bar;
        __builtin_amdgcn_s_waitcnt(0);
        unsigned nloc = b.st[0], nx = b.st[1];
        if (nloc == 0u) { xcd_barrier_complete(bar, b.x, nloc, nx); b.st[0] = nloc; b.st[1] = nx; }
        const unsigned old = xb_add(&bar[XB_XSUB(b.x)], 1u);
        const unsigned gen = old / nloc;
        if (old + 1u == (gen + 1u) * nloc) {
            __builtin_amdgcn_fence(__ATOMIC_RELEASE, "agent");
            asm volatile("s_waitcnt vmcnt(0)" ::: "memory");
            const unsigned og = xb_add(&bar[XB_TOP], 1u);
            const unsigned tg = og / nx;
            if (og + 1u == (tg + 1u) * nx) xb_add(&bar[XB_TOPGEN], 1u);
            else XB_SPIN(xb_ld(&bar[XB_TOPGEN]) == tg, bar);
            __builtin_amdgcn_fence(__ATOMIC_ACQUIRE, "agent");
            xb_add(&bar[XB_XGEN(b.x)], 1u);
            asm volatile("s_waitcnt vmcnt(0)" ::: "memory");
        } else {
            XB_SPIN(xb_ld(&bar[XB_XGEN(b.x)]) == gen, bar);
            __builtin_amdgcn_fence(__ATOMIC_ACQUIRE, "agent");
            asm volatile("s_waitcnt vmcnt(0)" ::: "memory");
        }
    }
    __syncthreads();
}

struct Frame {
    LAS uchar* lds; volatile LAS unsigned* LW; gu32* ctl;
    int tid, lane, wave, G;
    uchar* ws; float* out;
    const float *x, *norm_mix_w, *w_in, *w_pool, *pool_scale, *conv_w, *conv_b, *dt_bias, *a_log, *d_skip, *ssd_norm_w, *w_ssd_out, *w_out, *norm_ffn_w, *router_w, *router_b, *w_up, *b_up, *w_down, *b_down, *norm_final_w;
};
#define WSP(type, off) ((type*)(F.ws + (off)))

struct DenseOrder {
    pg8::TileOrder to; const bf16* Bt; int K; int pn0 = 0, skip_lo = 1 << 20, skip_n = 0;
    __device__ __forceinline__ bool next(int i, pg8::Unit& u) const { u.e = 0; const bool ok = to.tile(i, u.pm, u.pn); u.pn += pn0; if (u.pn >= skip_lo) u.pn += skip_n; return ok; }
    __device__ __forceinline__ unsigned arow(const pg8::Unit& u, int R) const { return (unsigned)(u.pm * 256 + R) * (unsigned)(K * 2); }
    __device__ __forceinline__ const char* bbase(const pg8::Unit& u) const { return (const char*)Bt + (size_t)u.pn * 256 * K * 2; }
};
struct PoolOrder {
    int G, c; const bf16* Bt;
    __device__ __forceinline__ bool next(int i, pg8::Unit& u) const { const int L = i * G + c; if (L >= 512) return false; u.e = L >> 7; u.pm = (L & 127) >> 1; u.pn = L & 1; return true; }
    __device__ __forceinline__ unsigned arow(const pg8::Unit& u, int R) const { return (unsigned)(u.e * T + u.pm * 256 + R) * 1024u; }
    __device__ __forceinline__ const char* bbase(const pg8::Unit& u) const { return (const char*)Bt + (size_t)(u.e * 512 + u.pn * 256) * 1024; }
};
struct MoeOrder {
    pg8::TileOrder to; const bf16* Bt; int K; size_t estride_bytes; volatile LAS unsigned* LW; const int* slot_tok; bool gather;
    __device__ __forceinline__ bool next(int i, pg8::Unit& u) const {
        if (!to.tile(i, u.pm, u.pn)) return false;
        int e = 0;
#pragma unroll 8
        for (int j = 1; j <= NEXP; ++j) e += ((int)LW[LW_RBS + j] <= u.pm) ? 1 : 0;
        u.e = __builtin_amdgcn_readfirstlane(e); return true;
    }
    __device__ __forceinline__ unsigned arow(const pg8::Unit& u, int R) const {
        if (!gather) return (unsigned)(u.pm * 256 + R) * (unsigned)(K * 2);
        const int idx = (u.pm - (int)LW[LW_RBS + u.e]) * 256 + R, cnt = (int)LW[LW_CNT + u.e];
        const int tok = slot_tok[u.e * T + (idx < cnt ? idx : 0)];
        return (unsigned)(idx < cnt ? tok : 0) * (unsigned)(K * 2);
    }
    __device__ __forceinline__ const char* bbase(const pg8::Unit& u) const { return (const char*)Bt + (size_t)u.e * estride_bytes + (size_t)u.pn * 256 * K * 2; }
};

template <bool F8>
struct EpiInProjT {
    static constexpr bool PERM = true;
    bf16 *xp, *z, *xbc, *gp, *gs; float* dt;
    __device__ __forceinline__ void operator()(const f32x4 (&acc)[2][2][4][2], const pg8::Unit& u, int wr, int wc, int fr, int fq) const {
        const int row0 = u.pm * 256 + wr * 64 + fr, pn = u.pn;
        if (pn == 64) {
            if (wc < 2) {
#pragma unroll
                for (int ai = 0; ai < 2; ++ai)
#pragma unroll
                    for (int m = 0; m < 4; ++m) { float* p = dt + (size_t)(row0 + ai * 128 + m * 16) * 64 + wc * 32 + 8 * fq; *(f32x4*)p = acc[ai][0][m][0]; *(f32x4*)(p + 4) = acc[ai][0][m][1]; }
            }
            return;
        }
        bf16* base; int ldc, colt;
        if (pn < 8) { base = xp; ldc = 2048; colt = pn * 256; } else if (pn < 24) { base = z; ldc = 4096; colt = (pn - 8) * 256; } else if (pn < 48) { base = xbc; ldc = 6144; colt = (pn - 24) * 256; }
        else if (pn < 56) { base = gp; ldc = 2048; colt = (pn - 48) * 256; } else { base = gs; ldc = 2048; colt = (pn - 56) * 256; }
        const int col0 = colt + wc * 32 + 8 * fq;
#pragma unroll
        for (int ai = 0; ai < 2; ++ai)
#pragma unroll
            for (int m = 0; m < 4; ++m) { bf16* rowp = base + (size_t)(row0 + ai * 128 + m * 16) * ldc + col0;
#pragma unroll
                for (int bj = 0; bj < 2; ++bj) { constexpr float sc = F8 ? 1.0f / 32.0f : 1.0f; const f32x4 v0 = acc[ai][bj][m][0] * sc, v1 = acc[ai][bj][m][1] * sc;
                    u32x4 w; w.x = cvt_pk_bf16(v0[0], v0[1]); w.y = cvt_pk_bf16(v0[2], v0[3]); w.z = cvt_pk_bf16(v1[0], v1[1]); w.w = cvt_pk_bf16(v1[2], v1[3]);
                    *(u32x4*)(rowp + bj * 128) = w; } }
    }
};
typedef EpiInProjT<false> EpiInProj;
struct EpiPool {
    static constexpr bool PERM = true;
    bf16* merged; const bf16* gp; const float* ps;
    __device__ __forceinline__ void operator()(const f32x4 (&acc)[2][2][4][2], const pg8::Unit& u, int wr, int wc, int fr, int fq) const {
        const int row0 = u.pm * 256 + wr * 64 + fr, col0 = u.e * 512 + u.pn * 256 + wc * 32 + 8 * fq;
        f32x4 sv[2][2];
#pragma unroll
        for (int bj = 0; bj < 2; ++bj)
#pragma unroll
            for (int n = 0; n < 2; ++n) sv[bj][n] = *(const f32x4*)(ps + col0 + bj * 128 + 4 * n);
#pragma unroll
        for (int ai = 0; ai < 2; ++ai) {
            u32x4 gq[4][2];
#pragma unroll
            for (int m = 0; m < 4; ++m)
#pragma unroll
                for (int bj = 0; bj < 2; ++bj) gq[m][bj] = *(const u32x4*)(gp + (size_t)(row0 + ai * 128 + m * 16) * 2048 + col0 + bj * 128);
#pragma unroll
            for (int m = 0; m < 4; ++m) { const size_t ro = (size_t)(row0 + ai * 128 + m * 16) * 2048 + col0;
#pragma unroll
                for (int bj = 0; bj < 2; ++bj) { const u32x4 g = gq[m][bj];
                    const f32x4 v0 = acc[ai][bj][m][0] * sv[bj][0], v1 = acc[ai][bj][m][1] * sv[bj][1];
                    u32x4 w; w.x = cvt_pk_bf16(v0[0] * sigmoidf_(bflo(g.x)), v0[1] * sigmoidf_(bfhi(g.x))); w.y = cvt_pk_bf16(v0[2] * sigmoidf_(bflo(g.y)), v0[3] * sigmoidf_(bfhi(g.y)));
                    w.z = cvt_pk_bf16(v1[0] * sigmoidf_(bflo(g.z)), v1[1] * sigmoidf_(bfhi(g.z))); w.w = cvt_pk_bf16(v1[2] * sigmoidf_(bflo(g.w)), v1[3] * sigmoidf_(bfhi(g.w)));
                    *(u32x4*)(merged + ro + bj * 128) = w; } } }
    }
};
struct EpiSsdOut {
    static constexpr bool PERM = true;
    bf16* merged; const bf16* gs;
    __device__ __forceinline__ void operator()(const f32x4 (&acc)[2][2][4][2], const pg8::Unit& u, int wr, int wc, int fr, int fq) const {
        const int row0 = u.pm * 256 + wr * 64 + fr, col0 = u.pn * 256 + wc * 32 + 8 * fq;
#pragma unroll
        for (int ai = 0; ai < 2; ++ai) {
            u32x4 gq[4][2], pq[4][2];
#pragma unroll
            for (int m = 0; m < 4; ++m)
#pragma unroll
                for (int bj = 0; bj < 2; ++bj) { const size_t ro = (size_t)(row0 + ai * 128 + m * 16) * 2048 + col0 + bj * 128; gq[m][bj] = *(const u32x4*)(gs + ro); pq[m][bj] = *(const u32x4*)(merged + ro); }
#pragma unroll
            for (int m = 0; m < 4; ++m) { const size_t ro = (size_t)(row0 + ai * 128 + m * 16) * 2048 + col0;
#pragma unroll
                for (int bj = 0; bj < 2; ++bj) { const u32x4 g = gq[m][bj]; const u32x4 p = pq[m][bj];
                    const f32x4 v0 = acc[ai][bj][m][0], v1 = acc[ai][bj][m][1];
                    u32x4 w; w.x = cvt_pk_bf16(v0[0] * sigmoidf_(bflo(g.x)) + bflo(p.x), v0[1] * sigmoidf_(bfhi(g.x)) + bfhi(p.x)); w.y = cvt_pk_bf16(v0[2] * sigmoidf_(bflo(g.y)) + bflo(p.y), v0[3] * sigmoidf_(bfhi(g.y)) + bfhi(p.y));
                    w.z = cvt_pk_bf16(v1[0] * sigmoidf_(bflo(g.z)) + bflo(p.z), v1[1] * sigmoidf_(bfhi(g.z)) + bfhi(p.z)); w.w = cvt_pk_bf16(v1[2] * sigmoidf_(bflo(g.w)) + bflo(p.w), v1[3] * sigmoidf_(bfhi(g.w)) + bfhi(p.w));
                    *(u32x4*)(merged + ro + bj * 128) = w; } } }
    }
};
struct EpiWout {
    static constexpr bool PERM = true;
    const float* x; bf16* h1;
    __device__ __forceinline__ void operator()(const f32x4 (&acc)[2][2][4][2], const pg8::Unit& u, int wr, int wc, int fr, int fq) const {
        const int row0 = u.pm * 256 + wr * 64 + fr, col0 = u.pn * 256 + wc * 32 + 8 * fq;
#pragma unroll
        for (int ai = 0; ai < 2; ++ai) {
            f32x4 xq[4][2][2];
#pragma unroll
            for (int m = 0; m < 4; ++m)
#pragma unroll
                for (int bj = 0; bj < 2; ++bj)
#pragma unroll
                    for (int n = 0; n < 2; ++n) xq[m][bj][n] = *(const f32x4*)(x + (size_t)(row0 + ai * 128 + m * 16) * 2048 + col0 + bj * 128 + n * 4);
#pragma unroll
            for (int m = 0; m < 4; ++m) { const size_t ro = (size_t)(row0 + ai * 128 + m * 16) * 2048 + col0;
#pragma unroll
                for (int bj = 0; bj < 2; ++bj) { const f32x4 v0 = xq[m][bj][0] + acc[ai][bj][m][0], v1 = xq[m][bj][1] + acc[ai][bj][m][1];
                    u32x4 w; w.x = cvt_pk_bf16(v0[0], v0[1]); w.y = cvt_pk_bf16(v0[2], v0[3]); w.z = cvt_pk_bf16(v1[0], v1[1]); w.w = cvt_pk_bf16(v1[2], v1[3]);
                    *(u32x4*)(h1 + ro + bj * 128) = w; } } }
    }
};
constexpr float WSC = MOE_FP8 ? 1.0f / 32.0f : 1.0f;
__device__ __forceinline__ float swiglu_(float glu, float lin) { glu = fminf(glu, 7.0f); lin = fminf(fmaxf(lin, -7.0f), 7.0f); return glu * sigmoidf_(1.702f * glu) * (lin + 1.0f); }
struct EpiUp {
    static constexpr bool PERM = true;
    uchar* act; const float* b_up;
    __device__ __forceinline__ void operator()(const f32x4 (&acc)[2][2][4][2], const pg8::Unit& u, int wr, int wc, int fr, int fq) const {
        const int row0 = u.pm * 256 + wr * 64 + fr, col0 = u.pn * 128 + wc * 32 + 8 * fq;
        const float* bb = b_up + (size_t)u.e * 4096 + col0;
        const f32x4 bg0 = *(const f32x4*)bb, bg1 = *(const f32x4*)(bb + 4), bl0 = *(const f32x4*)(bb + 2048), bl1 = *(const f32x4*)(bb + 2052);
#pragma unroll
        for (int ai = 0; ai < 2; ++ai)
#pragma unroll
            for (int m = 0; m < 4; ++m) {
                const f32x4 g0 = acc[ai][0][m][0] * WSC + bg0, g1 = acc[ai][0][m][1] * WSC + bg1, l0 = acc[ai][1][m][0] * WSC + bl0, l1 = acc[ai][1][m][1] * WSC + bl1;
                if constexpr (MOE_FP8) { u32x2 w; w.x = cvt4_fp8(swiglu_(g0[0], l0[0]), swiglu_(g0[1], l0[1]), swiglu_(g0[2], l0[2]), swiglu_(g0[3], l0[3]));
                    w.y = cvt4_fp8(swiglu_(g1[0], l1[0]), swiglu_(g1[1], l1[1]), swiglu_(g1[2], l1[2]), swiglu_(g1[3], l1[3]));
                    *(u32x2*)(act + (size_t)(row0 + ai * 128 + m * 16) * 2048 + col0) = w; }
                else { u32x4 w; w.x = cvt_pk_bf16(swiglu_(g0[0], l0[0]), swiglu_(g0[1], l0[1])); w.y = cvt_pk_bf16(swiglu_(g0[2], l0[2]), swiglu_(g0[3], l0[3]));
                    w.z = cvt_pk_bf16(swiglu_(g1[0], l1[0]), swiglu_(g1[1], l1[1])); w.w = cvt_pk_bf16(swiglu_(g1[2], l1[2]), swiglu_(g1[3], l1[3]));
                    *(u32x4*)((bf16*)act + (size_t)(row0 + ai * 128 + m * 16) * 2048 + col0) = w; } }
    }
};
constexpr float YBS = 8.0f;
struct EpiDown {
    static constexpr bool PERM = true;
    uchar* yb; const float* b_down;
    __device__ __forceinline__ void operator()(const f32x4 (&acc)[2][2][4][2], const pg8::Unit& u, int wr, int wc, int fr, int fq) const {
        const int row0 = u.pm * 256 + wr * 64 + fr, col0 = u.pn * 256 + wc * 32 + 8 * fq;
        const float* bb = b_down + (size_t)u.e * 2048 + col0;
        f32x4 bv[2][2];
#pragma unroll
        for (int bj = 0; bj < 2; ++bj)
#pragma unroll
            for (int n = 0; n < 2; ++n) bv[bj][n] = *(const f32x4*)(bb + bj * 128 + 4 * n) * YBS;
#pragma unroll
        for (int ai = 0; ai < 2; ++ai)
#pragma unroll
            for (int m = 0; m < 4; ++m) { uchar* rowp = yb + (size_t)(row0 + ai * 128 + m * 16) * 2048 + col0;
#pragma unroll
                for (int bj = 0; bj < 2; ++bj) { const f32x4 v0 = acc[ai][bj][m][0] * (WSC * YBS) + bv[bj][0], v1 = acc[ai][bj][m][1] * (WSC * YBS) + bv[bj][1];
                    u32x2 w; w.x = cvt4_fp8(v0[0], v0[1], v0[2], v0[3]); w.y = cvt4_fp8(v1[0], v1[1], v1[2], v1[3]);
                    *(u32x2*)(rowp + bj * 128) = w; } }
    }
};

__device__ __forceinline__ int hperm(int p) { return 32 * (p >> 5) + 8 * ((p >> 2) & 3) + 4 * ((p >> 4) & 1) + (p & 3); }
template <int MODE = 0>
__device__ __forceinline__ void tr_item(const float* W, int ldw, int k0, int n0, bf16* dst, int K, LAS float* scr, int lane) {
    const int kq = lane >> 4, n4 = (lane & 15) * 4;
    f32x4 v[16];
#pragma unroll
    for (int i = 0; i < 16; ++i) v[i] = __builtin_nontemporal_load((const f32x4*)(W + (size_t)(k0 + 4 * i + kq) * ldw + n0 + n4));
#pragma unroll
    for (int i = 0; i < 16; ++i) { LAS float* s = scr + (4 * i + kq) * 65 + n4; s[0] = v[i][0]; s[1] = v[i][1]; s[2] = v[i][2]; s[3] = v[i][3]; }
    LDS_WAIT();
    const int c = lane & 7, nn = lane >> 3;
#pragma unroll
    for (int i = 0; i < 8; ++i) { const int n = nn + 8 * i; const LAS float* s = scr + (8 * c) * 65 + n;
        u32x4 o; o.x = cvt_pk_bf16(s[0], s[65]); o.y = cvt_pk_bf16(s[130], s[195]); o.z = cvt_pk_bf16(s[260], s[325]); o.w = cvt_pk_bf16(s[390], s[455]);
        if (MODE == 2) { bf16* p = dst + (size_t)n * K + hperm(8 * c); *(u32x2*)p = (u32x2){o.x, o.y}; *(u32x2*)(p + 8) = (u32x2){o.z, o.w}; }
        else *(u32x4*)(dst + (size_t)(MODE == 1 ? hperm(n) : n) * K + 8 * c) = o; }
    LDS_WAIT();
}
__device__ __forceinline__ void tr_item_fp8(const float* W, int ldw, int k0, int n0, uchar* dst, int K, LAS float* scr, int lane) {
    const int kq = lane >> 4, n4 = (lane & 15) * 4;
    f32x4 v[16];
#pragma unroll
    for (int i = 0; i < 16; ++i) v[i] = __builtin_nontemporal_load((const f32x4*)(W + (size_t)(k0 + 4 * i + kq) * ldw + n0 + n4));
#pragma unroll
    for (int i = 0; i < 16; ++i) { LAS float* s = scr + (4 * i + kq) * 65 + n4; s[0] = v[i][0]; s[1] = v[i][1]; s[2] = v[i][2]; s[3] = v[i][3]; }
    LDS_WAIT();
    const int c = lane & 3, nn = lane >> 2;
#pragma unroll
    for (int i = 0; i < 4; ++i) { const int n = nn + 16 * i; const LAS float* s = scr + (16 * c) * 65 + n;
        u32x4 o; o.x = cvt4_fp8(s[0] * 32.f, s[65] * 32.f, s[130] * 32.f, s[195] * 32.f); o.y = cvt4_fp8(s[260] * 32.f, s[325] * 32.f, s[390] * 32.f, s[455] * 32.f);
        o.z = cvt4_fp8(s[520] * 32.f, s[585] * 32.f, s[650] * 32.f, s[715] * 32.f); o.w = cvt4_fp8(s[780] * 32.f, s[845] * 32.f, s[910] * 32.f, s[975] * 32.f);
        *(u32x4*)(dst + (size_t)n * K + 16 * c) = o; }
    LDS_WAIT();
}
__device__ __forceinline__ void rms_row_bf16(const f32x4 (&v)[8], const f32x4 (&wv)[8], bf16* orow, uchar* orow8, int lane) {
    float s = 0.f;
#pragma unroll
    for (int j = 0; j < 8; ++j) s += (v[j][0] * v[j][0] + v[j][1] * v[j][1]) + (v[j][2] * v[j][2] + v[j][3] * v[j][3]);
    const float rstd = rsqrtf(wave_sum(s) * (1.f / D) + EPS);
#pragma unroll
    for (int j = 0; j < 8; ++j) { const float a0 = v[j][0] * rstd * wv[j][0], a1 = v[j][1] * rstd * wv[j][1], a2 = v[j][2] * rstd * wv[j][2], a3 = v[j][3] * rstd * wv[j][3];
        u32x2 o; o.x = cvt_pk_bf16(a0, a1); o.y = cvt_pk_bf16(a2, a3);
        *(u32x2*)(orow + 4 * (lane + 64 * j)) = o; *(unsigned*)(orow8 + 4 * (lane + 64 * j)) = cvt4_fp8(a0, a1, a2, a3); }
}
template <int PART>
__device__ __forceinline__ void p0_convert(Frame& F, int gw, int NGW) {
    LAS float* scr = (LAS float*)(F.lds + F.wave * 16640);
    constexpr int I_IN = 32 * 257, I_POOL = 4 * 64, I_SSD = 64 * 32, I_OUT = 32 * 32, I_UP = 32 * 32 * 64, I_DOWN = 32 * 32 * 32;
    constexpr int NEARLY = I_IN + I_POOL + I_SSD + I_OUT, NITEMS = NEARLY + I_UP + I_DOWN;
    constexpr int IT0 = PART == 1 ? I_IN : 0, IT1 = PART == 0 ? I_IN : (PART == 3 ? NITEMS : NEARLY);
    for (int it = IT0 + gw; it < IT1; it += NGW) {
        int r = it;
        if (r < I_IN) { const int kb = r / 257, nb = r % 257, n0 = nb * 64; const int r0 = n0 < 12288 ? n0 : (n0 == 12288 ? 16384 : n0 - 64);
            if (n0 >= 2048 && n0 < 6144) tr_item<1>(F.w_in, INCOLS, kb * 64, n0, WSP(bf16, WS_WIN) + (size_t)r0 * 2048 + kb * 64, 2048, scr, F.lane);
            else if (n0 >= 12352) tr_item_fp8(F.w_in, INCOLS, kb * 64, n0, WSP(uchar, WS_WIN8) + (size_t)(n0 - 12352) * 2048 + kb * 64, 2048, scr, F.lane);
            else tr_item(F.w_in, INCOLS, kb * 64, n0, WSP(bf16, WS_WIN) + (size_t)r0 * 2048 + kb * 64, 2048, scr, F.lane);
            continue; } r -= I_IN;
        if (r < I_POOL) { const int g = r >> 6, kb = (r >> 3) & 7, nb = r & 7;
            tr_item(F.w_pool + (size_t)g * 512 * 512, 512, kb * 64, nb * 64, WSP(bf16, WS_WPOOL) + (size_t)(g * 512 + nb * 64) * 512 + kb * 64, 512, scr, F.lane); continue; } r -= I_POOL;
        if (r < I_SSD) { const int kb = r >> 5, nb = r & 31;
            tr_item<2>(F.w_ssd_out, 2048, kb * 64, nb * 64, WSP(bf16, WS_WSSD) + (size_t)(nb * 64) * 4096 + kb * 64, 4096, scr, F.lane); continue; } r -= I_SSD;
        if (r < I_OUT) { const int kb = r >> 5, nb = r & 31;
            tr_item(F.w_out, 2048, kb * 64, nb * 64, WSP(bf16, WS_WOUT) + (size_t)(nb * 64) * 2048 + kb * 64, 2048, scr, F.lane); continue; } r -= I_OUT;
        if (r < I_UP) { const int e = r >> 11, kb = (r >> 6) & 31, nb = r & 63, n0 = nb * 64; const int j = n0 & 2047; const int r0 = 256 * (j >> 7) + (n0 >= 2048 ? 128 : 0) + (j & 127);
            if constexpr (MOE_FP8) tr_item_fp8(F.w_up + (size_t)e * 2048 * 4096, 4096, kb * 64, n0, WSP(uchar, WS_WUP) + ((size_t)e * 4096 + r0) * 2048 + kb * 64, 2048, scr, F.lane);
            else tr_item(F.w_up + (size_t)e * 2048 * 4096, 4096, kb * 64, n0, WSP(bf16, WS_WUP) + ((size_t)e * 4096 + r0) * 2048 + kb * 64, 2048, scr, F.lane);
            continue; } r -= I_UP;
        { const int e = r >> 10, kb = (r >> 5) & 31, nb = r & 31;
            if constexpr (MOE_FP8) tr_item_fp8(F.w_down + (size_t)e * 2048 * 2048, 2048, kb * 64, nb * 64, WSP(uchar, WS_WDOWN) + ((size_t)e * 2048 + nb * 64) * 2048 + kb * 64, 2048, scr, F.lane);
            else tr_item(F.w_down + (size_t)e * 2048 * 2048, 2048, kb * 64, nb * 64, WSP(bf16, WS_WDOWN) + ((size_t)e * 2048 + nb * 64) * 2048 + kb * 64, 2048, scr, F.lane); }
    }
}

struct LateItem { const float* src; uchar* dst; int ldw; };
__device__ __forceinline__ LateItem late_item(Frame& F, int r) {
    constexpr int I_UP = 32 * 32 * 64;
    LateItem L;
    if (r < I_UP) { const int e = r >> 11, kb = (r >> 6) & 31, nb = r & 63, n0 = nb * 64; const int j = n0 & 2047; const int r0 = 256 * (j >> 7) + (n0 >= 2048 ? 128 : 0) + (j & 127);
        L.src = F.w_up + (size_t)e * 2048 * 4096 + (size_t)(kb * 64) * 4096 + n0; L.ldw = 4096; L.dst = WSP(uchar, WS_WUP) + ((size_t)e * 4096 + r0) * 2048 + kb * 64; }
    else { r -= I_UP; const int e = r >> 10, kb = (r >> 5) & 31, nb = r & 31;
        L.src = F.w_down + (size_t)e * 2048 * 2048 + (size_t)(kb * 64) * 2048 + nb * 64; L.ldw = 2048; L.dst = WSP(uchar, WS_WDOWN) + ((size_t)e * 2048 + nb * 64) * 2048 + kb * 64; }
    return L;
}
#define LATE_LOAD(v, L) do { _Pragma("unroll") for (int i = 0; i < 16; ++i) v[i] = __builtin_nontemporal_load((const f32x4*)((L).src + (size_t)(4 * i + (lane >> 4)) * (L).ldw + (lane & 15) * 4)); } while (0)
#define LATE_PROC(v, L) do { _Pragma("unroll") for (int i = 0; i < 16; ++i) { LAS float* s_ = scr + (4 * i + (lane >> 4)) * 65 + (lane & 15) * 4; s_[0] = v[i][0]; s_[1] = v[i][1]; s_[2] = v[i][2]; s_[3] = v[i][3]; } \
        LDS_WAIT(); \
        _Pragma("unroll") for (int i = 0; i < 4; ++i) { const int n_ = (lane >> 2) + 16 * i; const LAS float* s_ = scr + (16 * (lane & 3)) * 65 + n_; \
            u32x4 o_; o_.x = cvt4_fp8(s_[0] * 32.f, s_[65] * 32.f, s_[130] * 32.f, s_[195] * 32.f); o_.y = cvt4_fp8(s_[260] * 32.f, s_[325] * 32.f, s_[390] * 32.f, s_[455] * 32.f); \
            o_.z = cvt4_fp8(s_[520] * 32.f, s_[585] * 32.f, s_[650] * 32.f, s_[715] * 32.f); o_.w = cvt4_fp8(s_[780] * 32.f, s_[845] * 32.f, s_[910] * 32.f, s_[975] * 32.f); \
            __builtin_nontemporal_store(o_, (u32x4*)((L).dst + (size_t)n_ * 2048 + 16 * (lane & 3))); } \
        LDS_WAIT(); } while (0)
__device__ __forceinline__ void p1_convert_late(Frame& F, int gw, int NGW) {
    static_assert(MOE_FP8, "pipelined converter writes e4m3");
    LAS float* scr = (LAS float*)(F.lds + F.wave * 16640);
    const int lane = F.lane;
    constexpr int NLATE = 32 * 32 * 64 + 32 * 32 * 32;
    f32x4 va[16], vb[16];
    int it = gw; LateItem La, Lb;
    if (it < NLATE) { La = late_item(F, it); LATE_LOAD(va, La); }
    while (it < NLATE) {
        const int it2 = it + NGW; if (it2 < NLATE) { Lb = late_item(F, it2); LATE_LOAD(vb, Lb); }
        LATE_PROC(va, La);
        const int it3 = it2 + NGW; if (it3 < NLATE) { La = late_item(F, it3); LATE_LOAD(va, La); }
        if (it2 < NLATE) LATE_PROC(vb, Lb);
        it = it3;
    }
}
#undef LATE_LOAD
#undef LATE_PROC
__device__ __forceinline__ void p0_prologue(Frame& F, bool with_late) {
    const int gw = blockIdx.x * NWAVES + F.wave, NGW = F.G * NWAVES;
    if (with_late) p0_convert<3>(F, gw, NGW); else p0_convert<0>(F, gw, NGW);
    { u32x4* pad = (u32x4*)(WSP(bf16, WS_WIN) + (size_t)INCOLS * 2048); const int n16 = (NPAD - INCOLS) * 2048 * 2 / 16;
      for (int i = blockIdx.x * 512 + F.tid; i < n16; i += F.G * 512) pad[i] = (u32x4){0u, 0u, 0u, 0u}; }
    f32x4 wv[8];
#pragma unroll
    for (int j = 0; j < 8; ++j) wv[j] = *(const f32x4*)(F.norm_mix_w + 4 * (F.lane + 64 * j));
    f32x4 va[8], vb[8];
    for (int m = gw; m < T; m += 2 * NGW) {
#pragma unroll
        for (int j = 0; j < 8; ++j) va[j] = __builtin_nontemporal_load((const f32x4*)(F.x + (size_t)m * D + 4 * (F.lane + 64 * j)));
        const int m2 = m + NGW;
        if (m2 < T) {
#pragma unroll
            for (int j = 0; j < 8; ++j) vb[j] = __builtin_nontemporal_load((const f32x4*)(F.x + (size_t)m2 * D + 4 * (F.lane + 64 * j))); }
        rms_row_bf16(va, wv, WSP(bf16, WS_U) + (size_t)m * D, WSP(uchar, WS_U8) + (size_t)m * D, F.lane);
        if (m2 < T) rms_row_bf16(vb, wv, WSP(bf16, WS_U) + (size_t)m2 * D, WSP(uchar, WS_U8) + (size_t)m2 * D, F.lane);
    }
}

constexpr int LDP = 136;
constexpr int SOFF_DTS = 0, SOFF_ACS = 4096, SOFF_T0 = 8192;
struct Conv2Regs { u32x4 v[2][7]; f32x4 w[2][4][2]; f32x4 bb[2][2]; };
__device__ __forceinline__ void conv2_load(Frame& F, int tbase, int pos0, int chA, int chB, Conv2Regs& R) {
    const int nb = F.tid & 15, r4 = F.tid >> 4;
    const bf16* xbc = WSP(const bf16, WS_XBC);
    const bool ok0 = pos0 + 4 * r4 - 3 >= 0;
#pragma unroll
    for (int t = 0; t < 2; ++t) { const int ch = (t ? chB : chA) + 8 * nb;
#pragma unroll
        for (int q = 0; q < 7; ++q) { const int rr = 4 * r4 - 3 + q; R.v[t][q] = *(const u32x4*)(xbc + (size_t)(tbase + ((q >= 3 || ok0) ? rr : 0)) * XBCW + ch); }
#pragma unroll
        for (int k = 0; k < 4; ++k) { R.w[t][k][0] = *(const f32x4*)(F.conv_w + (size_t)k * XBCW + ch); R.w[t][k][1] = *(const f32x4*)(F.conv_w + (size_t)k * XBCW + ch + 4); }
        R.bb[t][0] = *(const f32x4*)(F.conv_b + ch); R.bb[t][1] = *(const f32x4*)(F.conv_b + ch + 4); }
}
__device__ __forceinline__ void conv2_store(Frame& F, int pos0, Conv2Regs& R, LAS bf16* dstA, LAS bf16* dstB) {
    const int nb = F.tid & 15, r4 = F.tid >> 4;
#pragma unroll
    for (int t = 0; t < 2; ++t) {
#pragma unroll
        for (int q = 0; q < 3; ++q) { const bool ok = pos0 + 4 * r4 - 3 + q >= 0; R.v[t][q].x = ok ? R.v[t][q].x : 0u; R.v[t][q].y = ok ? R.v[t][q].y : 0u; R.v[t][q].z = ok ? R.v[t][q].z : 0u; R.v[t][q].w = ok ? R.v[t][q].w : 0u; }
        LAS bf16* dst = t ? dstB : dstA;
#pragma unroll
        for (int i = 0; i < 4; ++i) {
            f32x4 a0 = R.bb[t][0], a1 = R.bb[t][1];
#pragma unroll
            for (int k = 0; k < 4; ++k) { const u32x4 x = R.v[t][i + k];
                a0[0] += R.w[t][k][0][0] * bflo(x.x); a0[1] += R.w[t][k][0][1] * bfhi(x.x); a0[2] += R.w[t][k][0][2] * bflo(x.y); a0[3] += R.w[t][k][0][3] * bfhi(x.y);
                a1[0] += R.w[t][k][1][0] * bflo(x.z); a1[1] += R.w[t][k][1][1] * bfhi(x.z); a1[2] += R.w[t][k][1][2] * bflo(x.w); a1[3] += R.w[t][k][1][3] * bfhi(x.w); }
            u32x4 o; o.x = cvt_pk_bf16(siluf_(a0[0]), siluf_(a0[1])); o.y = cvt_pk_bf16(siluf_(a0[2]), siluf_(a0[3])); o.z = cvt_pk_bf16(siluf_(a1[0]), siluf_(a1[1])); o.w = cvt_pk_bf16(siluf_(a1[2]), siluf_(a1[3]));
            *(LAS u32x4*)(dst + (4 * r4 + i) * LDP + 8 * nb) = o;
        }
    }
}
__device__ __forceinline__ void dt2_load(Frame& F, int tbase, int g, float (&raw)[4]) {
    const int h = 8 * g + F.wave; const float* dtp = WSP(const float, WS_DT);
    raw[0] = dtp[(size_t)(tbase + F.lane) * 64 + h]; raw[1] = dtp[(size_t)(tbase + F.lane + 64) * 64 + h]; raw[2] = F.dt_bias[h]; raw[3] = F.a_log[h];
}
__device__ __forceinline__ void dt2_store(Frame& F, const float (&raw)[4]) {
    LAS float* dts = (LAS float*)(F.lds + SOFF_DTS); LAS float* acs = (LAS float*)(F.lds + SOFF_ACS);
    const int j = F.wave, lane = F.lane; const float bias = raw[2], a = -__expf(raw[3]);
    float carry = 0.f;
#pragma unroll
    for (int half = 0; half < 2; ++half) {
        const int s = lane + 64 * half; const float r = raw[half] + bias;
        const float dtv = r > 20.f ? r : log1pf(__expf(r));
        float v = dtv * a;
#pragma unroll
        for (int o = 1; o < 64; o <<= 1) { const float u = __shfl_up(v, o); if (lane >= o) v += u; }
        v += carry; carry = __shfl(v, 63);
        dts[j * 128 + s] = dtv; acs[j * 128 + s] = v;
    }
}
__device__ __forceinline__ void cpair_load_s(Frame& F, int tbase, int pos0, int chg, int sb, unsigned (&u)[11]) {
    const bf16* xbc = WSP(const bf16, WS_XBC);
    const bool ok0 = pos0 + 8 * sb - 3 >= 0;
#pragma unroll
    for (int q = 0; q < 11; ++q) { const int rr = 8 * sb - 3 + q; u[q] = *(const unsigned*)(xbc + (size_t)(tbase + ((q >= 3 || ok0) ? rr : 0)) * XBCW + chg); }
}
__device__ __forceinline__ void cpair_fix(int pos0, int sb, unsigned (&u)[11]) {
#pragma unroll
    for (int q = 0; q < 3; ++q) u[q] = (pos0 + 8 * sb - 3 + q >= 0) ? u[q] : 0u;
}
__device__ __forceinline__ void cpair_loadw(Frame& F, int chg, f32x2 (&xw)[5]) {
#pragma unroll
    for (int k = 0; k < 4; ++k) xw[k] = *(const f32x2*)(F.conv_w + (size_t)k * XBCW + chg);
    xw[4] = *(const f32x2*)(F.conv_b + chg);
}
template <int MODE>
__device__ __forceinline__ void cpair_store_w(int chl, int sb, LAS bf16* dst, const unsigned (&u)[11], const f32x2 (&xw)[5], const LAS float* dts, const LAS float* acs, float aend) {
    float o0[8], o1[8];
#pragma unroll
    for (int i = 0; i < 8; ++i) { float a0 = xw[4][0], a1 = xw[4][1];
#pragma unroll
        for (int k = 0; k < 4; ++k) { a0 += xw[k][0] * bflo(u[i + k]); a1 += xw[k][1] * bfhi(u[i + k]); }
        float sc = 1.f;
        if (MODE >= 1) { const int s = 8 * sb + i; sc = dts[s]; if (MODE == 2) sc *= __expf(aend - acs[s]); }
        o0[i] = siluf_(a0) * sc; o1[i] = siluf_(a1) * sc; }
    u32x4 p0, p1; p0.x = cvt_pk_bf16(o0[0], o0[1]); p0.y = cvt_pk_bf16(o0[2], o0[3]); p0.z = cvt_pk_bf16(o0[4], o0[5]); p0.w = cvt_pk_bf16(o0[6], o0[7]);
    p1.x = cvt_pk_bf16(o1[0], o1[1]); p1.y = cvt_pk_bf16(o1[2], o1[3]); p1.z = cvt_pk_bf16(o1[4], o1[5]); p1.w = cvt_pk_bf16(o1[6], o1[7]);
    *(LAS u32x4*)(dst + chl * LDP + 8 * sb) = p0; *(LAS u32x4*)(dst + (chl + 1) * LDP + 8 * sb) = p1;
}
struct ConvT2Regs { unsigned u[2][11]; f32x2 w[5]; };
__device__ __forceinline__ void convT2_load(Frame& F, int tbase, int pos0, int chg, ConvT2Regs& R) {
    const bf16* xbc = WSP(const bf16, WS_XBC);
#pragma unroll
    for (int it = 0; it < 2; ++it) { const int sb = (F.tid >> 6) + 8 * it; const bool ok0 = pos0 + 8 * sb - 3 >= 0;
#pragma unroll
        for (int q = 0; q < 11; ++q) { const int rr = 8 * sb - 3 + q; R.u[it][q] = *(const unsigned*)(xbc + (size_t)(tbase + ((q >= 3 || ok0) ? rr : 0)) * XBCW + chg); } }
#pragma unroll
    for (int k = 0; k < 4; ++k) R.w[k] = *(const f32x2*)(F.conv_w + (size_t)k * XBCW + chg);
    R.w[4] = *(const f32x2*)(F.conv_b + chg);
}
__device__ __forceinline__ void convT2_store(Frame& F, int pos0, int chl, ConvT2Regs& R, LAS bf16* dst) {
#pragma unroll
    for (int it = 0; it < 2; ++it) { const int sb = (F.tid >> 6) + 8 * it;
#pragma unroll
        for (int q = 0; q < 3; ++q) R.u[it][q] = (pos0 + 8 * sb - 3 + q >= 0) ? R.u[it][q] : 0u;
        float o0[8], o1[8];
#pragma unroll
        for (int i = 0; i < 8; ++i) { float a0 = R.w[4][0], a1 = R.w[4][1];
#pragma unroll
            for (int k = 0; k < 4; ++k) { a0 += R.w[k][0] * bflo(R.u[it][i + k]); a1 += R.w[k][1] * bfhi(R.u[it][i + k]); }
            o0[i] = siluf_(a0); o1[i] = siluf_(a1); }
        u32x4 p0, p1; p0.x = cvt_pk_bf16(o0[0], o0[1]); p0.y = cvt_pk_bf16(o0[2], o0[3]); p0.z = cvt_pk_bf16(o0[4], o0[5]); p0.w = cvt_pk_bf16(o0[6], o0[7]);
        p1.x = cvt_pk_bf16(o1[0], o1[1]); p1.y = cvt_pk_bf16(o1[2], o1[3]); p1.z = cvt_pk_bf16(o1[4], o1[5]); p1.w = cvt_pk_bf16(o1[6], o1[7]);
        *(LAS u32x4*)(dst + chl * LDP + 8 * sb) = p0; *(LAS u32x4*)(dst + (chl + 1) * LDP + 8 * sb) = p1; }
}
__device__ __forceinline__ void p2_states_unit(Frame& F, int unit) {
    const int g = unit & 7, c = (unit >> 3) & 63, b = unit >> 9;
    const int tbase = b * SEQ + c * 128, pos0 = c * 128;
    LAS float* dts = (LAS float*)(F.lds + SOFF_DTS); LAS float* acs = (LAS float*)(F.lds + SOFF_ACS);
    LAS bf16* BMT = (LAS bf16*)(F.lds + SOFF_T0);
    LAS bf16* XT0 = BMT + 128 * LDP; LAS bf16* XT1 = XT0 + 64 * LDP;
    const int lane = F.lane, w = F.wave, c16 = lane & 15, q = lane >> 4;
    const int pp = F.tid & 31, sbx = F.tid >> 5;
    unsigned xu[11]; f32x2 xw[5];
    cpair_load_s(F, tbase, pos0, 512 * g + 2 * pp, sbx, xu); cpair_loadw(F, 512 * g + 2 * pp, xw);
    float dtraw[4]; dt2_load(F, tbase, g, dtraw);
    ConvT2Regs cr; convT2_load(F, tbase, pos0, 4096 + 128 * g + 2 * (F.tid & 63), cr);
    __syncthreads();
    dt2_store(F, dtraw);
    convT2_store(F, pos0, 2 * (F.tid & 63), cr, BMT);
    __syncthreads();
    cpair_fix(pos0, sbx, xu); cpair_store_w<2>(2 * pp, sbx, XT0, xu, xw, dts, acs, acs[127]);
    bf16x8 bmf[4];
#pragma unroll
    for (int kk = 0; kk < 4; ++kk) bmf[kk] = *(const LAS bf16x8*)(BMT + (16 * w + c16) * LDP + 32 * kk + 8 * q);
    __syncthreads();
    bf16* states = WSP(bf16, WS_STATES);
    for (int j = 0; j < 8; ++j) {
        LAS bf16* XT = (j & 1) ? XT1 : XT0;
        const float aend = acs[j * 128 + 127];
        if (j < 7) { cpair_load_s(F, tbase, pos0, 512 * g + 64 * (j + 1) + 2 * pp, sbx, xu); cpair_loadw(F, 512 * g + 64 * (j + 1) + 2 * pp, xw); }
        f32x4 acc[4];
#pragma unroll
        for (int pt = 0; pt < 4; ++pt) acc[pt] = (f32x4){0.f, 0.f, 0.f, 0.f};
        { bf16x8 xa[2][4];
#pragma unroll
          for (int pt = 0; pt < 4; ++pt) xa[0][pt] = *(const LAS bf16x8*)(XT + (16 * pt + c16) * LDP + 8 * q);
#pragma unroll
          for (int kk = 0; kk < 4; ++kk) {
              if (kk < 3) {
#pragma unroll
                  for (int pt = 0; pt < 4; ++pt) xa[(kk + 1) & 1][pt] = *(const LAS bf16x8*)(XT + (16 * pt + c16) * LDP + 32 * (kk + 1) + 8 * q); }
              __builtin_amdgcn_sched_barrier(0);
#pragma unroll
              for (int pt = 0; pt < 4; ++pt) acc[pt] = __builtin_amdgcn_mfma_f32_16x16x32_bf16(bmf[kk], xa[kk & 1][pt], acc[pt], 0, 0, 0);
              __builtin_amdgcn_sched_barrier(0); } }
        const int h = 8 * g + j;
#pragma unroll
        for (int pt = 0; pt < 4; ++pt) { u32x2 o; o.x = cvt_pk_bf16(acc[pt][0], acc[pt][1]); o.y = cvt_pk_bf16(acc[pt][2], acc[pt][3]);
            *(u32x2*)(states + ((((size_t)(b * 64 + c) * 64 + h) * 64 + 16 * pt + c16) * 128 + 16 * w + 4 * q)) = o; }
        if (w == j && lane == 0) WSP(float, WS_CDEC)[(b * 64 + c) * 64 + h] = __expf(aend);
        if (j < 7) { cpair_fix(pos0, sbx, xu); cpair_store_w<2>(2 * pp, sbx, (j & 1) ? XT0 : XT1, xu, xw, dts + (j + 1) * 128, acs + (j + 1) * 128, acs[(j + 1) * 128 + 127]); }
        __syncthreads();
    }
}
template <int W>
__device__ __forceinline__ void pool_item(const bf16* xp, bf16* pooled, int cg, int g, int t0, int p0) {
    u32x4 rows[15 + W];
#pragma unroll
    for (int i = 0; i < 15 + W; ++i) { rows[i] = (u32x4){0u, 0u, 0u, 0u}; const int dq = i - (W - 1); if (p0 + dq >= 0) rows[i] = *(const u32x4*)(xp + (size_t)(t0 + dq) * 2048 + 8 * cg); }
    float S[8];
#pragma unroll
    for (int e = 0; e < 8; ++e) S[e] = 0.f;
#pragma unroll
    for (int i = 0; i < W - 1; ++i) { const u32x4 v = rows[i];
        S[0] += bflo(v.x); S[1] += bfhi(v.x); S[2] += bflo(v.y); S[3] += bfhi(v.y); S[4] += bflo(v.z); S[5] += bfhi(v.z); S[6] += bflo(v.w); S[7] += bfhi(v.w); }
#pragma unroll
    for (int i = 0; i < 16; ++i) {
        const int t = t0 + i, p = p0 + i;
        const u32x4 v = rows[W - 1 + i];
        float xv[8] = {bflo(v.x), bfhi(v.x), bflo(v.y), bfhi(v.y), bflo(v.z), bfhi(v.z), bflo(v.w), bfhi(v.w)};
        const float inv = 1.0f / (float)((p + 1) < W ? (p + 1) : W);
        float o[8];
#pragma unroll
        for (int e = 0; e < 8; ++e) { S[e] += xv[e]; o[e] = S[e] * inv - xv[e]; }
        u32x4 ov; ov.x = cvt_pk_bf16(o[0], o[1]); ov.y = cvt_pk_bf16(o[2], o[3]); ov.z = cvt_pk_bf16(o[4], o[5]); ov.w = cvt_pk_bf16(o[6], o[7]);
        *(u32x4*)(pooled + ((size_t)g * T + t) * 512 + (8 * cg & 511)) = ov;
        const u32x4 u = rows[i];
        S[0] -= bflo(u.x); S[1] -= bfhi(u.x); S[2] -= bflo(u.y); S[3] -= bfhi(u.y); S[4] -= bflo(u.z); S[5] -= bfhi(u.z); S[6] -= bflo(u.w); S[7] -= bfhi(u.w);
    }
}
__device__ __forceinline__ void p2_pool_items(Frame& F) {
    const bf16* xp = WSP(const bf16, WS_XP); bf16* pooled = WSP(bf16, WS_POOLED);
    for (int idx = blockIdx.x * 512 + F.tid; idx < (T / 16) * 256; idx += F.G * 512) {
        const int cg = idx & 255, rb = idx >> 8;
        const int g = __builtin_amdgcn_readfirstlane(cg >> 6);
        const int t0 = rb * 16, p0 = t0 & (SEQ - 1);
        if (g == 0) pool_item<2>(xp, pooled, cg, g, t0, p0); else if (g == 1) pool_item<4>(xp, pooled, cg, g, t0, p0);
        else if (g == 2) pool_item<8>(xp, pooled, cg, g, t0, p0); else pool_item<16>(xp, pooled, cg, g, t0, p0);
    }
}

__device__ __forceinline__ void p3_scan(Frame& F) {
    bf16* states = WSP(bf16, WS_STATES); const float* cdec = WSP(const float, WS_CDEC);
    for (int idx = blockIdx.x * 512 + F.tid; idx < 2 * 64 * 64 * 16; idx += F.G * 512) {
        const int n8 = idx & 15, p = (idx >> 4) & 63, h = (idx >> 10) & 63, b = idx >> 16;
        float run[8];
#pragma unroll
        for (int e = 0; e < 8; ++e) run[e] = 0.f;
        for (int c0 = 0; c0 < 64; c0 += 8) {
            u32x4 v[8]; float dec[8];
#pragma unroll
            for (int cc = 0; cc < 8; ++cc) { const int c = c0 + cc; v[cc] = *(const u32x4*)(states + ((((size_t)(b * 64 + c) * 64 + h) * 64 + p) * 128 + 8 * n8)); dec[cc] = cdec[(b * 64 + c) * 64 + h]; }
#pragma unroll
            for (int cc = 0; cc < 8; ++cc) { const int c = c0 + cc;
                u32x4 o; o.x = cvt_pk_bf16(run[0], run[1]); o.y = cvt_pk_bf16(run[2], run[3]); o.z = cvt_pk_bf16(run[4], run[5]); o.w = cvt_pk_bf16(run[6], run[7]);
                *(u32x4*)(states + ((((size_t)(b * 64 + c) * 64 + h) * 64 + p) * 128 + 8 * n8)) = o;
                const float d = dec[cc];
                run[0] = run[0] * d + bflo(v[cc].x); run[1] = run[1] * d + bfhi(v[cc].x); run[2] = run[2] * d + bflo(v[cc].y); run[3] = run[3] * d + bfhi(v[cc].y);
                run[4] = run[4] * d + bflo(v[cc].z); run[5] = run[5] * d + bfhi(v[cc].z); run[6] = run[6] * d + bflo(v[cc].w); run[7] = run[7] * d + bfhi(v[cc].w); }
        }
    }
}

__device__ __forceinline__ void p4_unit(Frame& F, int unit) {
    const int g = unit & 7, c = (unit >> 3) & 63, b = unit >> 9;
    const int tbase = b * SEQ + c * 128, pos0 = c * 128;
    LAS float* dts = (LAS float*)(F.lds + SOFF_DTS); LAS float* acs = (LAS float*)(F.lds + SOFF_ACS);
    LAS bf16* CMs = (LAS bf16*)(F.lds + SOFF_T0);
    LAS bf16* BMs = CMs + 128 * LDP;
    LAS bf16* XT0 = BMs + 128 * LDP; LAS bf16* PV0 = XT0 + 64 * LDP;
    LAS bf16* XT1 = BMs; LAS bf16* PV1 = BMs + 64 * LDP;
    const int lane = F.lane, w = F.wave, c16 = lane & 15, q = lane >> 4;
    const int l = 16 * w + c16;
    const int pp = F.tid & 31, sbx = F.tid >> 5;
    const bf16* zb = WSP(const bf16, WS_Z); const bf16* states = WSP(const bf16, WS_STATES);
    bf16* yg = WSP(bf16, WS_YG);
    LAS u32x4* parkA = (LAS u32x4*)(F.lds + SOFF_T0) + F.tid; LAS u32x4* parkB = (LAS u32x4*)(F.lds + SOFF_T0 + 384 * LDP * 2) + F.tid;
    unsigned xu[11]; u32x4 pvr[2]; f32x2 xw[5];
    const float dskall = F.d_skip[8 * g + (lane & 7)];
    cpair_load_s(F, tbase, pos0, 512 * g + 2 * pp, sbx, xu); cpair_loadw(F, 512 * g + 2 * pp, xw);
    { const bf16* src = states + (((size_t)(b * 64 + c) * 64 + 8 * g) * 64) * 128;
#pragma unroll
      for (int it = 0; it < 2; ++it) { const int i16 = F.tid + 512 * it; pvr[it] = *(const u32x4*)(src + (i16 >> 4) * 128 + 8 * (i16 & 15)); } }
    float dtraw[4]; dt2_load(F, tbase, g, dtraw);
    Conv2Regs cr; conv2_load(F, tbase, pos0, 4096 + 1024 + 128 * g, 4096 + 128 * g, cr);
    __syncthreads();
    dt2_store(F, dtraw);
    conv2_store(F, pos0, cr, CMs, BMs);
    __syncthreads();
    bf16x8 cmf[4];
#pragma unroll
    for (int kn = 0; kn < 4; ++kn) cmf[kn] = *(const LAS bf16x8*)(CMs + l * LDP + 32 * kn + 8 * q);
    f32x4 cb[8];
#pragma unroll
    for (int st = 0; st < 8; ++st) { cb[st] = (f32x4){0.f, 0.f, 0.f, 0.f};
        if (st <= w) {
            bf16x8 ba[4];
#pragma unroll
            for (int kn = 0; kn < 4; ++kn) ba[kn] = *(const LAS bf16x8*)(BMs + (16 * st + c16) * LDP + 32 * kn + 8 * q);
            __builtin_amdgcn_sched_barrier(0);
#pragma unroll
            for (int kn = 0; kn < 4; ++kn) cb[st] = __builtin_amdgcn_mfma_f32_16x16x32_bf16(ba[kn], cmf[kn], cb[st], 0, 0, 0); } }
    cpair_fix(pos0, sbx, xu); cpair_store_w<1>(2 * pp, sbx, XT0, xu, xw, dts, acs, 0.f);
#pragma unroll
    for (int it = 0; it < 2; ++it) { const int i16 = F.tid + 512 * it; *(LAS u32x4*)(PV0 + (i16 >> 4) * LDP + 8 * (i16 & 15)) = pvr[it]; }
    __syncthreads();
    float ssq = 0.f;
    for (int j = 0; j < 8; ++j) {
        LAS bf16* XT = (j & 1) ? XT1 : XT0; LAS bf16* PV = (j & 1) ? PV1 : PV0;
        const int h = 8 * g + j;
        u32x4 zq[2];
#pragma unroll
        for (int i = 0; i < 2; ++i) zq[i] = *(const u32x4*)(zb + (size_t)(tbase + l) * ZI + 512 * g + 64 * j + 32 * i + 8 * q);
        const float al = acs[j * 128 + l], dtl = dts[j * 128 + l], dsk = __builtin_bit_cast(float, __builtin_amdgcn_readlane(__builtin_bit_cast(int, dskall), j)) / dtl;
        f32x4 ad[4], ao[4];
#pragma unroll
        for (int pt = 0; pt < 4; ++pt) { ad[pt] = (f32x4){0.f, 0.f, 0.f, 0.f}; ao[pt] = (f32x4){0.f, 0.f, 0.f, 0.f}; }
#pragma unroll
        for (int kk = 0; kk < 4; ++kk) {
            if (32 * kk <= 16 * w + 15) {
                const f32x4 as0 = *(const LAS f32x4*)(acs + j * 128 + 32 * kk + 4 * q), as1 = *(const LAS f32x4*)(acs + j * 128 + 32 * kk + 16 + 4 * q);
                u32x2 xlo[4], xhi[4];
#pragma unroll
                for (int pt = 0; pt < 4; ++pt) { xlo[pt] = *(const LAS u32x2*)(XT + (16 * pt + c16) * LDP + 32 * kk + 4 * q); xhi[pt] = *(const LAS u32x2*)(XT + (16 * pt + c16) * LDP + 32 * kk + 16 + 4 * q); }
                __builtin_amdgcn_sched_barrier(0);
                float mv[8];
                if (32 * kk + 31 <= 16 * w) {
#pragma unroll
                    for (int i = 0; i < 4; ++i) { mv[i] = cb[2 * kk][i] * __expf(al - as0[i]); mv[4 + i] = cb[2 * kk + 1][i] * __expf(al - as1[i]); }
                } else {
#pragma unroll
                    for (int i = 0; i < 4; ++i) { const int s0 = 32 * kk + 4 * q + i, s1 = s0 + 16;
                        float v0 = cb[2 * kk][i] * __expf(fminf(al - as0[i], 0.f)), v1 = cb[2 * kk + 1][i] * __expf(fminf(al - as1[i], 0.f));
                        v0 = (s0 <= l) ? v0 : 0.f; v1 = (s1 <= l) ? v1 : 0.f; if (s0 == l) v0 += dsk; if (s1 == l) v1 += dsk; mv[i] = v0; mv[4 + i] = v1; }
                }
                u32x4 bw; bw.x = cvt_pk_bf16_v(mv[0], mv[1]); bw.y = cvt_pk_bf16_v(mv[2], mv[3]); bw.z = cvt_pk_bf16_v(mv[4], mv[5]); bw.w = cvt_pk_bf16_v(mv[6], mv[7]);
                const bf16x8 bfrag = __builtin_bit_cast(bf16x8, bw);
#pragma unroll
                for (int pt = 0; pt < 4; ++pt) { const u32x2 lo = xlo[pt], hi = xhi[pt];
                    u32x4 aw; aw.x = lo.x; aw.y = lo.y; aw.z = hi.x; aw.w = hi.y;
                    ad[pt] = __builtin_amdgcn_mfma_f32_16x16x32_bf16(__builtin_bit_cast(bf16x8, aw), bfrag, ad[pt], 0, 0, 0); }
            }
        }
        if (j < 7) { cpair_load_s(F, tbase, pos0, 512 * g + 64 * (j + 1) + 2 * pp, sbx, xu); cpair_loadw(F, 512 * g + 64 * (j + 1) + 2 * pp, xw);
            const bf16* src = states + (((size_t)(b * 64 + c) * 64 + h + 1) * 64) * 128;
#pragma unroll
            for (int it = 0; it < 2; ++it) { const int i16 = F.tid + 512 * it; pvr[it] = *(const u32x4*)(src + (i16 >> 4) * 128 + 8 * (i16 & 15)); } }
        { bf16x8 pa[2][4];
#pragma unroll
          for (int pt = 0; pt < 4; ++pt) pa[0][pt] = *(const LAS bf16x8*)(PV + (16 * pt + c16) * LDP + 8 * q);
#pragma unroll
          for (int kn = 0; kn < 4; ++kn) {
              if (kn < 3) {
#pragma unroll
                  for (int pt = 0; pt < 4; ++pt) pa[(kn + 1) & 1][pt] = *(const LAS bf16x8*)(PV + (16 * pt + c16) * LDP + 32 * (kn + 1) + 8 * q); }
              __builtin_amdgcn_sched_barrier(0);
#pragma unroll
              for (int pt = 0; pt < 4; ++pt) ao[pt] = __builtin_amdgcn_mfma_f32_16x16x32_bf16(pa[kn & 1][pt], cmf[kn], ao[pt], 0, 0, 0);
              __builtin_amdgcn_sched_barrier(0); } }
        const float eal = __expf(al);
#pragma unroll
        for (int i = 0; i < 2; ++i) { u32x4 oq;
#pragma unroll
            for (int hh = 0; hh < 2; ++hh) { const int pt = 2 * i + hh; const unsigned z01 = hh ? zq[i].z : zq[i].x, z23 = hh ? zq[i].w : zq[i].y;
                const float y0 = (ad[pt][0] + eal * ao[pt][0]) * siluf_(bflo(z01)), y1 = (ad[pt][1] + eal * ao[pt][1]) * siluf_(bfhi(z01));
                const float y2 = (ad[pt][2] + eal * ao[pt][2]) * siluf_(bflo(z23)), y3 = (ad[pt][3] + eal * ao[pt][3]) * siluf_(bfhi(z23));
                ssq += (y0 * y0 + y1 * y1) + (y2 * y2 + y3 * y3);
                if (hh) { oq.z = cvt_pk_bf16(y0, y1); oq.w = cvt_pk_bf16(y2, y3); } else { oq.x = cvt_pk_bf16(y0, y1); oq.y = cvt_pk_bf16(y2, y3); } }
            if (j < 4) ((j < 2) ? parkA : parkB)[((j & 1) * 2 + i) * 512] = oq;
            else *(u32x4*)(yg + (size_t)(tbase + l) * ZI + 512 * g + 64 * j + 32 * i + 8 * q) = oq; }

        if (j < 7) { cpair_fix(pos0, sbx, xu); cpair_store_w<1>(2 * pp, sbx, (j & 1) ? XT0 : XT1, xu, xw, dts + (j + 1) * 128, acs + (j + 1) * 128, 0.f);
            LAS bf16* PVn = (j & 1) ? PV0 : PV1;
#pragma unroll
            for (int it = 0; it < 2; ++it) { const int i16 = F.tid + 512 * it; *(LAS u32x4*)(PVn + (i16 >> 4) * LDP + 8 * (i16 & 15)) = pvr[it]; } }
        __syncthreads();
    }
    ssq += __shfl_xor(ssq, 16); ssq += __shfl_xor(ssq, 32);
    const float rstd = rsqrtf(ssq * (1.f / 512.f) + EPS);
#define Y_RESCALE(J0, LOADV) do { u32x4 v[8]; f32x4 nw[16]; \
        _Pragma("unroll") for (int i = 0; i < 8; ++i) { const int ch = 512 * g + 64 * ((J0) + (i >> 1)) + 32 * (i & 1); nw[2 * i] = *(const f32x4*)(F.ssd_norm_w + ch + 4 * q); nw[2 * i + 1] = *(const f32x4*)(F.ssd_norm_w + ch + 16 + 4 * q); v[i] = LOADV; } \
        _Pragma("unroll") for (int i = 0; i < 8; ++i) { const int ch = 512 * g + 64 * ((J0) + (i >> 1)) + 32 * (i & 1); u32x4 o; \
            o.x = cvt_pk_bf16(bflo(v[i].x) * rstd * nw[2 * i][0], bfhi(v[i].x) * rstd * nw[2 * i][1]); o.y = cvt_pk_bf16(bflo(v[i].y) * rstd * nw[2 * i][2], bfhi(v[i].y) * rstd * nw[2 * i][3]); \
            o.z = cvt_pk_bf16(bflo(v[i].z) * rstd * nw[2 * i + 1][0], bfhi(v[i].z) * rstd * nw[2 * i + 1][1]); o.w = cvt_pk_bf16(bflo(v[i].w) * rstd * nw[2 * i + 1][2], bfhi(v[i].w) * rstd * nw[2 * i + 1][3]); \
            *(u32x4*)(yg + (size_t)(tbase + l) * ZI + ch + 8 * q) = o; } } while (0)
    Y_RESCALE(0, (((i < 4) ? parkA : parkB)[(((i >> 1) & 1) * 2 + (i & 1)) * 512]));
    asm volatile("s_waitcnt vmcnt(0)" ::: "memory");
    Y_RESCALE(4, (*(const u32x4*)(yg + (size_t)(tbase + l) * ZI + ch + 8 * q)));
#undef Y_RESCALE
}


constexpr int UTP = 2050;
__device__ __forceinline__ void p7_router(Frame& F) {
    LAS float* UT = (LAS float*)F.lds;
    const int lane = F.lane, w = F.wave, c16 = lane & 15, q = lane >> 4;
    float rwa[16][2], rwb[16][2];
    const float* rwp = F.router_w + (size_t)(256 * w + q) * NEXP + c16;
#define P7_LOADRW(buf, sc) do { const float* rp_ = rwp + (sc) * 2048; asm volatile("" : "+v"(rp_));   \
        const GAS float* rg_ = (const GAS float*)rp_;                       \
        _Pragma("unroll") for (int st = 0; st < 16; ++st) _Pragma("unroll") for (int nt = 0; nt < 2; ++nt) buf[st][nt] = rg_[st * 128 + 16 * nt]; } while (0)
#define P7_MMA(buf, sc) do { float av_[16]; _Pragma("unroll") for (int st = 0; st < 16; ++st) av_[st] = UT[c16 * UTP + 256 * w + 64 * (sc) + 4 * st + q];     \
        __builtin_amdgcn_sched_barrier(0); \
        _Pragma("unroll") for (int st = 0; st < 16; ++st) { acc[0] = __builtin_amdgcn_mfma_f32_16x16x4f32(av_[st], buf[st][0], acc[0], 0, 0, 0); acc[1] = __builtin_amdgcn_mfma_f32_16x16x4f32(av_[st], buf[st][1], acc[1], 0, 0, 0); } } while (0)
    const bf16* h1 = WSP(const bf16, WS_H1); uchar* u2 = WSP(uchar, WS_U);
    f32x4 wvn[8];
#pragma unroll
    for (int j = 0; j < 8; ++j) wvn[j] = *(const f32x4*)(F.norm_ffn_w + 4 * (lane + 64 * j));
    for (int grp = blockIdx.x; grp < T / 16; grp += F.G) {
        __syncthreads();
        P7_LOADRW(rwa, 0); asm volatile("" ::: "memory");
#pragma unroll
        for (int tt = 0; tt < 2; ++tt) { const int tl = 2 * w + tt, tok = grp * 16 + tl; const bf16* xr = h1 + (size_t)tok * D;
            f32x4 v[8]; float s = 0.f;
#pragma unroll
            for (int j = 0; j < 8; ++j) { const u32x2 hq = *(const u32x2*)(xr + 4 * (lane + 64 * j)); v[j] = (f32x4){bflo(hq.x), bfhi(hq.x), bflo(hq.y), bfhi(hq.y)}; s += (v[j][0] * v[j][0] + v[j][1] * v[j][1]) + (v[j][2] * v[j][2] + v[j][3] * v[j][3]); }
            const float rstd = rsqrtf(wave_sum(s) * (1.f / D) + EPS);
#pragma unroll
            for (int j = 0; j < 8; ++j) { const int col = 4 * (lane + 64 * j); const f32x4 wv = wvn[j];
                const float a0 = v[j][0] * rstd * wv[0], a1 = v[j][1] * rstd * wv[1], a2 = v[j][2] * rstd * wv[2], a3 = v[j][3] * rstd * wv[3];
                if constexpr (MOE_FP8) *(unsigned*)(u2 + (size_t)tok * D + col) = cvt4_fp8(a0, a1, a2, a3);
                else { u32x2 o; o.x = cvt_pk_bf16(a0, a1); o.y = cvt_pk_bf16(a2, a3); *(u32x2*)((bf16*)u2 + (size_t)tok * D + col) = o; }
                LAS float* d = UT + tl * UTP + col; *(LAS f32x2*)d = (f32x2){a0, a1}; *(LAS f32x2*)(d + 2) = (f32x2){a2, a3}; } }
        __syncthreads();
        f32x4 acc[2] = {(f32x4){0.f, 0.f, 0.f, 0.f}, (f32x4){0.f, 0.f, 0.f, 0.f}};
#define P7_FENCE asm volatile("" ::: "memory")
        P7_FENCE; P7_LOADRW(rwb, 1); P7_FENCE; P7_MMA(rwa, 0); P7_FENCE; P7_LOADRW(rwa, 2); P7_FENCE; P7_MMA(rwb, 1); P7_FENCE; P7_LOADRW(rwb, 3); P7_FENCE; P7_MMA(rwa, 2); P7_FENCE; P7_MMA(rwb, 3);
#undef P7_FENCE
        __syncthreads();
        LAS float* PL = UT;
#pragma unroll
        for (int nt = 0; nt < 2; ++nt)
#pragma unroll
            for (int r = 0; r < 4; ++r) PL[(w * 16 + 4 * q + r) * 32 + 16 * nt + c16] = acc[nt][r];
        __syncthreads();
        { const int tl = F.tid >> 5, e = F.tid & 31, tok = grp * 16 + tl;
          float lg = F.router_b[e];
#pragma unroll
          for (int ww = 0; ww < 8; ++ww) lg += PL[(ww * 16 + tl) * 32 + e];
          bool taken = false; float tv[4]; int ti[4];
#pragma unroll
          for (int k = 0; k < 4; ++k) { float cv = taken ? -3.0e38f : lg; int ci = e;
#pragma unroll
              for (int o = 16; o >= 1; o >>= 1) { const float ov = __shfl_xor(cv, o); const int oi = __shfl_xor(ci, o); const bool better = (ov > cv) || (ov == cv && oi < ci); cv = better ? ov : cv; ci = better ? oi : ci; }
              tv[k] = cv; ti[k] = ci; if (e == ci) taken = true; }
          const float e1 = __expf(tv[1] - tv[0]), e2 = __expf(tv[2] - tv[0]), e3 = __expf(tv[3] - tv[0]), inv = 1.0f / (1.0f + e1 + e2 + e3);
          if (e < 4) { const int ex = e == 0 ? ti[0] : (e == 1 ? ti[1] : (e == 2 ? ti[2] : ti[3])); const float gt = (e == 0 ? 1.0f : (e == 1 ? e1 : (e == 2 ? e2 : e3))) * inv;
              const unsigned pos = __hip_atomic_fetch_add((unsigned*)(F.ctl + CW_CNT + 64 * ex), 1u, RLX_AGENT);
              WSP(int, WS_SLOTTOK)[ex * T + (int)pos] = tok; WSP(int, WS_TOKE)[tok * 4 + e] = ex; WSP(int, WS_TOKPOS)[tok * 4 + e] = (int)pos; WSP(float, WS_GATE)[tok * 4 + e] = gt; } }
    }
}

#undef P7_LOADRW
#undef P7_MMA
__device__ __forceinline__ void moe_tables(Frame& F) {
    __syncthreads();
    if (F.tid < NEXP) F.LW[LW_CNT + F.tid] = __hip_atomic_load((unsigned*)(F.ctl + CW_CNT + 64 * F.tid), RLX_AGENT);
    __syncthreads();
    if (F.tid == 0) { unsigned a = 0; for (int e = 0; e < NEXP; ++e) { F.LW[LW_RBS + e] = a; a += (F.LW[LW_CNT + e] + 255u) >> 8; } F.LW[LW_RBS + NEXP] = a; }
    __syncthreads();
}

__device__ __forceinline__ void p10_combine(Frame& F) {
    const int gw = blockIdx.x * NWAVES + F.wave, NGW = F.G * NWAVES, lane = F.lane;
    const bf16* h1 = WSP(const bf16, WS_H1); const uchar* yb = WSP(const uchar, WS_YB);
    const int* toke = WSP(const int, WS_TOKE); const int* tokp = WSP(const int, WS_TOKPOS); const float* gate = WSP(const float, WS_GATE);
    f32x4 nw[4][2];
#pragma unroll
    for (int jj = 0; jj < 4; ++jj) { const int col = 8 * (lane + 64 * jj); nw[jj][0] = *(const f32x4*)(F.norm_final_w + col); nw[jj][1] = *(const f32x4*)(F.norm_final_w + col + 4); }
    int tok = gw;
    i32x4_t en = (i32x4_t){0, 0, 0, 0}, pn = (i32x4_t){0, 0, 0, 0}; f32x4 gn = (f32x4){0.f, 0.f, 0.f, 0.f};
    if (tok < T) { en = *(const i32x4_t*)(toke + tok * 4); pn = *(const i32x4_t*)(tokp + tok * 4); gn = *(const f32x4*)(gate + tok * 4); }
    for (; tok < T; tok += NGW) {
        const i32x4_t ec = en, pc = pn; const f32x4 gc = gn;
        const int tnext = tok + NGW;
        if (tnext < T) { en = *(const i32x4_t*)(toke + tnext * 4); pn = *(const i32x4_t*)(tokp + tnext * 4); gn = *(const f32x4*)(gate + tnext * 4); }
        float hv[4][8];
#pragma unroll
        for (int jj = 0; jj < 4; ++jj) { const u32x4 a = *(const u32x4*)(h1 + (size_t)tok * D + 8 * (lane + 64 * jj));
            hv[jj][0] = bflo(a.x); hv[jj][1] = bfhi(a.x); hv[jj][2] = bflo(a.y); hv[jj][3] = bfhi(a.y); hv[jj][4] = bflo(a.z); hv[jj][5] = bfhi(a.z); hv[jj][6] = bflo(a.w); hv[jj][7] = bfhi(a.w); }
#pragma unroll
        for (int k = 0; k < 4; ++k) { const int e = ec[k], pos = pc[k]; const float gt = gc[k] * (1.0f / YBS);
            const size_t slot = (size_t)F.LW[LW_RBS + e] * 256 + pos;
#pragma unroll
            for (int jj = 0; jj < 4; ++jj) { const u32x2 v = *(const u32x2*)(yb + slot * D + 8 * (lane + 64 * jj));
                const f32x2 p0 = __builtin_amdgcn_cvt_pk_f32_fp8((int)v.x, false), p1 = __builtin_amdgcn_cvt_pk_f32_fp8((int)v.x, true), p2 = __builtin_amdgcn_cvt_pk_f32_fp8((int)v.y, false), p3 = __builtin_amdgcn_cvt_pk_f32_fp8((int)v.y, true);
                hv[jj][0] += gt * p0[0]; hv[jj][1] += gt * p0[1]; hv[jj][2] += gt * p1[0]; hv[jj][3] += gt * p1[1]; hv[jj][4] += gt * p2[0]; hv[jj][5] += gt * p2[1]; hv[jj][6] += gt * p3[0]; hv[jj][7] += gt * p3[1]; } }
        float s = 0.f;
#pragma unroll
        for (int jj = 0; jj < 4; ++jj)
#pragma unroll
            for (int e = 0; e < 8; ++e) s += hv[jj][e] * hv[jj][e];
        const float rstd = rsqrtf(wave_sum(s) * (1.f / D) + EPS);
#pragma unroll
        for (int jj = 0; jj < 4; ++jj) { const int col = 8 * (lane + 64 * jj);
            float* o = F.out + (size_t)tok * D + col;
            *(f32x4*)o = (f32x4){hv[jj][0] * rstd * nw[jj][0][0], hv[jj][1] * rstd * nw[jj][0][1], hv[jj][2] * rstd * nw[jj][0][2], hv[jj][3] * rstd * nw[jj][0][3]};
            *(f32x4*)(o + 4) = (f32x4){hv[jj][4] * rstd * nw[jj][1][0], hv[jj][5] * rstd * nw[jj][1][1], hv[jj][6] * rstd * nw[jj][1][2], hv[jj][7] * rstd * nw[jj][1][3]}; }
    }
}

struct Args { const float* in[21]; float* out; unsigned char* ws; int ph_lo, ph_hi, li, pad; };
__global__ void __launch_bounds__(NWAVES * 64, 2) mk_fwd(Args args) {
    extern __shared__ __attribute__((aligned(16))) unsigned char lds[];
    Frame F;
    F.lds = (LAS uchar*)lds; F.LW = (volatile LAS unsigned*)(F.lds + LDSCTL_OFF);
    F.tid = threadIdx.x; F.lane = F.tid & 63; F.wave = __builtin_amdgcn_readfirstlane(F.tid >> 6); F.G = gridDim.x;
    F.ws = args.ws; F.out = args.out; F.ctl = (gu32*)(args.ws + WS_CTL);
    F.x = args.in[0]; F.norm_mix_w = args.in[1]; F.w_in = args.in[2]; F.w_pool = args.in[3]; F.pool_scale = args.in[4]; F.conv_w = args.in[5]; F.conv_b = args.in[6];
    F.dt_bias = args.in[7]; F.a_log = args.in[8]; F.d_skip = args.in[9]; F.ssd_norm_w = args.in[10]; F.w_ssd_out = args.in[11]; F.w_out = args.in[12]; F.norm_ffn_w = args.in[13];
    F.router_w = args.in[14]; F.router_b = args.in[15]; F.w_up = args.in[16]; F.b_up = args.in[17]; F.w_down = args.in[18]; F.b_down = args.in[19]; F.norm_final_w = args.in[20];
    for (int u = F.tid; u < 256; u += NWAVES * 64) F.LW[u] = 0u;
    __syncthreads();
    XcdBarrier bar; bar.bar = (unsigned*)(F.ctl + CW_BAR) + args.li * XCD_BAR_WORDS; bar.x = 0; bar.st = nullptr;
    if (N_LAUNCHES != NPHASES) bar = xcd_barrier_post((unsigned*)(F.ctl + CW_BAR) + args.li * XCD_BAR_WORDS, F.LW + LW_BAR);
    const int lo = args.ph_lo, hi = args.ph_hi;
#define IN(k) (lo <= (k) && (k) < hi)
#define SEAM(k) do { if (IN(k) && IN((k) + 1)) xcd_barrier(bar); } while (0)

    const bool split = (F.G == 256);
    const int bx = (int)blockIdx.x, xcd_ = bx & 7, slot_ = bx >> 3;
    const bool gemm_wg = !split || xcd_ < 6;
    const int G1 = split ? 192 : F.G, c1 = split ? slot_ * 6 + xcd_ : bx;
    if (IN(0)) { REPS(0) p0_prologue(F, !split); } SEAM(0);

    if (IN(1)) {
        if (gemm_wg) {
            { EpiInProj E{WSP(bf16, WS_XP), WSP(bf16, WS_Z), WSP(bf16, WS_XBC), WSP(bf16, WS_GP), WSP(bf16, WS_GS), WSP(float, WS_DT)};
              DenseOrder S; S.to.init(T / 256, 49, G1, c1, split ? 6 : 8); S.skip_lo = 48; S.skip_n = 16; S.Bt = WSP(const bf16, WS_WIN); S.K = D;
              pg8::gemm_phase<EpiInProj, DenseOrder, PG8_ALIGN, PG8_SP2>(F.lds, WSP(const bf16, WS_U), D, S, E); }
            __syncthreads();
            { EpiInProjT<true> E{WSP(bf16, WS_XP), WSP(bf16, WS_Z), WSP(bf16, WS_XBC), WSP(bf16, WS_GP), WSP(bf16, WS_GS), WSP(float, WS_DT)};
              DenseOrder S; S.K = D / 2; S.Bt = (const bf16*)(WSP(const char, WS_WIN8) - (size_t)48 * 256 * 2048);
              if (!split) { S.to.init(T / 256, 16, G1, c1, 8); S.pn0 = 48; }
              else if (c1 < 64) { S.to.init(T / 256, 4, 64, c1, 6); S.pn0 = 60; }
              else { S.to.init(T / 256, 12, 128, c1 - 64, 6); S.pn0 = 48; }
              pg8::gemm_phase<EpiInProjT<true>, DenseOrder, PG8_ALIGN, PG8_SP2, true>(F.lds, WSP(const bf16, WS_U8), D / 2, S, E); }
        } else p1_convert_late(F, (slot_ * 2 + (xcd_ - 6)) * NWAVES + F.wave, 64 * NWAVES);
    } SEAM(1);

    if (IN(2)) {
        if (split) { p0_convert<1>(F, (int)blockIdx.x * NWAVES + F.wave, F.G * NWAVES); __syncthreads(); }
        REPS(3) for (int u = blockIdx.x; u < 1024; u += F.G) p2_states_unit(F, u);
        REPS(12) p2_pool_items(F);
    } SEAM(2);

    if (IN(3)) {
        PoolOrder S{F.G, (int)blockIdx.x, WSP(const bf16, WS_WPOOL)};
        EpiPool E{WSP(bf16, WS_MERGED), WSP(const bf16, WS_GP), F.pool_scale};
        pg8::gemm_phase<EpiPool, PoolOrder, PG8_ALIGN, PG8_SP2>(F.lds, WSP(const bf16, WS_POOLED), 512, S, E);
        p3_scan(F);
    } SEAM(3);

    if (IN(5)) { REPS(5) for (int u = blockIdx.x; u < 1024; u += F.G) p4_unit(F, u); } SEAM(5);

    if (IN(6)) {
        DenseOrder S; S.to.init(T / 256, D / 256, F.G, (int)blockIdx.x); S.to.wgm = 4;   S.Bt = WSP(const bf16, WS_WSSD); S.K = ZI;
        EpiSsdOut E{WSP(bf16, WS_MERGED), WSP(const bf16, WS_GS)};
        pg8::gemm_phase<EpiSsdOut, DenseOrder, PG8_ALIGN, PG8_SP2>(F.lds, WSP(const bf16, WS_YG), ZI, S, E);
    } SEAM(6);

    if (IN(7)) {
        DenseOrder S; S.to.init(T / 256, D / 256, F.G, (int)blockIdx.x); S.to.wgm = 4; S.Bt = WSP(const bf16, WS_WOUT); S.K = D;
        EpiWout E{F.x, WSP(bf16, WS_H1)};
        pg8::gemm_phase<EpiWout, DenseOrder, PG8_ALIGN, PG8_SP2>(F.lds, WSP(const bf16, WS_MERGED), D, S, E);
    } SEAM(7);

    if (IN(8)) { p7_router(F); } SEAM(8);

    if (IN(9)) {
        moe_tables(F);
        MoeOrder S; S.to.init((int)F.LW[LW_RBS + NEXP], 16, F.G, (int)blockIdx.x); S.Bt = WSP(const bf16, WS_WUP); S.K = MOE_FP8 ? D / 2 : D; S.estride_bytes = (size_t)4096 * 2048 * (MOE_FP8 ? 1 : 2); S.LW = F.LW; S.slot_tok = WSP(const int, WS_SLOTTOK); S.gather = true;
        EpiUp E{WSP(uchar, WS_ACT), F.b_up};
        pg8::gemm_phase<EpiUp, MoeOrder, PG8_ALIGN, PG8_SP2, MOE_FP8 != 0>(F.lds, WSP(const bf16, WS_U), MOE_FP8 ? D / 2 : D, S, E);
    } SEAM(9);

    if (IN(10)) {
        moe_tables(F);
        MoeOrder S; S.to.init((int)F.LW[LW_RBS + NEXP], 8, F.G, (int)blockIdx.x); S.Bt = WSP(const bf16, WS_WDOWN); S.K = MOE_FP8 ? D / 2 : D; S.estride_bytes = (size_t)2048 * 2048 * (MOE_FP8 ? 1 : 2); S.LW = F.LW; S.slot_tok = WSP(const int, WS_SLOTTOK); S.gather = false;
        EpiDown E{WSP(uchar, WS_YB), F.b_down};
        pg8::gemm_phase<EpiDown, MoeOrder, PG8_ALIGN, PG8_SP2, MOE_FP8 != 0>(F.lds, WSP(const bf16, WS_ACT), MOE_FP8 ? D / 2 : D, S, E);
    } SEAM(10);

    if (IN(11)) { moe_tables(F); REPS(11) p10_combine(F); }
#undef IN
#undef SEAM
}

extern "C" void kernel_launch(void* const* d_in, const int* in_sizes, int n_in, void* d_out, int out_size, void* d_ws, size_t ws_size, hipStream_t stream) {
    static int grid = 0;
    if (grid == 0) {
        if (n_in != 21 || in_sizes[0] != T * D || out_size != T * D || ws_size < WS_END) { fprintf(stderr, "kernel_launch: unexpected shapes (n_in %d, in0 %d, out %d, ws %zu < %zu); nothing launched\n", n_in, n_in > 0 ? in_sizes[0] : -1, out_size, ws_size, (size_t)WS_END); grid = -1; return; }
        int dev = 0, cus = 0, per_cu = 0;
        if (hipGetDevice(&dev) != hipSuccess || hipDeviceGetAttribute(&cus, hipDeviceAttributeMultiprocessorCount, dev) != hipSuccess) { grid = -1; return; }
        if (hipFuncSetAttribute((const void*)mk_fwd, hipFuncAttributeMaxDynamicSharedMemorySize, LDS_BYTES) != hipSuccess) { fprintf(stderr, "kernel_launch: hipFuncSetAttribute failed\n"); grid = -1; return; }
        if (hipOccupancyMaxActiveBlocksPerMultiprocessor(&per_cu, (const void*)mk_fwd, NWAVES * 64, LDS_BYTES) != hipSuccess || per_cu < 1)
            fprintf(stderr, "kernel_launch: note: occupancy query reports %d workgroups per CU\n", per_cu);
        (void)hipGetLastError();
        grid = cus;
    }
    if (grid < 0) return;
    if (hipMemsetAsync((char*)d_ws + WS_CTL, 0, CTL_ZERO_BYTES, stream) != hipSuccess) return;
    Args a{};
    for (int i = 0; i < 21; ++i) a.in[i] = (const float*)d_in[i];
    a.out = (float*)d_out; a.ws = (unsigned char*)d_ws;
    int lo = 0, li = 0;
    for (int k = 1; k <= NPHASES; ++k) {
        const bool cut = (k == NPHASES) || (N_LAUNCHES == NPHASES) || (N_LAUNCHES != 1 && ((MK_CUTS >> k) & 1));
        if (!cut) continue;
        a.ph_lo = lo; a.ph_hi = k; a.li = li; lo = k; ++li;
        hipLaunchKernelGGL(mk_fwd, dim3(grid), dim3(NWAVES * 64), LDS_BYTES, stream, a);
        const hipError_t le = hipPeekAtLastError();
        if (le != hipSuccess) { fprintf(stderr, "kernel_launch: launch %d failed: %s\n", li, hipGetErrorName(le)); break; }
    }
}
```
